# Optimizing an MI355X kernel written in HIP

```python
import jax
import jax.numpy as jnp
from jax import lax
import numpy as np

D_MODEL = 1024
BATCH = 2
SEQ = 8192
DEPTH = 1

MEM_LEN = 256
ROPE_THETA = 500000.0
LN_EPS = 1e-5
ALPHA = (2.0 * DEPTH) ** 0.25
BETA = (8.0 * DEPTH) ** -0.25
GMLP_WIDTH = D_MODEL
GMLP_GROUPS = 8
GMLP_CHUNK = 128
NSA_HEADS = 16
NSA_HEAD_DIM = D_MODEL // NSA_HEADS
NSA_KV_HEADS = 4
NSA_GROUP = NSA_HEADS // NSA_KV_HEADS
NSA_KV_DIM = NSA_KV_HEADS * NSA_HEAD_DIM
ROT_DIM = NSA_HEAD_DIM // 4
CMP_BLOCK = 32
CMP_STRIDE = 16
CMP_HIDDEN = 4 * NSA_HEAD_DIM
SLC_BLOCK = 64
N_SELECT = 16
WINDOW = 512
Q_BLOCK = 128
XATTN_HEADS = 4
XATTN_HEAD_DIM = D_MODEL // XATTN_HEADS
D_FF = 4 * D_MODEL
IN_SIZES = (GMLP_WIDTH, GMLP_WIDTH, NSA_HEADS * NSA_HEAD_DIM, 6 * NSA_KV_DIM, 3 * NSA_HEADS, D_MODEL, D_MODEL)
IN_COLS = sum(IN_SIZES)

kernel_name = 'hybrid_gmlp_nsa_deepnorm_block'


def layer_norm(x, g, b):
    xf = x.astype(jnp.float32)
    mu = jnp.mean(xf, axis=-1, keepdims=True)
    var = jnp.mean(jnp.square(xf - mu), axis=-1, keepdims=True)
    y = (xf - mu) * lax.rsqrt(var + LN_EPS) * g.astype(jnp.float32) + b.astype(jnp.float32)
    return y.astype(x.dtype)


def masked_softmax(s, mask):
    s = jnp.where(mask, s.astype(jnp.float32), -1e30)
    p = jax.nn.softmax(s, axis=-1)
    return jnp.where(mask, p, 0.0)


def partial_rope(x, pos):
    half = ROT_DIM // 2
    inv = ROPE_THETA ** (-jnp.arange(half, dtype=jnp.float32) / half)
    ang = pos.astype(jnp.float32)[..., None] * inv
    cos = jnp.cos(ang)[:, :, None, :]
    sin = jnp.sin(ang)[:, :, None, :]
    xf = x.astype(jnp.float32)
    x1, x2, rest = xf[..., :half], xf[..., half:ROT_DIM], xf[..., ROT_DIM:]
    out = jnp.concatenate([x1 * cos - x2 * sin, x2 * cos + x1 * sin, rest], axis=-1)
    return out.astype(x.dtype)


def gmlp_spatial_gating(u, v, ln_g, ln_b, w_s, b_s):
    B, S, C = v.shape
    v = layer_norm(v, ln_g, ln_b)
    vg = v.reshape(B, S // GMLP_CHUNK, GMLP_CHUNK, GMLP_GROUPS, C // GMLP_GROUPS)
    w = jnp.tril(w_s)
    mixed = jnp.einsum('gts,bnsgc->bntgc', w, vg) + b_s.T[None, None, :, :, None]
    return u * mixed.reshape(B, S, C)


def compress_blocks(k, pe, w1, b1, w2, b2):
    B, S = k.shape[:2]
    n_cmp = (S - CMP_BLOCK) // CMP_STRIDE + 1
    idx = CMP_STRIDE * np.arange(n_cmp)[:, None] + np.arange(CMP_BLOCK)[None, :]
    blocks = k[:, idx] + pe[None, None, :, None, :]
    flat = blocks.transpose(0, 1, 3, 2, 4).reshape(B, n_cmp, NSA_KV_HEADS, CMP_BLOCK * NSA_HEAD_DIM)
    h = jax.nn.gelu(flat @ w1 + b1)
    return h @ w2 + b2


def nsa_attention(q, k_cmp, v_cmp, k_slc, v_slc, k_win, v_win, g_nsa, positions,
                  cmp_k_pe, cmp_k_w1, cmp_k_b1, cmp_k_w2, cmp_k_b2,
                  cmp_v_pe, cmp_v_w1, cmp_v_b1, cmp_v_w2, cmp_v_b2):
    B, S = q.shape[:2]
    dt = q.dtype
    n_cmp = (S - CMP_BLOCK) // CMP_STRIDE + 1
    n_slc = S // SLC_BLOCK
    n_sel = min(N_SELECT, n_slc)
    n_qb = S // Q_BLOCK
    scale = NSA_HEAD_DIM ** -0.5

    q = partial_rope(q, positions).reshape(B, S, NSA_KV_HEADS, NSA_GROUP, NSA_HEAD_DIM)
    k_slc = partial_rope(k_slc, positions)
    k_win = partial_rope(k_win, positions)
    cmp_start = CMP_STRIDE * np.arange(n_cmp)
    cmp_end = cmp_start + CMP_BLOCK - 1
    kc = partial_rope(compress_blocks(k_cmp, cmp_k_pe, cmp_k_w1, cmp_k_b1, cmp_k_w2, cmp_k_b2), positions[:, cmp_end])
    vc = compress_blocks(v_cmp, cmp_v_pe, cmp_v_w1, cmp_v_b1, cmp_v_w2, cmp_v_b2)

    slc_start = SLC_BLOCK * np.arange(n_slc)
    overlap = jnp.asarray(((cmp_start[:, None] <= slc_start[None, :] + SLC_BLOCK - 1)
                           & (cmp_end[:, None] >= slc_start[None, :])).astype(np.float32))

    ks_blocks = k_slc.reshape(B, n_slc, SLC_BLOCK, NSA_KV_HEADS, NSA_HEAD_DIM).transpose(0, 3, 1, 2, 4)
    vs_blocks = v_slc.reshape(B, n_slc, SLC_BLOCK, NSA_KV_HEADS, NSA_HEAD_DIM).transpose(0, 3, 1, 2, 4)
    pad = ((0, 0), (WINDOW, 0), (0, 0), (0, 0))
    kw_pad = jnp.pad(k_win, pad)
    vw_pad = jnp.pad(v_win, pad)
    gates = jax.nn.sigmoid(g_nsa.astype(jnp.float32)).astype(dt).reshape(B, S, NSA_KV_HEADS, NSA_GROUP, 3)
    b_ix = jnp.arange(B)[:, None, None, None]
    h_ix = jnp.arange(NSA_KV_HEADS)[None, :, None, None]
    cmp_end_j = jnp.asarray(cmp_end)
    blk = jnp.arange(n_slc)
    m_sel = n_sel * SLC_BLOCK

    def query_block(qb):
        q0 = qb * Q_BLOCK
        t = q0 + jnp.arange(Q_BLOCK)
        qblk = lax.dynamic_slice_in_dim(q, q0, Q_BLOCK, axis=1)
        gblk = lax.dynamic_slice_in_dim(gates, q0, Q_BLOCK, axis=1)
        s_c = jnp.einsum('bqhgd,bnhd->bhgqn', qblk, kc) * scale
        p_c = masked_softmax(s_c, cmp_end_j[None, :] <= t[:, None])
        o_c = jnp.einsum('bhgqn,bnhd->bqhgd', p_c.astype(dt), vc)
        p_slc = jnp.einsum('bhgqn,nj->bhqj', p_c, overlap)
        cur = t // SLC_BLOCK
        valid = blk[None, :] <= cur[:, None]
        forced = (blk[None, :] == 0) | (blk[None, :] == cur[:, None]) | (blk[None, :] == cur[:, None] - 1)
        score = jnp.where(forced, jnp.inf, jnp.where(valid, p_slc, -jnp.inf))
        _, sel = lax.top_k(score, n_sel)
        k_sel = ks_blocks[b_ix, h_ix, sel].reshape(B, NSA_KV_HEADS, Q_BLOCK, m_sel, NSA_HEAD_DIM)
        v_sel = vs_blocks[b_ix, h_ix, sel].reshape(B, NSA_KV_HEADS, Q_BLOCK, m_sel, NSA_HEAD_DIM)
        kpos = (sel[..., None] * SLC_BLOCK + jnp.arange(SLC_BLOCK)).reshape(B, NSA_KV_HEADS, 1, Q_BLOCK, m_sel)
        s_s = jnp.einsum('bqhgd,bhqmd->bhgqm', qblk, k_sel) * scale
        p_s = masked_softmax(s_s, kpos <= t[:, None])
        o_s = jnp.einsum('bhgqm,bhqmd->bqhgd', p_s.astype(dt), v_sel)
        kw = lax.dynamic_slice_in_dim(kw_pad, q0, Q_BLOCK + WINDOW, axis=1)
        vw = lax.dynamic_slice_in_dim(vw_pad, q0, Q_BLOCK + WINDOW, axis=1)
        kpos_w = q0 - WINDOW + jnp.arange(Q_BLOCK + WINDOW)
        diff = t[:, None] - kpos_w[None, :]
        mask_w = (diff >= 0) & (diff < WINDOW) & (kpos_w[None, :] >= 0)
        s_w = jnp.einsum('bqhgd,bkhd->bhgqk', qblk, kw) * scale
        p_w = masked_softmax(s_w, mask_w)
        o_w = jnp.einsum('bhgqk,bkhd->bqhgd', p_w.astype(dt), vw)
        return gblk[..., 0:1] * o_c + gblk[..., 1:2] * o_s + gblk[..., 2:3] * o_w

    o = lax.map(query_block, jnp.arange(n_qb))
    return o.transpose(1, 0, 2, 3, 4, 5).reshape(B, S, NSA_HEADS * NSA_HEAD_DIM)


def memory_cross_attention(h, mem, w_q, w_kv, w_o):
    B, S, _ = h.shape
    M = mem.shape[1]
    q = (h @ w_q).reshape(B, S, XATTN_HEADS, XATTN_HEAD_DIM)
    k, v = jnp.split(mem @ w_kv, 2, axis=-1)
    k = k.reshape(B, M, XATTN_HEADS, XATTN_HEAD_DIM)
    v = v.reshape(B, M, XATTN_HEADS, XATTN_HEAD_DIM)
    s = jnp.einsum('bshd,bmhd->bhsm', q, k).astype(jnp.float32) * (XATTN_HEAD_DIM ** -0.5)
    p = jax.nn.softmax(s, axis=-1).astype(h.dtype)
    o = jnp.einsum('bhsm,bmhd->bshd', p, v).reshape(B, S, D_MODEL)
    return o @ w_o


def setup_inputs(seed: int = 0) -> dict:
    key = jax.random.key(seed)
    ks = iter(jax.random.split(key, 48))
    L = DEPTH

    def nrm(shape, scale):
        return scale * jax.random.normal(next(ks), shape, jnp.float32)

    def gain(shape):
        return 1.0 + nrm(shape, 0.02)

    fl = CMP_BLOCK * NSA_HEAD_DIM
    return {
        'x': nrm((BATCH, SEQ, D_MODEL), 1.0),
        'mem': nrm((BATCH, MEM_LEN, D_MODEL), 1.0),
        'positions': jnp.broadcast_to(jnp.arange(SEQ, dtype=jnp.int32), (BATCH, SEQ)),
        'ln_in_g': gain((D_MODEL,)),
        'ln_in_b': nrm((D_MODEL,), 0.02),
        'w_in': nrm((L, D_MODEL, IN_COLS), D_MODEL ** -0.5),
        'gmlp_ln_g': gain((L, GMLP_WIDTH)),
        'gmlp_ln_b': nrm((L, GMLP_WIDTH), 0.02),
        'gmlp_ws': nrm((L, GMLP_GROUPS, GMLP_CHUNK, GMLP_CHUNK), GMLP_CHUNK ** -0.5),
        'gmlp_bs': gain((L, GMLP_GROUPS, GMLP_CHUNK)),
        'cmp_k_pe': nrm((L, CMP_BLOCK, NSA_HEAD_DIM), 0.02),
        'cmp_k_w1': nrm((L, fl, CMP_HIDDEN), fl ** -0.5),
        'cmp_k_b1': nrm((L, CMP_HIDDEN), 0.02),
        'cmp_k_w2': nrm((L, CMP_HIDDEN, NSA_HEAD_DIM), CMP_HIDDEN ** -0.5),
        'cmp_k_b2': nrm((L, NSA_HEAD_DIM), 0.02),
        'cmp_v_pe': nrm((L, CMP_BLOCK, NSA_HEAD_DIM), 0.02),
        'cmp_v_w1': nrm((L, fl, CMP_HIDDEN), fl ** -0.5),
        'cmp_v_b1': nrm((L, CMP_HIDDEN), 0.02),
        'cmp_v_w2': nrm((L, CMP_HIDDEN, NSA_HEAD_DIM), CMP_HIDDEN ** -0.5),
        'cmp_v_b2': nrm((L, NSA_HEAD_DIM), 0.02),
        'w_out': nrm((L, D_MODEL, D_MODEL), BETA * D_MODEL ** -0.5),
        'ln1_g': gain((L, D_MODEL)),
        'ln1_b': nrm((L, D_MODEL), 0.02),
        'w_xq': nrm((L, D_MODEL, D_MODEL), D_MODEL ** -0.5),
        'w_xkv': nrm((L, D_MODEL, 2 * D_MODEL), D_MODEL ** -0.5),
        'w_xo': nrm((L, D_MODEL, D_MODEL), BETA * D_MODEL ** -0.5),
        'ln2_g': gain((L, D_MODEL)),
        'ln2_b': nrm((L, D_MODEL), 0.02),
        'w_ff1': nrm((L, D_MODEL, D_FF), D_MODEL ** -0.5),
        'w_ff2': nrm((L, D_FF, D_MODEL), BETA * D_FF ** -0.5),
        'ln3_g': gain((L, D_MODEL)),
        'ln3_b': nrm((L, D_MODEL), 0.02),
    }


def reference(x, mem, positions, ln_in_g, ln_in_b, w_in, gmlp_ln_g, gmlp_ln_b, gmlp_ws, gmlp_bs,
              cmp_k_pe, cmp_k_w1, cmp_k_b1, cmp_k_w2, cmp_k_b2,
              cmp_v_pe, cmp_v_w1, cmp_v_b1, cmp_v_w2, cmp_v_b2,
              w_out, ln1_g, ln1_b, w_xq, w_xkv, w_xo, ln2_g, ln2_b, w_ff1, w_ff2, ln3_g, ln3_b):
    B, S, _ = x.shape
    split_idx = [int(c) for c in np.cumsum(IN_SIZES)[:-1]]
    h = layer_norm(x, ln_in_g, ln_in_b)
    for l in range(DEPTH):
        z = h @ w_in[l]
        u, v, q, kv, g_nsa, g_a, g_b = jnp.split(z, split_idx, axis=-1)
        y_a = gmlp_spatial_gating(jax.nn.gelu(u), jax.nn.gelu(v), gmlp_ln_g[l], gmlp_ln_b[l], gmlp_ws[l], gmlp_bs[l])
        k_cmp, v_cmp, k_slc, v_slc, k_win, v_win = [
            t.reshape(B, S, NSA_KV_HEADS, NSA_HEAD_DIM) for t in jnp.split(kv, 6, axis=-1)]
        y_b = nsa_attention(q.reshape(B, S, NSA_HEADS, NSA_HEAD_DIM), k_cmp, v_cmp, k_slc, v_slc, k_win, v_win,
                            g_nsa, positions,
                            cmp_k_pe[l], cmp_k_w1[l], cmp_k_b1[l], cmp_k_w2[l], cmp_k_b2[l],
                            cmp_v_pe[l], cmp_v_w1[l], cmp_v_b1[l], cmp_v_w2[l], cmp_v_b2[l])
        mix = jax.nn.sigmoid(g_a) * y_a + jax.nn.sigmoid(g_b) * y_b
        h = layer_norm(ALPHA * h + mix @ w_out[l], ln1_g[l], ln1_b[l])
        h = layer_norm(ALPHA * h + memory_cross_attention(h, mem, w_xq[l], w_xkv[l], w_xo[l]), ln2_g[l], ln2_b[l])
        ff = jnp.square(jax.nn.relu(h @ w_ff1[l])) @ w_ff2[l]
        h = layer_norm(ALPHA * h + ff, ln3_g[l], ln3_b[l])
    return h
```

```cpp
#include <hip/hip_runtime.h>
#include <hip/hip_cooperative_groups.h>
#include <cstdio>
#include <cstdint>
namespace cg = cooperative_groups;

#define LAS __attribute__((address_space(3)))
typedef unsigned short bf16_t;
typedef short bf16x8 __attribute__((ext_vector_type(8)));
typedef float f32x4 __attribute__((ext_vector_type(4)));
typedef float f32x2 __attribute__((ext_vector_type(2)));
typedef unsigned u32x4 __attribute__((ext_vector_type(4)));
typedef unsigned u32x2 __attribute__((ext_vector_type(2)));

__device__ __forceinline__ unsigned f2bf(float f) { unsigned u = __builtin_bit_cast(unsigned, f); return (u + 0x7fffu + ((u >> 16) & 1u)) >> 16; }
__device__ __forceinline__ unsigned pk2(float lo, float hi) { return f2bf(lo) | (f2bf(hi) << 16); }
__device__ __forceinline__ float bflo(unsigned w) { return __builtin_bit_cast(float, w << 16); }
__device__ __forceinline__ float bfhi(unsigned w) { return __builtin_bit_cast(float, w & 0xffff0000u); }
__device__ __forceinline__ float bf1(bf16_t h) { return __builtin_bit_cast(float, ((unsigned)h) << 16); }
__device__ __forceinline__ float gelu_t(float x) { const float u = x * (1.f + 0.044715f * x * x); const float e = __builtin_amdgcn_exp2f(-2.3022081986f * u); return x * __builtin_amdgcn_rcpf(1.f + e); }
__device__ __forceinline__ float sigm(float x) { return __builtin_amdgcn_rcpf(1.f + __builtin_amdgcn_exp2f(-1.4426950409f * x)); }
__device__ __forceinline__ float wave_sum(float v) {
#pragma unroll
    for (int o = 1; o < 64; o <<= 1) v += __shfl_xor(v, o);
    return v;
}
#define LDS_WAIT() asm volatile("s_waitcnt lgkmcnt(0)" ::: "memory")

namespace pg8 {
constexpr int BM = 256, BK = 64, HALF = 128, HTB = HALF * BK * 2, STAGE_BYTES = 8 * HTB, NXCD = 8, WGM = 8;
__host__ __device__ __forceinline__ int lds_byte(int r, int c) { const int st = (r >> 4) * 2 + (c >> 5), rr = r & 15, cc = c & 31, ob = rr * 64 + cc * 2; return st * 1024 + (ob ^ (((ob >> 9) & 1) << 5)); }
__host__ __device__ __forceinline__ void stage_rc(int b, int& R, int& C) { const int st = b / 1024, sb = b % 1024, swz = sb ^ (((sb >> 9) & 1) << 5); R = (st >> 1) * 16 + swz / 64; C = (st & 1) * 32 + (swz % 64) / 2; }
__host__ __device__ __forceinline__ int perm32(int rho) { const int n = rho >> 4, i = rho & 15; return 8 * (i >> 2) + 4 * n + (i & 3); }
struct Unit { int pm, pn; };
struct Gemm { const bf16_t* A; const bf16_t* Bt; int M, N, K, lda; };
struct StaticOrder {
    int nM, nN, nwg, G, c;
    __device__ void init(int M, int N, int G_, int c_) { nM = M / BM; nN = N / BM; nwg = nM * nN; G = G_; c = c_; }
    __device__ bool next(int i, Unit& u) const {
        const long L = (long)i * G + c; if (L >= nwg) return false;
        int wgid = (int)L; { const int q = nwg / NXCD, r = nwg % NXCD, xcd = wgid % NXCD, off = wgid / NXCD; wgid = (xcd < r ? xcd * (q + 1) : r * (q + 1) + (xcd - r) * q) + off; }
        const int nig = WGM * nN, gid = wgid / nig, fm = gid * WGM, gsz = (nM - fm) < WGM ? (nM - fm) : WGM;
        u.pm = fm + ((wgid % nig) % gsz); u.pn = (wgid % nig) / gsz; return true;
    }
};
__device__ __forceinline__ unsigned cvt_pk_bf16(float lo, float hi) { unsigned r; asm volatile("v_cvt_pk_bf16_f32 %0, %1, %2" : "=v"(r) : "v"(lo), "v"(hi)); return r; }

template <int ACT> struct EpiBf16 {
    static constexpr bool PERM = true;
    bf16_t* O; int ldc; const float* bias; float scale;
    __device__ __forceinline__ void operator()(const f32x4 (&acc)[2][2][4][2], const Unit& u, int wr, int wc, int fr, int fq) const {
        const int row0 = u.pm * BM + wr * 64 + fr; const int col0 = u.pn * BM + wc * 32 + 8 * fq;
        f32x4 bv[2][2];
#pragma unroll
        for (int bj = 0; bj < 2; ++bj)
#pragma unroll
            for (int n = 0; n < 2; ++n) bv[bj][n] = bias ? *(const f32x4*)(bias + col0 + bj * HALF + 4 * n) : (f32x4){0.f, 0.f, 0.f, 0.f};
#pragma unroll
        for (int ai = 0; ai < 2; ++ai)
#pragma unroll
            for (int m = 0; m < 4; ++m) { bf16_t* rowp = O + (size_t)(row0 + ai * HALF + m * 16) * ldc + col0;
#pragma unroll
                for (int bj = 0; bj < 2; ++bj) { f32x4 v0 = acc[ai][bj][m][0] + bv[bj][0], v1 = acc[ai][bj][m][1] + bv[bj][1];
                    if (ACT == 2) {
#pragma unroll
                        for (int e = 0; e < 4; ++e) { v0[e] = gelu_t(v0[e]); v1[e] = gelu_t(v1[e]); } }
                    if (ACT == 3) {
#pragma unroll
                        for (int e = 0; e < 4; ++e) { float a0 = v0[e] > 0.f ? v0[e] : 0.f, a1 = v1[e] > 0.f ? v1[e] : 0.f; v0[e] = a0 * a0; v1[e] = a1 * a1; } }
                    v0 = v0 * scale; v1 = v1 * scale; u32x4 w; w.x = cvt_pk_bf16(v0[0], v0[1]); w.y = cvt_pk_bf16(v0[2], v0[3]); w.z = cvt_pk_bf16(v1[0], v1[1]); w.w = cvt_pk_bf16(v1[2], v1[3]);
                    *(u32x4*)(rowp + bj * HALF) = w; } }
    }
};
struct EpiF32 {
    static constexpr bool PERM = false;
    float* O; int ldc;
    __device__ __forceinline__ void operator()(const f32x4 (&acc)[2][2][4][2], const Unit& u, int wr, int wc, int fr, int fq) const {
        const int row0 = u.pm * BM + wr * 64 + fr; const int col0 = u.pn * BM + wc * 32 + 4 * fq;
#pragma unroll
        for (int ai = 0; ai < 2; ++ai)
#pragma unroll
            for (int m = 0; m < 4; ++m) { float* rowp = O + (size_t)(row0 + ai * HALF + m * 16) * ldc + col0;
#pragma unroll
                for (int bj = 0; bj < 2; ++bj)
#pragma unroll
                    for (int n = 0; n < 2; ++n) *(f32x4*)(rowp + bj * HALF + n * 16) = acc[ai][bj][m][n]; }
    }
};

template <class Epi, class Sched, bool ALIGN_EPI>
__device__ __forceinline__ void gemm_phase(LAS unsigned char* lds, const Gemm g, const Sched& S, const Epi& E) {
    const int tid = threadIdx.x, wid = __builtin_amdgcn_readfirstlane(tid >> 6), lane = tid & 63, wr = wid >> 2, wc = wid & 3, fr = lane & 15, fq = lane >> 4;
    const int K = g.K, nt = K / BK, lda = g.lda;
    unsigned voffA[2], voffB[2];
#pragma unroll
    for (int i = 0; i < 2; ++i) { int R, C; stage_rc(tid * 16 + i * 8192, R, C); const int Rb = Epi::PERM ? ((R & ~31) + perm32(R & 31)) : R;
        voffA[i] = (unsigned)(R * lda + C) * 2u; voffB[i] = (unsigned)(Rb * K + C) * 2u; }
    const size_t kstep = (size_t)(BK * 2);
    const size_t hstepA = (size_t)HALF * lda * 2, hstepB = (size_t)HALF * K * 2;
    const size_t tstepA = 2 * hstepA, tstepB = 2 * hstepB;
    const unsigned ldsw = (unsigned)wid * 1024u;
    const int aoff = lds_byte(wr * 64 + fr, fq * 8), boff = lds_byte(wc * 32 + fr, fq * 8);
#define PG8_SA(b, h) (((b) * 2 + (h)) * HTB)
#define PG8_SB(b, h) ((4 + (b) * 2 + (h)) * HTB)
#define PG8_STAGE(bufoff, gbase, voff) do { _Pragma("unroll") for (int _i = 0; _i < 2; ++_i) \
        __builtin_amdgcn_global_load_lds((const unsigned*)((const char*)(gbase) + (voff)[_i]), (LAS unsigned*)(lds + (bufoff) + ldsw + _i * 8192), 16, 0, 0); } while (0)
#define PG8_LDA(dst, b, h) do { _Pragma("unroll") for (int m = 0; m < 4; ++m) _Pragma("unroll") for (int k = 0; k < 2; ++k) dst[m][k] = *(const LAS bf16x8*)(lds + PG8_SA(b, h) + aoff + m * 2048 + k * 1024); } while (0)
#define PG8_LDB(dst, b, h) do { _Pragma("unroll") for (int n = 0; n < 2; ++n) _Pragma("unroll") for (int k = 0; k < 2; ++k) dst[n][k] = *(const LAS bf16x8*)(lds + PG8_SB(b, h) + boff + n * 2048 + k * 1024); } while (0)
#define PG8_MMA(ai, bj, At, Bt) do { __builtin_amdgcn_s_setprio(1); _Pragma("unroll") for (int m = 0; m < 4; ++m) _Pragma("unroll") for (int n = 0; n < 2; ++n) _Pragma("unroll") for (int k = 0; k < 2; ++k) \
        acc[ai][bj][m][n] = __builtin_amdgcn_mfma_f32_16x16x32_bf16(Bt[n][k], At[m][k], acc[ai][bj][m][n], 0, 0, 0); __builtin_amdgcn_s_setprio(0); } while (0)
#define PG8_WAIT_V(n) asm volatile("s_waitcnt vmcnt(" #n ")" ::: "memory")
#define PG8_WAIT_L(n) asm volatile("s_waitcnt lgkmcnt(" #n ")" ::: "memory")
#define PG8_BAR __builtin_amdgcn_s_barrier()
#define PG8_SCHED __builtin_amdgcn_sched_barrier(0)
    Unit cur, nxt; int ui = 0;
    if (!S.next(0, cur)) return;
    f32x4 acc[2][2][4][2];
#pragma unroll
    for (int a = 0; a < 2; ++a)
#pragma unroll
        for (int b = 0; b < 2; ++b)
#pragma unroll
            for (int m = 0; m < 4; ++m)
#pragma unroll
                for (int n = 0; n < 2; ++n) acc[a][b][m][n] = (f32x4){0.f, 0.f, 0.f, 0.f};
    bf16x8 At[4][2], B0[2][2], B1[2][2];
    const char* cA = (const char*)g.A + (size_t)cur.pm * tstepA; const char* cB = (const char*)g.Bt + (size_t)cur.pn * tstepB;
    PG8_STAGE(PG8_SB(0, 0), cB, voffB); PG8_STAGE(PG8_SB(0, 1), cB + hstepB, voffB); PG8_STAGE(PG8_SA(0, 0), cA, voffA); PG8_STAGE(PG8_SA(0, 1), cA + hstepA, voffA);
    if (wr == 1) PG8_BAR;
    PG8_WAIT_V(2); PG8_BAR;
    PG8_STAGE(PG8_SB(1, 0), cB + kstep, voffB); PG8_STAGE(PG8_SA(1, 0), cA + kstep, voffA); PG8_STAGE(PG8_SB(1, 1), cB + hstepB + kstep, voffB);
    PG8_WAIT_V(6); PG8_BAR;
    for (;;) {
        const bool has_next = S.next(ui + 1, nxt);
        const char* nA = has_next ? (const char*)g.A + (size_t)nxt.pm * tstepA : cA; const char* nB = has_next ? (const char*)g.Bt + (size_t)nxt.pn * tstepB : cB;
        for (int t = 0; t < nt; t += 2) {
            const bool last = (t == nt - 2);
            const char* a1 = cA + (size_t)(t + 1) * kstep;
            const char* a2 = last ? nA : cA + (size_t)(t + 2) * kstep; const char* b2 = last ? nB : cB + (size_t)(t + 2) * kstep;
            const char* a3 = a2 + kstep; const char* b3 = b2 + kstep;
            PG8_LDB(B0, 0, 0); PG8_LDB(B1, 0, 1); PG8_SCHED; PG8_LDA(At, 0, 0); PG8_STAGE(PG8_SA(1, 1), a1 + hstepA, voffA);
            PG8_WAIT_V(8); PG8_WAIT_L(0); PG8_BAR; PG8_MMA(0, 0, At, B0); PG8_MMA(0, 1, At, B1); PG8_BAR; PG8_SCHED;
            PG8_LDA(At, 0, 1); PG8_STAGE(PG8_SB(0, 0), b2, voffB); PG8_STAGE(PG8_SB(0, 1), b2 + hstepB, voffB); PG8_STAGE(PG8_SA(0, 0), a2, voffA);
            PG8_WAIT_V(8); PG8_WAIT_L(0); PG8_BAR; PG8_MMA(1, 0, At, B0); PG8_MMA(1, 1, At, B1); PG8_BAR; PG8_SCHED;
            PG8_LDB(B0, 1, 0); PG8_LDB(B1, 1, 1); PG8_SCHED; PG8_LDA(At, 1, 0); PG8_STAGE(PG8_SA(0, 1), a2 + hstepA, voffA);
            PG8_WAIT_V(8); PG8_WAIT_L(0); PG8_BAR; PG8_MMA(0, 0, At, B0); PG8_MMA(0, 1, At, B1); PG8_BAR; PG8_SCHED;
            PG8_LDA(At, 1, 1); PG8_STAGE(PG8_SB(1, 0), b3, voffB); PG8_STAGE(PG8_SB(1, 1), b3 + hstepB, voffB); PG8_STAGE(PG8_SA(1, 0), a3, voffA);
            PG8_WAIT_V(8); PG8_WAIT_L(0); PG8_BAR; PG8_MMA(1, 0, At, B0); PG8_MMA(1, 1, At, B1); PG8_BAR; PG8_SCHED;
        }
        if constexpr (ALIGN_EPI) { if (wr == 0) PG8_BAR; }
        E(acc, cur, wr, wc, fr, fq);
        if (!has_next) break;
#pragma unroll
        for (int a = 0; a < 2; ++a)
#pragma unroll
            for (int b = 0; b < 2; ++b)
#pragma unroll
                for (int m = 0; m < 4; ++m)
#pragma unroll
                    for (int n = 0; n < 2; ++n) acc[a][b][m][n] = (f32x4){0.f, 0.f, 0.f, 0.f};
        cur = nxt; cA = nA; cB = nB; ++ui;
        if constexpr (ALIGN_EPI) { if (wr == 1) PG8_BAR; }
    }
    PG8_WAIT_V(0);
    if constexpr (!ALIGN_EPI) { if (wr == 0) PG8_BAR; }
    PG8_BAR;
#undef PG8_SA
#undef PG8_SB
#undef PG8_STAGE
#undef PG8_LDA
#undef PG8_LDB
#undef PG8_MMA
#undef PG8_WAIT_V
#undef PG8_WAIT_L
#undef PG8_BAR
#undef PG8_SCHED
}
}

constexpr int NB = 2, S = 8192, D = 1024, T = NB * S, FF = 4096;
constexpr int ZC = 6912;
constexpr int C_U = 0, C_V = 1024, C_Q = 2048, C_KCMP = 3072, C_VCMP = 3328, C_KSLC = 3584, C_VSLC = 3840, C_KWIN = 4096, C_VWIN = 4352, C_GN = 4608, C_GA = 4656, C_GB = 5680;
constexpr float ALPHA = 1.189207115002721f;
constexpr float QSCALE = 0.125f * 1.4426950408889634f;
constexpr float XSCALE = 0.0625f * 1.4426950408889634f;
constexpr float LN_EPS = 1e-5f;
constexpr size_t MiB = 1u << 20;
constexpr size_t WS_Z = 0, WS_KCMPT = 216 * MiB, WS_VCMPT = 224 * MiB, WS_VSLCT = 232 * MiB, WS_VWINT = 240 * MiB, WS_HDNK = 248 * MiB, WS_HDNV = 250 * MiB,
                 WS_KC = 252 * MiB, WS_VCT = 252 * MiB + 512 * 1024, WS_WOUT_T = 253 * MiB, WS_C1 = 255 * MiB, WS_W2KT = 255 * MiB + 4096, WS_W2VT = 255 * MiB + 65536, WS_WSTRIL = 255 * MiB + 131072;
constexpr size_t WS_HF = 0, WS_HB = 64 * MiB, WS_XQ = 96 * MiB, WS_XO = 128 * MiB, WS_ACCF = 160 * MiB, WS_FFB = 96 * MiB,
                 WS_WXQ_T = 224 * MiB, WS_WXO_T = 226 * MiB, WS_WFF1_T = 228 * MiB, WS_WFF2_T = 236 * MiB;
constexpr size_t DO_H0B = 0, DO_MIX = 0, DO_WIN_T = 32 * MiB, DO_WXKV_T = 46 * MiB, DO_MEMB = 50 * MiB, DO_XKV = 51 * MiB, DO_XVT = 53 * MiB, DO_ROPE = 54 * MiB, DO_W1KT = 55 * MiB, DO_W1VT = 56 * MiB;
constexpr int LDS_BYTES = 147456;

struct Args { const float* in[32]; float* out; unsigned char* ws; int ph_lo, ph_hi; };

__device__ __forceinline__ void tr_item(const float* W, int K, int N, int Npad, bf16_t* WT, LAS float* scr, int item, int lane) {
    const int nblk = Npad / 32, kb = item / nblk, nb = item % nblk, k0 = 64 * kb, n0 = 32 * nb;
    const int cc = n0 + (lane & 31);
#pragma unroll 8
    for (int i = 0; i < 32; ++i) { const int kk = 2 * i + (lane >> 5); scr[kk * 33 + (lane & 31)] = (cc < N) ? W[(size_t)(k0 + kk) * N + cc] : 0.f; }
    LDS_WAIT();
    const int c = lane & 7;
#pragma unroll
    for (int j = 0; j < 4; ++j) { const int n = (lane >> 3) + 8 * j; const LAS float* s = scr + (8 * c) * 33 + n;
        u32x4 o; o.x = pk2(s[0 * 33], s[1 * 33]); o.y = pk2(s[2 * 33], s[3 * 33]); o.z = pk2(s[4 * 33], s[5 * 33]); o.w = pk2(s[6 * 33], s[7 * 33]);
        *(u32x4*)(WT + (size_t)(n0 + n) * K + k0 + 8 * c) = o; }
    LDS_WAIT();
}

__device__ __forceinline__ void ln_apply(f32x4 (&v)[4], const float* g, const float* b, int lane) {
    float s = 0.f;
#pragma unroll
    for (int j = 0; j < 4; ++j) s += (v[j].x + v[j].y) + (v[j].z + v[j].w);
    const float mean = wave_sum(s) * (1.f / 1024.f); float s2 = 0.f;
#pragma unroll
    for (int j = 0; j < 4; ++j) { v[j] = v[j] - mean; s2 += (v[j].x * v[j].x + v[j].y * v[j].y) + (v[j].z * v[j].z + v[j].w * v[j].w); }
    const float rstd = 1.f / sqrtf(wave_sum(s2) * (1.f / 1024.f) + LN_EPS);
#pragma unroll
    for (int j = 0; j < 4; ++j) { const f32x4 gg = *(const f32x4*)(g + 4 * lane + 256 * j), bb = *(const f32x4*)(b + 4 * lane + 256 * j); v[j] = v[j] * rstd * gg + bb; }
}
__device__ __forceinline__ void row_load(f32x4 (&v)[4], const float* p, int lane) {
#pragma unroll
    for (int j = 0; j < 4; ++j) v[j] = *(const f32x4*)(p + 4 * lane + 256 * j);
}
__device__ __forceinline__ void row_store_f32(const f32x4 (&v)[4], float* p, int lane) {
#pragma unroll
    for (int j = 0; j < 4; ++j) *(f32x4*)(p + 4 * lane + 256 * j) = v[j];
}
__device__ __forceinline__ void row_store_bf16(const f32x4 (&v)[4], bf16_t* p, int lane) {
#pragma unroll
    for (int j = 0; j < 4; ++j) { u32x2 w; w.x = pk2(v[j].x, v[j].y); w.y = pk2(v[j].z, v[j].w); *(u32x2*)(p + 4 * lane + 256 * j) = w; }
}

#define MFMA16(a, b, c) __builtin_amdgcn_mfma_f32_16x16x32_bf16((a), (b), (c), 0, 0, 0)

__device__ __forceinline__ void qk32(const bf16_t* kp, size_t t1off, bf16x8 qf0, bf16x8 qf1, f32x4& s0, f32x4& s1) {
    const bf16x8 k00 = *(const bf16x8*)(kp), k01 = *(const bf16x8*)(kp + 32), k10 = *(const bf16x8*)(kp + t1off), k11 = *(const bf16x8*)(kp + t1off + 32);
    const f32x4 z = {0.f, 0.f, 0.f, 0.f};
    s0 = MFMA16(k00, qf0, z); s0 = MFMA16(k01, qf1, s0); s1 = MFMA16(k10, qf0, z); s1 = MFMA16(k11, qf1, s1);
}
__device__ __forceinline__ void pv32(const bf16_t* vp, size_t dtoff, bf16x8 pb, f32x4 (&o)[4]) {
#pragma unroll
    for (int dt = 0; dt < 4; ++dt) { const u32x2 lo = *(const u32x2*)(vp + dt * dtoff), hi = *(const u32x2*)(vp + dt * dtoff + 16);
        u32x4 w; w.x = lo.x; w.y = lo.y; w.z = hi.x; w.w = hi.y; o[dt] = MFMA16(__builtin_bit_cast(bf16x8, w), pb, o[dt]); }
}
__device__ __forceinline__ bf16x8 pack_p(const float (&p)[8]) { u32x4 w; w.x = pk2(p[0], p[1]); w.y = pk2(p[2], p[3]); w.z = pk2(p[4], p[5]); w.w = pk2(p[6], p[7]); return __builtin_bit_cast(bf16x8, w); }
__device__ __forceinline__ bf16x8 osm_step(f32x4 s0, f32x4 s1, unsigned vm, float& m, float& l, f32x4 (&o)[4]) {
    float mx = -1e30f;
#pragma unroll
    for (int e = 0; e < 4; ++e) { if ((vm >> e) & 1u) mx = fmaxf(mx, s0[e]); if ((vm >> (4 + e)) & 1u) mx = fmaxf(mx, s1[e]); }
    mx = fmaxf(mx, __shfl_xor(mx, 16)); mx = fmaxf(mx, __shfl_xor(mx, 32));
    const float mn = fmaxf(m, mx), alpha = __builtin_amdgcn_exp2f(m - mn); m = mn;
    float p[8]; float ps = 0.f;
#pragma unroll
    for (int e = 0; e < 4; ++e) { p[e] = ((vm >> e) & 1u) ? __builtin_amdgcn_exp2f(s0[e] - mn) : 0.f; p[4 + e] = ((vm >> (4 + e)) & 1u) ? __builtin_amdgcn_exp2f(s1[e] - mn) : 0.f; ps += p[e] + p[4 + e]; }
    l = l * alpha + ps;
#pragma unroll
    for (int dt = 0; dt < 4; ++dt) o[dt] = o[dt] * alpha;
    return pack_p(p);
}

__global__ void __launch_bounds__(512, 2) mk_fwd(Args a) {
    extern __shared__ __attribute__((aligned(16))) unsigned char lds_raw[];
    LAS unsigned char* lds = (LAS unsigned char*)lds_raw;
    cg::grid_group grid = cg::this_grid();
    const int tid = threadIdx.x, lane = tid & 63, wid = __builtin_amdgcn_readfirstlane(tid >> 6);
    const int G = gridDim.x, gw = blockIdx.x * 8 + wid, NGW = G * 8, gtid = blockIdx.x * 512 + tid, NGT = G * 512;
    unsigned char* ws = a.ws; unsigned char* dout = (unsigned char*)a.out;
    const int lo = a.ph_lo, hi = a.ph_hi;
#define IN(k) (lo <= (k) && (k) < hi)
#define SYNC(k) do { if (IN(k) && IN((k) + 1)) grid.sync(); } while (0)
    bf16_t* const Z = (bf16_t*)(ws + WS_Z);
    float* const ROPE = (float*)(dout + DO_ROPE);

    if (IN(0)) {
        LAS float* scr = (LAS float*)(lds + wid * 8448);
        constexpr int I_WIN = 16 * 216, I_XKV = 16 * 64, I_W1 = 32 * 8, I_W2 = 4 * 2, I_WOUT = 16 * 32;
        constexpr int NIT = I_WIN + I_XKV + 2 * I_W1 + 2 * I_W2 + I_WOUT;
        for (int it = gw; it < NIT; it += NGW) { int r = it;
            if (r < I_WIN) { tr_item(a.in[5], 1024, 6704, 6912, (bf16_t*)(dout + DO_WIN_T), scr, r, lane); continue; } r -= I_WIN;
            if (r < I_XKV) { tr_item(a.in[24], 1024, 2048, 2048, (bf16_t*)(dout + DO_WXKV_T), scr, r, lane); continue; } r -= I_XKV;
            if (r < I_W1) { tr_item(a.in[11], 2048, 256, 256, (bf16_t*)(dout + DO_W1KT), scr, r, lane); continue; } r -= I_W1;
            if (r < I_W1) { tr_item(a.in[16], 2048, 256, 256, (bf16_t*)(dout + DO_W1VT), scr, r, lane); continue; } r -= I_W1;
            if (r < I_W2) { tr_item(a.in[13], 256, 64, 64, (bf16_t*)(ws + WS_W2KT), scr, r, lane); continue; } r -= I_W2;
            if (r < I_W2) { tr_item(a.in[18], 256, 64, 64, (bf16_t*)(ws + WS_W2VT), scr, r, lane); continue; } r -= I_W2;
            tr_item(a.in[20], 1024, 1024, 1024, (bf16_t*)(ws + WS_WOUT_T), scr, r, lane);
        }
        for (int m = gw; m < T; m += NGW) { f32x4 v[4]; row_load(v, a.in[0] + (size_t)m * D, lane); ln_apply(v, a.in[3], a.in[4], lane); row_store_bf16(v, (bf16_t*)(dout + DO_H0B) + (size_t)m * D, lane); }
        for (int i = gtid; i < 512 * 1024 / 4; i += NGT) { const f32x4 v = *(const f32x4*)(a.in[1] + 4 * (size_t)i); u32x2 w; w.x = pk2(v.x, v.y); w.y = pk2(v.z, v.w); *(u32x2*)((bf16_t*)(dout + DO_MEMB) + 4 * (size_t)i) = w; }
        for (int i = gtid; i < T * 8; i += NGT) { const int tok = i >> 3, fi = i & 7; const int pos = ((const int*)a.in[2])[tok];
            float inv = 1.0f;
            inv = fi == 1 ? 0.19392274474868576f : inv; inv = fi == 2 ? 0.03760603093086393f : inv; inv = fi == 3 ? 0.007292664737217109f : inv; inv = fi == 4 ? 0.001414213562373095f : inv;
            inv = fi == 5 ? 0.0002742481756762073f : inv; inv = fi == 6 ? 5.318295896944988e-05f : inv; inv = fi == 7 ? 1.031338537721246e-05f : inv;
            const float ang = (float)pos * inv; ROPE[tok * 16 + fi] = cosf(ang); ROPE[tok * 16 + 8 + fi] = sinf(ang); }
        for (int i = gtid; i < 8 * 128 * 128; i += NGT) { const int t = (i >> 7) & 127, s = i & 127; const float w = a.in[8][i]; ((bf16_t*)(ws + WS_WSTRIL))[i] = (bf16_t)(s <= t ? f2bf(w) : 0u); }
        if (gw < 8) { const int mat = gw >> 2, col = (gw & 3) * 64 + lane; const float* pe = a.in[mat ? 15 : 10]; const float* w1 = a.in[mat ? 16 : 11]; float sum = a.in[mat ? 17 : 12][col];
            for (int k = 0; k < 2048; ++k) sum += pe[k] * w1[(size_t)k * 256 + col];
            ((float*)(ws + WS_C1))[mat * 256 + col] = sum; }
    }
    SYNC(0);

    if (IN(1)) {
        { pg8::Gemm g{(const bf16_t*)(dout + DO_H0B), (const bf16_t*)(dout + DO_WIN_T), T, ZC, D, D}; pg8::StaticOrder So; So.init(T, ZC, G, (int)blockIdx.x);
          pg8::EpiBf16<0> E{Z, ZC, nullptr, 1.f}; pg8::gemm_phase<pg8::EpiBf16<0>, pg8::StaticOrder, true>(lds, g, So, E); }
        { pg8::Gemm g{(const bf16_t*)(dout + DO_MEMB), (const bf16_t*)(dout + DO_WXKV_T), 512, 2048, D, D}; pg8::StaticOrder So; So.init(512, 2048, G, (G - 1) - (int)blockIdx.x);
          pg8::EpiBf16<0> E{(bf16_t*)(dout + DO_XKV), 2048, nullptr, 1.f}; pg8::gemm_phase<pg8::EpiBf16<0>, pg8::StaticOrder, true>(lds, g, So, E); }
    }
    SYNC(1);

    if (IN(2)) {
        bf16_t* const KCMPT = (bf16_t*)(ws + WS_KCMPT); bf16_t* const VCMPT = (bf16_t*)(ws + WS_VCMPT); bf16_t* const VSLCT = (bf16_t*)(ws + WS_VSLCT); bf16_t* const VWINT = (bf16_t*)(ws + WS_VWINT);
        for (int tok = gw; tok < T; tok += NGW) {
            bf16_t* zr = Z + (size_t)tok * ZC; const int b = tok >> 13, t = tok & 8191;
            float rc[8], rs[8];
            { const f32x4 c0 = *(const f32x4*)(ROPE + tok * 16), c1 = *(const f32x4*)(ROPE + tok * 16 + 4), s0 = *(const f32x4*)(ROPE + tok * 16 + 8), s1 = *(const f32x4*)(ROPE + tok * 16 + 12);
#pragma unroll
              for (int e = 0; e < 4; ++e) { rc[e] = c0[e]; rc[4 + e] = c1[e]; rs[e] = s0[e]; rs[4 + e] = s1[e]; } }
            { const u32x4 w0 = *(const u32x4*)(zr + C_V + 16 * lane), w1 = *(const u32x4*)(zr + C_V + 16 * lane + 8); float f[16];
#pragma unroll
              for (int e = 0; e < 4; ++e) { f[2 * e] = bflo(w0[e]); f[2 * e + 1] = bfhi(w0[e]); f[8 + 2 * e] = bflo(w1[e]); f[8 + 2 * e + 1] = bfhi(w1[e]); }
              float s = 0.f;
#pragma unroll
              for (int e = 0; e < 16; ++e) { f[e] = gelu_t(f[e]); s += f[e]; }
              const float mean = wave_sum(s) * (1.f / 1024.f); float s2 = 0.f;
#pragma unroll
              for (int e = 0; e < 16; ++e) { f[e] -= mean; s2 += f[e] * f[e]; }
              const float rstd = 1.f / sqrtf(wave_sum(s2) * (1.f / 1024.f) + LN_EPS);
              const float* gg = a.in[6] + 16 * lane; const float* bb = a.in[7] + 16 * lane; u32x4 o0, o1;
#pragma unroll
              for (int e = 0; e < 4; ++e) { o0[e] = pk2(f[2 * e] * rstd * gg[2 * e] + bb[2 * e], f[2 * e + 1] * rstd * gg[2 * e + 1] + bb[2 * e + 1]);
                                            o1[e] = pk2(f[8 + 2 * e] * rstd * gg[8 + 2 * e] + bb[8 + 2 * e], f[9 + 2 * e] * rstd * gg[9 + 2 * e] + bb[9 + 2 * e]); }
              *(u32x4*)(zr + C_V + 16 * lane) = o0; *(u32x4*)(zr + C_V + 16 * lane + 8) = o1; }
            { const u32x4 w0 = *(const u32x4*)(zr + C_Q + 16 * lane), w1 = *(const u32x4*)(zr + C_Q + 16 * lane + 8); float f[16];
#pragma unroll
              for (int e = 0; e < 4; ++e) { f[2 * e] = bflo(w0[e]); f[2 * e + 1] = bfhi(w0[e]); f[8 + 2 * e] = bflo(w1[e]); f[8 + 2 * e + 1] = bfhi(w1[e]); }
              if ((lane & 3) == 0) {
#pragma unroll
                  for (int i = 0; i < 8; ++i) { const float x1 = f[i], x2 = f[8 + i]; f[i] = x1 * rc[i] - x2 * rs[i]; f[8 + i] = x2 * rc[i] + x1 * rs[i]; } }
              u32x4 o0, o1;
#pragma unroll
              for (int e = 0; e < 4; ++e) { o0[e] = pk2(f[2 * e] * QSCALE, f[2 * e + 1] * QSCALE); o1[e] = pk2(f[8 + 2 * e] * QSCALE, f[9 + 2 * e] * QSCALE); }
              *(u32x4*)(zr + C_Q + 16 * lane) = o0; *(u32x4*)(zr + C_Q + 16 * lane + 8) = o1; }
            { const int h = lane >> 4, r = lane & 15; const size_t bh = (size_t)(b * 4 + h);
              const f32x4 rcl = *(const f32x4*)(ROPE + tok * 16 + 4 * (r & 1)), rsl = *(const f32x4*)(ROPE + tok * 16 + 8 + 4 * (r & 1));
#pragma unroll
              for (int sg = 0; sg < 6; ++sg) {
                  const u32x2 w = *(const u32x2*)(zr + C_KCMP + sg * 256 + 4 * lane);
                  if (sg == 0) *(u32x2*)(KCMPT + (bh * 8192 + t) * 64 + 4 * r) = w;
                  else if (sg == 1) *(u32x2*)(VCMPT + (bh * 8192 + t) * 64 + 4 * r) = w;
                  else if (sg == 2 || sg == 4) {
                      float x[4] = {bflo(w.x), bfhi(w.x), bflo(w.y), bfhi(w.y)}; float y[4];
#pragma unroll
                      for (int e = 0; e < 4; ++e) { const float other = __shfl_xor(x[e], 2); const float c = rcl[e], sn = rsl[e];
                          y[e] = (r < 2) ? (x[e] * c - other * sn) : ((r < 4) ? (x[e] * c + other * sn) : x[e]); }
                      u32x2 o; o.x = pk2(y[0], y[1]); o.y = pk2(y[2], y[3]); *(u32x2*)(zr + C_KCMP + sg * 256 + 4 * lane) = o;
                  } else { bf16_t* VT = (sg == 3) ? VSLCT : VWINT; bf16_t* p = VT + (bh * 64 + 4 * r) * 8192 + t;
                      p[0] = (bf16_t)(w.x & 0xffffu); p[8192] = (bf16_t)(w.x >> 16); p[2 * 8192] = (bf16_t)(w.y & 0xffffu); p[3 * 8192] = (bf16_t)(w.y >> 16); }
              } }
        }
        for (int i = gtid; i < 512 * 128; i += NGT) { const int mrow = i >> 7, cgp = i & 127; const u32x4 w = *(const u32x4*)((const bf16_t*)(dout + DO_XKV) + (size_t)mrow * 2048 + 1024 + 8 * cgp);
            bf16_t* p = (bf16_t*)(dout + DO_XVT) + ((size_t)((mrow >> 8) * 1024 + 8 * cgp)) * 256 + (mrow & 255);
#pragma unroll
            for (int e = 0; e < 4; ++e) { p[(2 * e) * 256] = (bf16_t)(w[e] & 0xffffu); p[(2 * e + 1) * 256] = (bf16_t)(w[e] >> 16); } }
    }
    SYNC(2);

    if (IN(3)) {
        const bf16_t* WSTRIL = (const bf16_t*)(ws + WS_WSTRIL);
        for (int un = blockIdx.x; un < 1024; un += G) {
            const int chunk = un >> 3, g = un & 7; const size_t tokbase = (size_t)chunk * 128;
            LAS bf16_t* vT = (LAS bf16_t*)lds;
#pragma unroll
            for (int i = 0; i < 4; ++i) { const int p = tid + 512 * i, s = p >> 4, c0 = (p & 15) * 8; const u32x4 w = *(const u32x4*)(Z + (tokbase + s) * ZC + C_V + g * 128 + c0);
#pragma unroll
                for (int e = 0; e < 4; ++e) { vT[(c0 + 2 * e) * 136 + s] = (bf16_t)(w[e] & 0xffffu); vT[(c0 + 2 * e + 1) * 136 + s] = (bf16_t)(w[e] >> 16); } }
            __syncthreads();
            const int j = lane & 15, q4 = lane >> 4, t = 16 * wid + j;
            f32x4 acc[8];
#pragma unroll
            for (int it = 0; it < 8; ++it) acc[it] = (f32x4){0.f, 0.f, 0.f, 0.f};
            const int nks = (16 * wid + 15) / 32 + 1;
            for (int ks = 0; ks < nks; ++ks) { const bf16x8 wf = *(const bf16x8*)(WSTRIL + (size_t)g * 16384 + t * 128 + 32 * ks + 8 * q4);
#pragma unroll
                for (int it = 0; it < 8; ++it) { const bf16x8 vf = *(const LAS bf16x8*)(vT + (16 * it + j) * 136 + 32 * ks + 8 * q4); acc[it] = MFMA16(vf, wf, acc[it]); } }
            const float bsv = a.in[9][g * 128 + t]; bf16_t* zr = Z + (tokbase + t) * ZC;
#pragma unroll
            for (int it = 0; it < 8; ++it) { const int c = g * 128 + 16 * it + 4 * q4; const u32x2 uw = *(const u32x2*)(zr + C_U + c), gaw = *(const u32x2*)(zr + C_GA + c);
                const float u0 = bflo(uw.x), u1 = bfhi(uw.x), u2 = bflo(uw.y), u3 = bfhi(uw.y), g0 = bflo(gaw.x), g1 = bfhi(gaw.x), g2 = bflo(gaw.y), g3 = bfhi(gaw.y);
                u32x2 o; o.x = pk2(gelu_t(u0) * (acc[it][0] + bsv) * sigm(g0), gelu_t(u1) * (acc[it][1] + bsv) * sigm(g1)); o.y = pk2(gelu_t(u2) * (acc[it][2] + bsv) * sigm(g2), gelu_t(u3) * (acc[it][3] + bsv) * sigm(g3));
                *(u32x2*)(zr + C_U + c) = o; }
            __syncthreads();
        }
        { pg8::Gemm g{(const bf16_t*)(ws + WS_KCMPT), (const bf16_t*)(dout + DO_W1KT), 4096, 256, 2048, 1024}; pg8::StaticOrder So; So.init(4096, 256, G, (int)blockIdx.x);
          pg8::EpiBf16<2> E{(bf16_t*)(ws + WS_HDNK), 256, (const float*)(ws + WS_C1), 1.f}; pg8::gemm_phase<pg8::EpiBf16<2>, pg8::StaticOrder, true>(lds, g, So, E); }
        { pg8::Gemm g{(const bf16_t*)(ws + WS_VCMPT), (const bf16_t*)(dout + DO_W1VT), 4096, 256, 2048, 1024}; pg8::StaticOrder So; So.init(4096, 256, G, (G - 1) - (int)blockIdx.x);
          pg8::EpiBf16<2> E{(bf16_t*)(ws + WS_HDNV), 256, (const float*)(ws + WS_C1) + 256, 1.f}; pg8::gemm_phase<pg8::EpiBf16<2>, pg8::StaticOrder, true>(lds, g, So, E); }
    }
    SYNC(3);

    if (IN(4)) {
        for (int u = gw; u < 512; u += NGW) {
            const int mat = u >> 8, r0 = (u & 255) * 16, j = lane & 15, q4 = lane >> 4;
            const bf16_t* HDN = (const bf16_t*)(ws + (mat ? WS_HDNV : WS_HDNK)); const bf16_t* W2T = (const bf16_t*)(ws + (mat ? WS_W2VT : WS_W2KT)); const float* b2 = a.in[mat ? 19 : 14];
            f32x4 acc[4];
#pragma unroll
            for (int it = 0; it < 4; ++it) acc[it] = (f32x4){0.f, 0.f, 0.f, 0.f};
#pragma unroll
            for (int ks = 0; ks < 8; ++ks) { const bf16x8 hb = *(const bf16x8*)(HDN + (size_t)(r0 + j) * 256 + 32 * ks + 8 * q4);
#pragma unroll
                for (int it = 0; it < 4; ++it) { const bf16x8 wf = *(const bf16x8*)(W2T + (16 * it + j) * 256 + 32 * ks + 8 * q4); acc[it] = MFMA16(wf, hb, acc[it]); } }
            const int r = r0 + j, bh = r >> 9, n = r & 511, b = bh >> 2;
#pragma unroll
            for (int it = 0; it < 4; ++it) { const f32x4 bv = *(const f32x4*)(b2 + 16 * it + 4 * q4); acc[it] = acc[it] + bv; }
            if (mat == 0) {
                const int pt = 16 * n + 31; const float* rt = ROPE + (size_t)(b * 8192 + (pt < 8192 ? pt : 8191)) * 16;
#pragma unroll
                for (int e = 0; e < 4; ++e) { const float x = acc[0][e], other = __shfl_xor(x, 32); const int fi = 4 * (q4 & 1) + e; const float c = rt[fi], sn = rt[8 + fi];
                    acc[0][e] = (q4 < 2) ? (x * c - other * sn) : (x * c + other * sn); }
#pragma unroll
                for (int it = 0; it < 4; ++it) { u32x2 o; o.x = pk2(acc[it][0], acc[it][1]); o.y = pk2(acc[it][2], acc[it][3]); if (n == 511) { o.x = 0u; o.y = 0u; }
                    *(u32x2*)((bf16_t*)(ws + WS_KC) + (size_t)r * 64 + 16 * it + 4 * q4) = o; }
            } else {
#pragma unroll
                for (int it = 0; it < 4; ++it)
#pragma unroll
                    for (int e = 0; e < 4; ++e) ((bf16_t*)(ws + WS_VCT))[((size_t)bh * 64 + 16 * it + 4 * q4 + e) * 512 + n] = (bf16_t)(n == 511 ? 0u : f2bf(acc[it][e]));
            }
        }
    }
    SYNC(4);

    if (IN(5)) {
        const bf16_t* KC = (const bf16_t*)(ws + WS_KC); const bf16_t* VCT = (const bf16_t*)(ws + WS_VCT); const bf16_t* VSLCT = (const bf16_t*)(ws + WS_VSLCT); const bf16_t* VWINT = (const bf16_t*)(ws + WS_VWINT);
        bf16_t* MIX = (bf16_t*)(dout + DO_MIX);
        LAS float* wl = (LAS float*)(lds + wid * 4352);
        const int j = lane & 15, q4 = lane >> 4, tk = j >> 2, hd = j & 3;
        for (int rd = 0; rd < 8; ++rd) {
            const int uu = gw + rd * NGW; if (uu >= 16384) break;
            const int bhu = uu >> 11; int tg = uu & 2047; if (rd & 1) tg = 2047 - tg;
            const int b = bhu >> 2, kvh = bhu & 3, t0 = 4 * tg, t = t0 + tk; const size_t tok = (size_t)b * S + t, bh = (size_t)bhu;
            const bf16_t* zr = Z + tok * ZC; const int head = kvh * 4 + hd;
            const bf16x8 qf0 = *(const bf16x8*)(zr + C_Q + head * 64 + 8 * q4), qf1 = *(const bf16x8*)(zr + C_Q + head * 64 + 32 + 8 * q4);
            for (int i = lane; i < 1040; i += 64) wl[i] = 0.f;
            const float gcm = sigm(bf1(zr[C_GN + head * 3 + 0])), gsl = sigm(bf1(zr[C_GN + head * 3 + 1])), gwn = sigm(bf1(zr[C_GN + head * 3 + 2]));
            f32x4 yb[4];
#pragma unroll
            for (int dt = 0; dt < 4; ++dt) yb[dt] = (f32x4){0.f, 0.f, 0.f, 0.f};
            const int ncmax = (t0 + 3 >= 31) ? (((t0 + 3 - 31) >> 4) + 1) : 0;
            const int nvalid = (t >= 31) ? (((t - 31) >> 4) + 1) : 0;
            {
                float m = -1e30f, l = 0.f;
                for (int kb = 0; kb < ncmax; kb += 32) { f32x4 s0, s1; qk32(KC + (bh * 512 + kb + j) * 64 + 8 * q4, 16 * 64, qf0, qf1, s0, s1);
                    float mx = -1e30f;
#pragma unroll
                    for (int e = 0; e < 4; ++e) { if (kb + 4 * q4 + e < nvalid) mx = fmaxf(mx, s0[e]); if (kb + 16 + 4 * q4 + e < nvalid) mx = fmaxf(mx, s1[e]); }
                    mx = fmaxf(mx, __shfl_xor(mx, 16)); mx = fmaxf(mx, __shfl_xor(mx, 32));
                    const float mn = fmaxf(m, mx); float ps = 0.f;
#pragma unroll
                    for (int e = 0; e < 4; ++e) { if (kb + 4 * q4 + e < nvalid) ps += __builtin_amdgcn_exp2f(s0[e] - mn); if (kb + 16 + 4 * q4 + e < nvalid) ps += __builtin_amdgcn_exp2f(s1[e] - mn); }
                    l = l * __builtin_amdgcn_exp2f(m - mn) + ps; m = mn; }
                l += __shfl_xor(l, 16); l += __shfl_xor(l, 32);
                const float invl = l > 0.f ? 1.f / l : 0.f;
                f32x4 o[4];
#pragma unroll
                for (int dt = 0; dt < 4; ++dt) o[dt] = (f32x4){0.f, 0.f, 0.f, 0.f};
                for (int kb = 0; kb < ncmax; kb += 32) { f32x4 s0, s1; qk32(KC + (bh * 512 + kb + j) * 64 + 8 * q4, 16 * 64, qf0, qf1, s0, s1);
                    float p[8];
#pragma unroll
                    for (int e = 0; e < 4; ++e) { p[e] = (kb + 4 * q4 + e < nvalid) ? __builtin_amdgcn_exp2f(s0[e] - m) * invl : 0.f; p[4 + e] = (kb + 16 + 4 * q4 + e < nvalid) ? __builtin_amdgcn_exp2f(s1[e] - m) * invl : 0.f; }
                    float a0 = (p[0] + p[1]) + (p[2] + p[3]), a1 = (p[4] + p[5]) + (p[6] + p[7]), x0 = p[3], x1 = p[7];
                    a0 += __shfl_xor(a0, 1); a0 += __shfl_xor(a0, 2); a1 += __shfl_xor(a1, 1); a1 += __shfl_xor(a1, 2);
                    x0 += __shfl_xor(x0, 1); x0 += __shfl_xor(x0, 2); x1 += __shfl_xor(x1, 1); x1 += __shfl_xor(x1, 2);
                    if (hd == 0) { const int jj0 = (kb >> 2) + q4, jj1 = jj0 + 4; wl[tk * 128 + jj0] = a0; wl[tk * 128 + jj1] = a1; wl[512 + tk * 132 + jj0 + 1] = x0; wl[512 + tk * 132 + jj1 + 1] = x1; }
                    pv32(VCT + (bh * 64 + j) * 512 + kb + 4 * q4, 16 * 512, pack_p(p), o); }
#pragma unroll
                for (int dt = 0; dt < 4; ++dt) yb[dt] = yb[dt] + o[dt] * gcm;
            }
            LDS_WAIT();
            unsigned mysel[4], um[4];
            {
                const int tk2 = lane >> 4, r = lane & 15, cur = t0 >> 6;
                float val[8];
#pragma unroll
                for (int mm = 0; mm < 8; ++mm) { const int jj = r + 16 * mm; const float pvv = wl[tk2 * 128 + jj] + wl[512 + tk2 * 132 + jj];
                    const bool forced = (jj == 0) | (jj == cur) | (jj == cur - 1);
                    val[mm] = forced ? __builtin_inff() : (jj <= cur ? pvv : -__builtin_inff()); }
                LDS_WAIT();
#pragma unroll
                for (int mm = 0; mm < 8; ++mm) wl[tk2 * 128 + r + 16 * mm] = val[mm];
                LDS_WAIT();
                int rank[8];
#pragma unroll
                for (int mm = 0; mm < 8; ++mm) rank[mm] = 0;
                for (int jp = 0; jp <= cur; ++jp) { const float vp = wl[tk2 * 128 + jp];
#pragma unroll
                    for (int mm = 0; mm < 8; ++mm) rank[mm] += ((vp > val[mm]) || (vp == val[mm] && jp < r + 16 * mm)) ? 1 : 0; }
                unsigned long long bm[8];
#pragma unroll
                for (int mm = 0; mm < 8; ++mm) bm[mm] = __ballot((r + 16 * mm <= cur) && rank[mm] < 16);
#pragma unroll
                for (int w = 0; w < 4; ++w) { const unsigned long long b0 = bm[2 * w], b1 = bm[2 * w + 1];
                    mysel[w] = (unsigned)((b0 >> (16 * tk)) & 0xFFFFull) | ((unsigned)((b1 >> (16 * tk)) & 0xFFFFull) << 16);
                    const unsigned u0 = (unsigned)((b0 | (b0 >> 16) | (b0 >> 32) | (b0 >> 48)) & 0xFFFFull), u1 = (unsigned)((b1 | (b1 >> 16) | (b1 >> 32) | (b1 >> 48)) & 0xFFFFull);
                    um[w] = u0 | (u1 << 16); }
                LDS_WAIT();
            }
            {
                float m = -1e30f, l = 0.f; f32x4 o[4];
#pragma unroll
                for (int dt = 0; dt < 4; ++dt) o[dt] = (f32x4){0.f, 0.f, 0.f, 0.f};
#pragma unroll
                for (int w = 0; w < 4; ++w) { unsigned bits = (unsigned)__builtin_amdgcn_readfirstlane((int)um[w]);
                    while (bits) { const int bit = __builtin_ctz(bits); bits &= bits - 1u; const int jj = 32 * w + bit; const bool mine = (mysel[w] >> bit) & 1u;
#pragma unroll
                        for (int hf = 0; hf < 2; ++hf) { const int kb = 64 * jj + 32 * hf; f32x4 s0, s1;
                            qk32(Z + ((size_t)b * S + kb + j) * ZC + C_KSLC + kvh * 64 + 8 * q4, (size_t)16 * ZC, qf0, qf1, s0, s1);
                            unsigned vm = 0u;
#pragma unroll
                            for (int e = 0; e < 4; ++e) { vm |= (mine && (kb + 4 * q4 + e <= t)) ? (1u << e) : 0u; vm |= (mine && (kb + 16 + 4 * q4 + e <= t)) ? (1u << (4 + e)) : 0u; }
                            const bf16x8 pb = osm_step(s0, s1, vm, m, l, o);
                            pv32(VSLCT + (bh * 64 + j) * 8192 + kb + 4 * q4, (size_t)16 * 8192, pb, o); } } }
                l += __shfl_xor(l, 16); l += __shfl_xor(l, 32); const float sc = (l > 0.f ? 1.f / l : 0.f) * gsl;
#pragma unroll
                for (int dt = 0; dt < 4; ++dt) yb[dt] = yb[dt] + o[dt] * sc;
            }
            {
                float m = -1e30f, l = 0.f; f32x4 o[4];
#pragma unroll
                for (int dt = 0; dt < 4; ++dt) o[dt] = (f32x4){0.f, 0.f, 0.f, 0.f};
                const int kmin = (t0 - 511 > 0) ? (t0 - 511) : 0;
                for (int kb = kmin & ~31; kb <= t0 + 3; kb += 32) { f32x4 s0, s1;
                    qk32(Z + ((size_t)b * S + kb + j) * ZC + C_KWIN + kvh * 64 + 8 * q4, (size_t)16 * ZC, qf0, qf1, s0, s1);
                    unsigned vm = 0u;
#pragma unroll
                    for (int e = 0; e < 4; ++e) { const int k0 = kb + 4 * q4 + e, k1 = k0 + 16; vm |= (k0 <= t && k0 > t - 512) ? (1u << e) : 0u; vm |= (k1 <= t && k1 > t - 512) ? (1u << (4 + e)) : 0u; }
                    const bf16x8 pb = osm_step(s0, s1, vm, m, l, o);
                    pv32(VWINT + (bh * 64 + j) * 8192 + kb + 4 * q4, (size_t)16 * 8192, pb, o); }
                l += __shfl_xor(l, 16); l += __shfl_xor(l, 32); const float sc = (l > 0.f ? 1.f / l : 0.f) * gwn;
#pragma unroll
                for (int dt = 0; dt < 4; ++dt) yb[dt] = yb[dt] + o[dt] * sc;
            }
#pragma unroll
            for (int dt = 0; dt < 4; ++dt) { const int c = head * 64 + 16 * dt + 4 * q4; const u32x2 mw = *(const u32x2*)(zr + C_U + c), gw2 = *(const u32x2*)(zr + C_GB + c);
                u32x2 o2; o2.x = pk2(bflo(mw.x) + sigm(bflo(gw2.x)) * yb[dt][0], bfhi(mw.x) + sigm(bfhi(gw2.x)) * yb[dt][1]); o2.y = pk2(bflo(mw.y) + sigm(bflo(gw2.y)) * yb[dt][2], bfhi(mw.y) + sigm(bfhi(gw2.y)) * yb[dt][3]);
                *(u32x2*)(MIX + tok * 1024 + c) = o2; }
        }
    }
    SYNC(5);

    if (IN(6)) { pg8::Gemm g{(const bf16_t*)(dout + DO_MIX), (const bf16_t*)(ws + WS_WOUT_T), T, D, D, D}; pg8::StaticOrder So; So.init(T, D, G, (int)blockIdx.x);
        pg8::EpiF32 E{(float*)(ws + WS_ACCF), D}; pg8::gemm_phase<pg8::EpiF32, pg8::StaticOrder, true>(lds, g, So, E); }
    SYNC(6);

    if (IN(7)) {
        for (int m = gw; m < T; m += NGW) { f32x4 v[4], ac[4]; row_load(v, a.in[0] + (size_t)m * D, lane); row_load(ac, (const float*)(ws + WS_ACCF) + (size_t)m * D, lane); ln_apply(v, a.in[3], a.in[4], lane);
#pragma unroll
            for (int jx = 0; jx < 4; ++jx) v[jx] = v[jx] * ALPHA + ac[jx];
            ln_apply(v, a.in[21], a.in[22], lane); row_store_f32(v, (float*)(ws + WS_HF) + (size_t)m * D, lane); row_store_bf16(v, (bf16_t*)(ws + WS_HB) + (size_t)m * D, lane); }
        LAS float* scr = (LAS float*)(lds + wid * 8448);
        constexpr int I_SQ = 16 * 32, I_F1 = 16 * 128, I_F2 = 64 * 32;
        for (int it = gw; it < 2 * I_SQ + I_F1 + I_F2; it += NGW) { int r = it;
            if (r < I_SQ) { tr_item(a.in[23], 1024, 1024, 1024, (bf16_t*)(ws + WS_WXQ_T), scr, r, lane); continue; } r -= I_SQ;
            if (r < I_SQ) { tr_item(a.in[25], 1024, 1024, 1024, (bf16_t*)(ws + WS_WXO_T), scr, r, lane); continue; } r -= I_SQ;
            if (r < I_F1) { tr_item(a.in[28], 1024, 4096, 4096, (bf16_t*)(ws + WS_WFF1_T), scr, r, lane); continue; } r -= I_F1;
            tr_item(a.in[29], 4096, 1024, 1024, (bf16_t*)(ws + WS_WFF2_T), scr, r, lane); }
    }
    SYNC(7);

    if (IN(8)) { pg8::Gemm g{(const bf16_t*)(ws + WS_HB), (const bf16_t*)(ws + WS_WXQ_T), T, D, D, D}; pg8::StaticOrder So; So.init(T, D, G, (int)blockIdx.x);
        pg8::EpiBf16<0> E{(bf16_t*)(ws + WS_XQ), D, nullptr, XSCALE}; pg8::gemm_phase<pg8::EpiBf16<0>, pg8::StaticOrder, true>(lds, g, So, E); }
    SYNC(8);

    if (IN(9)) {
        const bf16_t* XQ = (const bf16_t*)(ws + WS_XQ); const bf16_t* XKV = (const bf16_t*)(dout + DO_XKV); const bf16_t* XVT = (const bf16_t*)(dout + DO_XVT); bf16_t* XO = (bf16_t*)(ws + WS_XO);
        const int j = lane & 15, q4 = lane >> 4;
        for (int u = gw; u < 4096; u += NGW) { const int hx = u & 3, tok0 = (u >> 2) * 16, b = tok0 >> 13;
            bf16x8 qf[8];
#pragma unroll
            for (int ks = 0; ks < 8; ++ks) qf[ks] = *(const bf16x8*)(XQ + (size_t)(tok0 + j) * 1024 + hx * 256 + 32 * ks + 8 * q4);
            f32x4 s[16];
#pragma unroll
            for (int kt = 0; kt < 16; ++kt) { const bf16_t* kp = XKV + (size_t)(b * 256 + 16 * kt + j) * 2048 + hx * 256 + 8 * q4; s[kt] = (f32x4){0.f, 0.f, 0.f, 0.f};
#pragma unroll
                for (int ks = 0; ks < 8; ++ks) s[kt] = MFMA16(*(const bf16x8*)(kp + 32 * ks), qf[ks], s[kt]); }
            float mx = -1e30f;
#pragma unroll
            for (int kt = 0; kt < 16; ++kt) mx = fmaxf(fmaxf(mx, fmaxf(s[kt][0], s[kt][1])), fmaxf(s[kt][2], s[kt][3]));
            mx = fmaxf(mx, __shfl_xor(mx, 16)); mx = fmaxf(mx, __shfl_xor(mx, 32));
            float l = 0.f; bf16x8 pf[8];
#pragma unroll
            for (int kk = 0; kk < 8; ++kk) { float p[8];
#pragma unroll
                for (int e = 0; e < 4; ++e) { p[e] = __builtin_amdgcn_exp2f(s[2 * kk][e] - mx); p[4 + e] = __builtin_amdgcn_exp2f(s[2 * kk + 1][e] - mx); l += p[e] + p[4 + e]; }
                pf[kk] = pack_p(p); }
            l += __shfl_xor(l, 16); l += __shfl_xor(l, 32); const float invl = 1.f / l;
#pragma unroll 2
            for (int dt = 0; dt < 16; ++dt) { f32x4 o = {0.f, 0.f, 0.f, 0.f}; const bf16_t* vp = XVT + (size_t)(b * 1024 + hx * 256 + 16 * dt + j) * 256 + 4 * q4;
#pragma unroll
                for (int kk = 0; kk < 8; ++kk) { const u32x2 vlo = *(const u32x2*)(vp + 32 * kk), vhi = *(const u32x2*)(vp + 32 * kk + 16); u32x4 w; w.x = vlo.x; w.y = vlo.y; w.z = vhi.x; w.w = vhi.y;
                    o = MFMA16(__builtin_bit_cast(bf16x8, w), pf[kk], o); }
                u32x2 ow; ow.x = pk2(o[0] * invl, o[1] * invl); ow.y = pk2(o[2] * invl, o[3] * invl);
                *(u32x2*)(XO + (size_t)(tok0 + j) * 1024 + hx * 256 + 16 * dt + 4 * q4) = ow; }
        }
    }
    SYNC(9);

    if (IN(10)) { pg8::Gemm g{(const bf16_t*)(ws + WS_XO), (const bf16_t*)(ws + WS_WXO_T), T, D, D, D}; pg8::StaticOrder So; So.init(T, D, G, (int)blockIdx.x);
        pg8::EpiF32 E{(float*)(ws + WS_ACCF), D}; pg8::gemm_phase<pg8::EpiF32, pg8::StaticOrder, true>(lds, g, So, E); }
    SYNC(10);

    if (IN(11)) {
        for (int m = gw; m < T; m += NGW) { f32x4 v[4], ac[4]; row_load(v, (const float*)(ws + WS_HF) + (size_t)m * D, lane); row_load(ac, (const float*)(ws + WS_ACCF) + (size_t)m * D, lane);
#pragma unroll
            for (int jx = 0; jx < 4; ++jx) v[jx] = v[jx] * ALPHA + ac[jx];
            ln_apply(v, a.in[26], a.in[27], lane); row_store_f32(v, (float*)(ws + WS_HF) + (size_t)m * D, lane); row_store_bf16(v, (bf16_t*)(ws + WS_HB) + (size_t)m * D, lane); }
    }
    SYNC(11);

    if (IN(12)) { pg8::Gemm g{(const bf16_t*)(ws + WS_HB), (const bf16_t*)(ws + WS_WFF1_T), T, FF, D, D}; pg8::StaticOrder So; So.init(T, FF, G, (int)blockIdx.x);
        pg8::EpiBf16<3> E{(bf16_t*)(ws + WS_FFB), FF, nullptr, 1.f}; pg8::gemm_phase<pg8::EpiBf16<3>, pg8::StaticOrder, true>(lds, g, So, E); }
    SYNC(12);

    if (IN(13)) { pg8::Gemm g{(const bf16_t*)(ws + WS_FFB), (const bf16_t*)(ws + WS_WFF2_T), T, D, FF, FF}; pg8::StaticOrder So; So.init(T, D, G, (int)blockIdx.x);
        pg8::EpiF32 E{a.out, D}; pg8::gemm_phase<pg8::EpiF32, pg8::StaticOrder, true>(lds, g, So, E); }
    SYNC(13);

    if (IN(14)) {
        for (int m = gw; m < T; m += NGW) { f32x4 v[4], ac[4]; row_load(v, (const float*)(ws + WS_HF) + (size_t)m * D, lane); row_load(ac, a.out + (size_t)m * D, lane);
#pragma unroll
            for (int jx = 0; jx < 4; ++jx) v[jx] = v[jx] * ALPHA + ac[jx];
            ln_apply(v, a.in[30], a.in[31], lane); row_store_f32(v, a.out + (size_t)m * D, lane); }
    }
#undef IN
#undef SYNC
}

constexpr int NPHASE = 15;
extern "C" void kernel_launch(void* const* d_in, const int* in_sizes, int n_in, void* d_out, int out_size, void* d_ws, size_t ws_size, hipStream_t stream) {
    static int grid = 0;
    if (grid == 0) {
        if (n_in != 32 || out_size != T * D || ws_size < 256 * MiB) { fprintf(stderr, "kernel_launch: unexpected shapes (n_in %d out %d ws %zu)\n", n_in, out_size, ws_size); grid = -1; return; }
        int dev = 0, cus = 0, per_cu = 0;
        hipGetDevice(&dev); hipDeviceGetAttribute(&cus, hipDeviceAttributeMultiprocessorCount, dev);
        hipFuncSetAttribute((const void*)mk_fwd, hipFuncAttributeMaxDynamicSharedMemorySize, LDS_BYTES);
        hipOccupancyMaxActiveBlocksPerMultiprocessor(&per_cu, (const void*)mk_fwd, 512, LDS_BYTES);
        (void)hipGetLastError();
        if (per_cu < 1) fprintf(stderr, "kernel_launch: occupancy query says %d blocks per CU\n", per_cu);
        grid = cus > 0 ? cus : 256;
    }
    if (grid < 0) return;
    Args a{};
    for (int i = 0; i < 32; ++i) a.in[i] = (const float*)d_in[i];
    a.out = (float*)d_out; a.ws = (unsigned char*)d_ws; a.ph_lo = 0; a.ph_hi = NPHASE;
    void* args[] = {&a};
    hipError_t e = hipLaunchCooperativeKernel((const void*)mk_fwd, dim3(grid), dim3(512), args, LDS_BYTES, stream);
    if (e != hipSuccess) fprintf(stderr, "cooperative launch failed: %s (grid %d)\n", hipGetErrorString(e), grid);
}
```

```cpp
#include <hip/hip_runtime.h>
#include <hip/hip_cooperative_groups.h>
#include <cstdio>
#include <cstdint>
namespace cg = cooperative_groups;

#define LAS __attribute__((address_space(3)))
typedef unsigned short bf16_t;
typedef short bf16x8 __attribute__((ext_vector_type(8)));
typedef float f32x4 __attribute__((ext_vector_type(4)));
typedef float f32x2 __attribute__((ext_vector_type(2)));
typedef unsigned u32x4 __attribute__((ext_vector_type(4)));
typedef unsigned u32x2 __attribute__((ext_vector_type(2)));

__device__ __forceinline__ unsigned f2bf(float f) { unsigned u = __builtin_bit_cast(unsigned, f); return (u + 0x7fffu + ((u >> 16) & 1u)) >> 16; }
__device__ __forceinline__ unsigned pk2(float lo, float hi) { return f2bf(lo) | (f2bf(hi) << 16); }
__device__ __forceinline__ float bflo(unsigned w) { return __builtin_bit_cast(float, w << 16); }
__device__ __forceinline__ float bfhi(unsigned w) { return __builtin_bit_cast(float, w & 0xffff0000u); }
__device__ __forceinline__ float bf1(bf16_t h) { return __builtin_bit_cast(float, ((unsigned)h) << 16); }
__device__ __forceinline__ float gelu_t(float x) { const float u = x * (1.f + 0.044715f * x * x); const float e = __builtin_amdgcn_exp2f(-2.3022081986f * u); return x * __builtin_amdgcn_rcpf(1.f + e); }
__device__ __forceinline__ float sigm(float x) { return __builtin_amdgcn_rcpf(1.f + __builtin_amdgcn_exp2f(-1.4426950409f * x)); }
__device__ __forceinline__ float wave_sum(float v) {
#pragma unroll
    for (int o = 1; o < 64; o <<= 1) v += __shfl_xor(v, o);
    return v;
}
#define LDS_WAIT() asm volatile("s_waitcnt lgkmcnt(0)" ::: "memory")

namespace pg8 {
constexpr int BM = 256, BK = 64, HALF = 128, HTB = HALF * BK * 2, STAGE_BYTES = 8 * HTB, NXCD = 8, WGM = 8;
__host__ __device__ __forceinline__ int lds_byte(int r, int c) { const int st = (r >> 4) * 2 + (c >> 5), rr = r & 15, cc = c & 31, ob = rr * 64 + cc * 2; return st * 1024 + (ob ^ (((ob >> 9) & 1) << 5)); }
__host__ __device__ __forceinline__ void stage_rc(int b, int& R, int& C) { const int st = b / 1024, sb = b % 1024, swz = sb ^ (((sb >> 9) & 1) << 5); R = (st >> 1) * 16 + swz / 64; C = (st & 1) * 32 + (swz % 64) / 2; }
__host__ __device__ __forceinline__ int perm32(int rho) { const int n = rho >> 4, i = rho & 15; return 8 * (i >> 2) + 4 * n + (i & 3); }
struct Unit { int pm, pn; };
struct Gemm { const bf16_t* A; const bf16_t* Bt; int M, N, K, lda; };
struct StaticOrder {
    int nM, nN, nwg, G, c;
    __device__ void init(int M, int N, int G_, int c_) { nM = M / BM; nN = N / BM; nwg = nM * nN; G = G_; c = c_; }
    __device__ bool next(int i, Unit& u) const {
        const long L = (long)i * G + c; if (L >= nwg) return false;
        int wgid = (int)L; { const int q = nwg / NXCD, r = nwg % NXCD, xcd = wgid % NXCD, off = wgid / NXCD; wgid = (xcd < r ? xcd * (q + 1) : r * (q + 1) + (xcd - r) * q) + off; }
        const int nig = WGM * nN, gid = wgid / nig, fm = gid * WGM, gsz = (nM - fm) < WGM ? (nM - fm) : WGM;
        u.pm = fm + ((wgid % nig) % gsz); u.pn = (wgid % nig) / gsz; return true;
    }
};
__device__ __forceinline__ unsigned cvt_pk_bf16(float lo, float hi) { unsigned r; asm volatile("v_cvt_pk_bf16_f32 %0, %1, %2" : "=v"(r) : "v"(lo), "v"(hi)); return r; }

template <int ACT> struct EpiBf16 {
    static constexpr bool PERM = true;
    bf16_t* O; int ldc; const float* bias; float scale;
    __device__ __forceinline__ void operator()(const f32x4 (&acc)[2][2][4][2], const Unit& u, int wr, int wc, int fr, int fq) const {
        const int row0 = u.pm * BM + wr * 64 + fr; const int col0 = u.pn * BM + wc * 32 + 8 * fq;
        f32x4 bv[2][2];
#pragma unroll
        for (int bj = 0; bj < 2; ++bj)
#pragma unroll
            for (int n = 0; n < 2; ++n) bv[bj][n] = bias ? *(const f32x4*)(bias + col0 + bj * HALF + 4 * n) : (f32x4){0.f, 0.f, 0.f, 0.f};
#pragma unroll
        for (int ai = 0; ai < 2; ++ai)
#pragma unroll
            for (int m = 0; m < 4; ++m) { bf16_t* rowp = O + (size_t)(row0 + ai * HALF + m * 16) * ldc + col0;
#pragma unroll
                for (int bj = 0; bj < 2; ++bj) { f32x4 v0 = acc[ai][bj][m][0] + bv[bj][0], v1 = acc[ai][bj][m][1] + bv[bj][1];
                    if (ACT == 2) {
#pragma unroll
                        for (int e = 0; e < 4; ++e) { v0[e] = gelu_t(v0[e]); v1[e] = gelu_t(v1[e]); } }
                    if (ACT == 3) {
#pragma unroll
                        for (int e = 0; e < 4; ++e) { float a0 = v0[e] > 0.f ? v0[e] : 0.f, a1 = v1[e] > 0.f ? v1[e] : 0.f; v0[e] = a0 * a0; v1[e] = a1 * a1; } }
                    v0 = v0 * scale; v1 = v1 * scale; u32x4 w; w.x = cvt_pk_bf16(v0[0], v0[1]); w.y = cvt_pk_bf16(v0[2], v0[3]); w.z = cvt_pk_bf16(v1[0], v1[1]); w.w = cvt_pk_bf16(v1[2], v1[3]);
                    *(u32x4*)(rowp + bj * HALF) = w; } }
    }
};
struct EpiF32 {
    static constexpr bool PERM = false;
    float* O; int ldc;
    __device__ __forceinline__ void operator()(const f32x4 (&acc)[2][2][4][2], const Unit& u, int wr, int wc, int fr, int fq) const {
        const int row0 = u.pm * BM + wr * 64 + fr; const int col0 = u.pn * BM + wc * 32 + 4 * fq;
#pragma unroll
        for (int ai = 0; ai < 2; ++ai)
#pragma unroll
            for (int m = 0; m < 4; ++m) { float* rowp = O + (size_t)(row0 + ai * HALF + m * 16) * ldc + col0;
#pragma unroll
                for (int bj = 0; bj < 2; ++bj)
#pragma unroll
                    for (int n = 0; n < 2; ++n) *(f32x4*)(rowp + bj * HALF + n * 16) = acc[ai][bj][m][n]; }
    }
};

template <class Epi, class Sched, bool ALIGN_EPI>
__device__ __forceinline__ void gemm_phase(LAS unsigned char* lds, const Gemm g, const Sched& S, const Epi& E) {
    const int tid = threadIdx.x, wid = __builtin_amdgcn_readfirstlane(tid >> 6), lane = tid & 63, wr = wid >> 2, wc = wid & 3, fr = lane & 15, fq = lane >> 4;
    const int K = g.K, nt = K / BK, lda = g.lda;
    unsigned voffA[2], voffB[2];
#pragma unroll
    for (int i = 0; i < 2; ++i) { int R, C; stage_rc(tid * 16 + i * 8192, R, C); const int Rb = Epi::PERM ? ((R & ~31) + perm32(R & 31)) : R;
        voffA[i] = (unsigned)(R * lda + C) * 2u; voffB[i] = (unsigned)(Rb * K + C) * 2u; }
    const size_t kstep = (size_t)(BK * 2);
    const size_t hstepA = (size_t)HALF * lda * 2, hstepB = (size_t)HALF * K * 2;
    const size_t tstepA = 2 * hstepA, tstepB = 2 * hstepB;
    const unsigned ldsw = (unsigned)wid * 1024u;
    const int aoff = lds_byte(wr * 64 + fr, fq * 8), boff = lds_byte(wc * 32 + fr, fq * 8);
#define PG8_SA(b, h) (((b) * 2 + (h)) * HTB)
#define PG8_SB(b, h) ((4 + (b) * 2 + (h)) * HTB)
#define PG8_STAGE(bufoff, gbase, voff) do { _Pragma("unroll") for (int _i = 0; _i < 2; ++_i) \
        __builtin_amdgcn_global_load_lds((const unsigned*)((const char*)(gbase) + (voff)[_i]), (LAS unsigned*)(lds + (bufoff) + ldsw + _i * 8192), 16, 0, 0); } while (0)
#define PG8_LDA(dst, b, h) do { _Pragma("unroll") for (int m = 0; m < 4; ++m) _Pragma("unroll") for (int k = 0; k < 2; ++k) dst[m][k] = *(const LAS bf16x8*)(lds + PG8_SA(b, h) + aoff + m * 2048 + k * 1024); } while (0)
#define PG8_LDB(dst, b, h) do { _Pragma("unroll") for (int n = 0; n < 2; ++n) _Pragma("unroll") for (int k = 0; k < 2; ++k) dst[n][k] = *(const LAS bf16x8*)(lds + PG8_SB(b, h) + boff + n * 2048 + k * 1024); } while (0)
#define PG8_MMA(ai, bj, At, Bt) do { __builtin_amdgcn_s_setprio(1); _Pragma("unroll") for (int m = 0; m < 4; ++m) _Pragma("unroll") for (int n = 0; n < 2; ++n) _Pragma("unroll") for (int k = 0; k < 2; ++k) \
        acc[ai][bj][m][n] = __builtin_amdgcn_mfma_f32_16x16x32_bf16(Bt[n][k], At[m][k], acc[ai][bj][m][n], 0, 0, 0); __builtin_amdgcn_s_setprio(0); } while (0)
#define PG8_WAIT_V(n) asm volatile("s_waitcnt vmcnt(" #n ")" ::: "memory")
#define PG8_WAIT_L(n) asm volatile("s_waitcnt lgkmcnt(" #n ")" ::: "memory")
#define PG8_BAR __builtin_amdgcn_s_barrier()
#define PG8_SCHED __builtin_amdgcn_sched_barrier(0)
    Unit cur, nxt; int ui = 0;
    if (!S.next(0, cur)) return;
    f32x4 acc[2][2][4][2];
#pragma unroll
    for (int a = 0; a < 2; ++a)
#pragma unroll
        for (int b = 0; b < 2; ++b)
#pragma unroll
            for (int m = 0; m < 4; ++m)
#pragma unroll
                for (int n = 0; n < 2; ++n) acc[a][b][m][n] = (f32x4){0.f, 0.f, 0.f, 0.f};
    bf16x8 At[4][2], B0[2][2], B1[2][2];
    const char* cA = (const char*)g.A + (size_t)cur.pm * tstepA; const char* cB = (const char*)g.Bt + (size_t)cur.pn * tstepB;
    PG8_STAGE(PG8_SB(0, 0), cB, voffB); PG8_STAGE(PG8_SB(0, 1), cB + hstepB, voffB); PG8_STAGE(PG8_SA(0, 0), cA, voffA); PG8_STAGE(PG8_SA(0, 1), cA + hstepA, voffA);
    if (wr == 1) PG8_BAR;
    PG8_WAIT_V(2); PG8_BAR;
    PG8_STAGE(PG8_SB(1, 0), cB + kstep, voffB); PG8_STAGE(PG8_SA(1, 0), cA + kstep, voffA); PG8_STAGE(PG8_SB(1, 1), cB + hstepB + kstep, voffB);
    PG8_WAIT_V(6); PG8_BAR;
    for (;;) {
        const bool has_next = S.next(ui + 1, nxt);
        const char* nA = has_next ? (const char*)g.A + (size_t)nxt.pm * tstepA : cA; const char* nB = has_next ? (const char*)g.Bt + (size_t)nxt.pn * tstepB : cB;
        for (int t = 0; t < nt; t += 2) {
            const bool last = (t == nt - 2);
            const char* a1 = cA + (size_t)(t + 1) * kstep;
            const char* a2 = last ? nA : cA + (size_t)(t + 2) * kstep; const char* b2 = last ? nB : cB + (size_t)(t + 2) * kstep;
            const char* a3 = a2 + kstep; const char* b3 = b2 + kstep;
            PG8_LDB(B0, 0, 0); PG8_LDB(B1, 0, 1); PG8_SCHED; PG8_LDA(At, 0, 0); PG8_STAGE(PG8_SA(1, 1), a1 + hstepA, voffA);
            PG8_WAIT_V(8); PG8_WAIT_L(0); PG8_BAR; PG8_MMA(0, 0, At, B0); PG8_MMA(0, 1, At, B1); PG8_BAR; PG8_SCHED;
            PG8_LDA(At, 0, 1); PG8_STAGE(PG8_SB(0, 0), b2, voffB); PG8_STAGE(PG8_SB(0, 1), b2 + hstepB, voffB); PG8_STAGE(PG8_SA(0, 0), a2, voffA);
            PG8_WAIT_V(8); PG8_WAIT_L(0); PG8_BAR; PG8_MMA(1, 0, At, B0); PG8_MMA(1, 1, At, B1); PG8_BAR; PG8_SCHED;
            PG8_LDB(B0, 1, 0); PG8_LDB(B1, 1, 1); PG8_SCHED; PG8_LDA(At, 1, 0); PG8_STAGE(PG8_SA(0, 1), a2 + hstepA, voffA);
            PG8_WAIT_V(8); PG8_WAIT_L(0); PG8_BAR; PG8_MMA(0, 0, At, B0); PG8_MMA(0, 1, At, B1); PG8_BAR; PG8_SCHED;
            PG8_LDA(At, 1, 1); PG8_STAGE(PG8_SB(1, 0), b3, voffB); PG8_STAGE(PG8_SB(1, 1), b3 + hstepB, voffB); PG8_STAGE(PG8_SA(1, 0), a3, voffA);
            PG8_WAIT_V(8); PG8_WAIT_L(0); PG8_BAR; PG8_MMA(1, 0, At, B0); PG8_MMA(1, 1, At, B1); PG8_BAR; PG8_SCHED;
        }
        if constexpr (ALIGN_EPI) { if (wr == 0) PG8_BAR; }
        E(acc, cur, wr, wc, fr, fq);
        if (!has_next) break;
#pragma unroll
        for (int a = 0; a < 2; ++a)
#pragma unroll
            for (int b = 0; b < 2; ++b)
#pragma unroll
                for (int m = 0; m < 4; ++m)
#pragma unroll
                    for (int n = 0; n < 2; ++n) acc[a][b][m][n] = (f32x4){0.f, 0.f, 0.f, 0.f};
        cur = nxt; cA = nA; cB = nB; ++ui;
        if constexpr (ALIGN_EPI) { if (wr == 1) PG8_BAR; }
    }
    PG8_WAIT_V(0);
    if constexpr (!ALIGN_EPI) { if (wr == 0) PG8_BAR; }
    PG8_BAR;
#undef PG8_SA
#undef PG8_SB
#undef PG8_STAGE
#undef PG8_LDA
#undef PG8_LDB
#undef PG8_MMA
#undef PG8_WAIT_V
#undef PG8_WAIT_L
#undef PG8_BAR
#undef PG8_SCHED
}
}

constexpr int NB = 2, S = 8192, D = 1024, T = NB * S, FF = 4096;
constexpr int ZC = 6912;
constexpr int C_U = 0, C_V = 1024, C_Q = 2048, C_KCMP = 3072, C_VCMP = 3328, C_KSLC = 3584, C_VSLC = 3840, C_KWIN = 4096, C_VWIN = 4352, C_GN = 4608, C_GA = 4656, C_GB = 5680;
constexpr float ALPHA = 1.189207115002721f;
constexpr float QSCALE = 0.125f * 1.4426950408889634f;
constexpr float XSCALE = 0.0625f * 1.4426950408889634f;
constexpr float LN_EPS = 1e-5f;
constexpr size_t MiB = 1u << 20;
constexpr size_t WS_Z = 0, WS_KCMPT = 216 * MiB, WS_VCMPT = 224 * MiB, WS_VSLCT = 232 * MiB, WS_VWINT = 240 * MiB, WS_HDNK = 248 * MiB, WS_HDNV = 250 * MiB,
                 WS_KC = 252 * MiB, WS_VCT = 252 * MiB + 512 * 1024, WS_WOUT_T = 253 * MiB, WS_C1 = 255 * MiB, WS_W2KT = 255 * MiB + 4096, WS_W2VT = 255 * MiB + 65536, WS_WSTRIL = 255 * MiB + 131072;
constexpr size_t WS_HF = 0, WS_HB = 64 * MiB, WS_XQ = 96 * MiB, WS_XO = 128 * MiB, WS_ACCF = 160 * MiB, WS_FFB = 96 * MiB,
                 WS_WXQ_T = 224 * MiB, WS_WXO_T = 226 * MiB, WS_WFF1_T = 228 * MiB, WS_WFF2_T = 236 * MiB;
constexpr size_t DO_H0B = 0, DO_MIX = 0, DO_WIN_T = 32 * MiB, DO_WXKV_T = 46 * MiB, DO_MEMB = 50 * MiB, DO_XKV = 51 * MiB, DO_XVT = 53 * MiB, DO_ROPE = 54 * MiB, DO_W1KT = 55 * MiB, DO_W1VT = 56 * MiB;
constexpr int LDS_BYTES = 147456;

struct Args { const float* in[32]; float* out; unsigned char* ws; int ph_lo, ph_hi; };

__device__ __forceinline__ void tr_item(const float* W, int K, int N, int Npad, bf16_t* WT, LAS float* scr, int item, int lane) {
    const int nblk = Npad / 32, kb = item / nblk, nb = item % nblk, k0 = 64 * kb, n0 = 32 * nb;
    const int cc = n0 + (lane & 31);
#pragma unroll 8
    for (int i = 0; i < 32; ++i) { const int kk = 2 * i + (lane >> 5); scr[kk * 33 + (lane & 31)] = (cc < N) ? W[(size_t)(k0 + kk) * N + cc] : 0.f; }
    LDS_WAIT();
    const int c = lane & 7;
#pragma unroll
    for (int j = 0; j < 4; ++j) { const int n = (lane >> 3) + 8 * j; const LAS float* s = scr + (8 * c) * 33 + n;
        u32x4 o; o.x = pk2(s[0 * 33], s[1 * 33]); o.y = pk2(s[2 * 33], s[3 * 33]); o.z = pk2(s[4 * 33], s[5 * 33]); o.w = pk2(s[6 * 33], s[7 * 33]);
        *(u32x4*)(WT + (size_t)(n0 + n) * K + k0 + 8 * c) = o; }
    LDS_WAIT();
}

__device__ __forceinline__ void ln_apply(f32x4 (&v)[4], const float* g, const float* b, int lane) {
    float s = 0.f;
#pragma unroll
    for (int j = 0; j < 4; ++j) s += (v[j].x + v[j].y) + (v[j].z + v[j].w);
    const float mean = wave_sum(s) * (1.f / 1024.f); float s2 = 0.f;
#pragma unroll
    for (int j = 0; j < 4; ++j) { v[j] = v[j] - mean; s2 += (v[j].x * v[j].x + v[j].y * v[j].y) + (v[j].z * v[j].z + v[j].w * v[j].w); }
    const float rstd = 1.f / sqrtf(wave_sum(s2) * (1.f / 1024.f) + LN_EPS);
#pragma unroll
    for (int j = 0; j < 4; ++j) { const f32x4 gg = *(const f32x4*)(g + 4 * lane + 256 * j), bb = *(const f32x4*)(b + 4 * lane + 256 * j); v[j] = v[j] * rstd * gg + bb; }
}
__device__ __forceinline__ void row_load(f32x4 (&v)[4], const float* p, int lane) {
#pragma unroll
    for (int j = 0; j < 4; ++j) v[j] = *(const f32x4*)(p + 4 * lane + 256 * j);
}
__device__ __forceinline__ void row_store_f32(const f32x4 (&v)[4], float* p, int lane) {
#pragma unroll
    for (int j = 0; j < 4; ++j) *(f32x4*)(p + 4 * lane + 256 * j) = v[j];
}
__device__ __forceinline__ void row_store_bf16(const f32x4 (&v)[4], bf16_t* p, int lane) {
#pragma unroll
    for (int j = 0; j < 4; ++j) { u32x2 w; w.x = pk2(v[j].x, v[j].y); w.y = pk2(v[j].z, v[j].w); *(u32x2*)(p + 4 * lane + 256 * j) = w; }
}

#define MFMA16(a, b, c) __builtin_amdgcn_mfma_f32_16x16x32_bf16((a), (b), (c), 0, 0, 0)

__device__ __forceinline__ void qk32(const bf16_t* kp, size_t t1off, bf16x8 qf0, bf16x8 qf1, f32x4& s0, f32x4& s1) {
    const bf16x8 k00 = *(const bf16x8*)(kp), k01 = *(const bf16x8*)(kp + 32), k10 = *(const bf16x8*)(kp + t1off), k11 = *(const bf16x8*)(kp + t1off + 32);
    const f32x4 z = {0.f, 0.f, 0.f, 0.f};
    s0 = MFMA16(k00, qf0, z); s0 = MFMA16(k01, qf1, s0); s1 = MFMA16(k10, qf0, z); s1 = MFMA16(k11, qf1, s1);
}
__device__ __forceinline__ void pv32(const bf16_t* vp, size_t dtoff, bf16x8 pb, f32x4 (&o)[4]) {
#pragma unroll
    for (int dt = 0; dt < 4; ++dt) { const u32x2 lo = *(const u32x2*)(vp + dt * dtoff), hi = *(const u32x2*)(vp + dt * dtoff + 16);
        u32x4 w; w.x = lo.x; w.y = lo.y; w.z = hi.x; w.w = hi.y; o[dt] = MFMA16(__builtin_bit_cast(bf16x8, w), pb, o[dt]); }
}
__device__ __forceinline__ bf16x8 pack_p(const float (&p)[8]) { u32x4 w; w.x = pk2(p[0], p[1]); w.y = pk2(p[2], p[3]); w.z = pk2(p[4], p[5]); w.w = pk2(p[6], p[7]); return __builtin_bit_cast(bf16x8, w); }
__device__ __forceinline__ bf16x8 osm_step(f32x4 s0, f32x4 s1, unsigned vm, float& m, float& l, f32x4 (&o)[4]) {
    float mx = -1e30f;
#pragma unroll
    for (int e = 0; e < 4; ++e) { if ((vm >> e) & 1u) mx = fmaxf(mx, s0[e]); if ((vm >> (4 + e)) & 1u) mx = fmaxf(mx, s1[e]); }
    mx = fmaxf(mx, __shfl_xor(mx, 16)); mx = fmaxf(mx, __shfl_xor(mx, 32));
    const float mn = fmaxf(m, mx), alpha = __builtin_amdgcn_exp2f(m - mn); m = mn;
    float p[8]; float ps = 0.f;
#pragma unroll
    for (int e = 0; e < 4; ++e) { p[e] = ((vm >> e) & 1u) ? __builtin_amdgcn_exp2f(s0[e] - mn) : 0.f; p[4 + e] = ((vm >> (4 + e)) & 1u) ? __builtin_amdgcn_exp2f(s1[e] - mn) : 0.f; ps += p[e] + p[4 + e]; }
    l = l * alpha + ps;
#pragma unroll
    for (int dt = 0; dt < 4; ++dt) o[dt] = o[dt] * alpha;
    return pack_p(p);
}

__global__ void __launch_bounds__(512, 2) mk_fwd(Args a) {
    extern __shared__ __attribute__((aligned(16))) unsigned char lds_raw[];
    LAS unsigned char* lds = (LAS unsigned char*)lds_raw;
    cg::grid_group grid = cg::this_grid();
    const int tid = threadIdx.x, lane = tid & 63, wid = __builtin_amdgcn_readfirstlane(tid >> 6);
    const int G = gridDim.x, gw = blockIdx.x * 8 + wid, NGW = G * 8, gtid = blockIdx.x * 512 + tid, NGT = G * 512;
    unsigned char* ws = a.ws; unsigned char* dout = (unsigned char*)a.out;
    const int lo = a.ph_lo, hi = a.ph_hi;
#define IN(k) (lo <= (k) && (k) < hi)
#define SYNC(k) do { if (IN(k) && IN((k) + 1)) grid.sync(); } while (0)
#ifndef PROBE_PH
#define PROBE_PH -1
#endif
#ifndef PROBE_N
#define PROBE_N 2
#endif
#define RPT(k) for (int rp_ = 0; rp_ < ((k) == PROBE_PH ? PROBE_N : 1); ++rp_, ((k) == PROBE_PH && rp_ < PROBE_N) ? grid.sync() : (void)0)
    bf16_t* const Z = (bf16_t*)(ws + WS_Z);
    float* const ROPE = (float*)(dout + DO_ROPE);

    if (IN(0)) RPT(0) {
        LAS float* scr = (LAS float*)(lds + wid * 8448);
        constexpr int I_WIN = 16 * 216, I_XKV = 16 * 64, I_W1 = 32 * 8, I_W2 = 4 * 2, I_WOUT = 16 * 32;
        constexpr int NIT = I_WIN + I_XKV + 2 * I_W1 + 2 * I_W2 + I_WOUT;
        for (int it = gw; it < NIT; it += NGW) { int r = it;
            if (r < I_WIN) { tr_item(a.in[5], 1024, 6704, 6912, (bf16_t*)(dout + DO_WIN_T), scr, r, lane); continue; } r -= I_WIN;
            if (r < I_XKV) { tr_item(a.in[24], 1024, 2048, 2048, (bf16_t*)(dout + DO_WXKV_T), scr, r, lane); continue; } r -= I_XKV;
            if (r < I_W1) { tr_item(a.in[11], 2048, 256, 256, (bf16_t*)(dout + DO_W1KT), scr, r, lane); continue; } r -= I_W1;
            if (r < I_W1) { tr_item(a.in[16], 2048, 256, 256, (bf16_t*)(dout + DO_W1VT), scr, r, lane); continue; } r -= I_W1;
            if (r < I_W2) { tr_item(a.in[13], 256, 64, 64, (bf16_t*)(ws + WS_W2KT), scr, r, lane); continue; } r -= I_W2;
            if (r < I_W2) { tr_item(a.in[18], 256, 64, 64, (bf16_t*)(ws + WS_W2VT), scr, r, lane); continue; } r -= I_W2;
            tr_item(a.in[20], 1024, 1024, 1024, (bf16_t*)(ws + WS_WOUT_T), scr, r, lane);
        }
        for (int m = gw; m < T; m += NGW) { f32x4 v[4]; row_load(v, a.in[0] + (size_t)m * D, lane); ln_apply(v, a.in[3], a.in[4], lane); row_store_bf16(v, (bf16_t*)(dout + DO_H0B) + (size_t)m * D, lane); }
        for (int i = gtid; i < 512 * 1024 / 4; i += NGT) { const f32x4 v = *(const f32x4*)(a.in[1] + 4 * (size_t)i); u32x2 w; w.x = pk2(v.x, v.y); w.y = pk2(v.z, v.w); *(u32x2*)((bf16_t*)(dout + DO_MEMB) + 4 * (size_t)i) = w; }
        for (int i = gtid; i < T * 8; i += NGT) { const int tok = i >> 3, fi = i & 7; const int pos = ((const int*)a.in[2])[tok];
            float inv = 1.0f;
            inv = fi == 1 ? 0.19392274474868576f : inv; inv = fi == 2 ? 0.03760603093086393f : inv; inv = fi == 3 ? 0.007292664737217109f : inv; inv = fi == 4 ? 0.001414213562373095f : inv;
            inv = fi == 5 ? 0.0002742481756762073f : inv; inv = fi == 6 ? 5.318295896944988e-05f : inv; inv = fi == 7 ? 1.031338537721246e-05f : inv;
            const float ang = (float)pos * inv; ROPE[tok * 16 + fi] = cosf(ang); ROPE[tok * 16 + 8 + fi] = sinf(ang); }
        for (int i = gtid; i < 8 * 128 * 128; i += NGT) { const int t = (i >> 7) & 127, s = i & 127; const float w = a.in[8][i]; ((bf16_t*)(ws + WS_WSTRIL))[i] = (bf16_t)(s <= t ? f2bf(w) : 0u); }
        if (gw < 8) { const int mat = gw >> 2, col = (gw & 3) * 64 + lane; const float* pe = a.in[mat ? 15 : 10]; const float* w1 = a.in[mat ? 16 : 11]; float sum = a.in[mat ? 17 : 12][col];
            for (int k = 0; k < 2048; ++k) sum += pe[k] * w1[(size_t)k * 256 + col];
            ((float*)(ws + WS_C1))[mat * 256 + col] = sum; }
    }
    SYNC(0);

    if (IN(1)) RPT(1) {
        { pg8::Gemm g{(const bf16_t*)(dout + DO_H0B), (const bf16_t*)(dout + DO_WIN_T), T, ZC, D, D}; pg8::StaticOrder So; So.init(T, ZC, G, (int)blockIdx.x);
          pg8::EpiBf16<0> E{Z, ZC, nullptr, 1.f}; pg8::gemm_phase<pg8::EpiBf16<0>, pg8::StaticOrder, true>(lds, g, So, E); }
        { pg8::Gemm g{(const bf16_t*)(dout + DO_MEMB), (const bf16_t*)(dout + DO_WXKV_T), 512, 2048, D, D}; pg8::StaticOrder So; So.init(512, 2048, G, (G - 1) - (int)blockIdx.x);
          pg8::EpiBf16<0> E{(bf16_t*)(dout + DO_XKV), 2048, nullptr, 1.f}; pg8::gemm_phase<pg8::EpiBf16<0>, pg8::StaticOrder, true>(lds, g, So, E); }
    }
    SYNC(1);

    if (IN(2)) RPT(2) {
        bf16_t* const KCMPT = (bf16_t*)(ws + WS_KCMPT); bf16_t* const VCMPT = (bf16_t*)(ws + WS_VCMPT);
        for (int tok = gw; tok < T; tok += NGW) {
            bf16_t* zr = Z + (size_t)tok * ZC; const int b = tok >> 13, t = tok & 8191;
            float rc[8], rs[8];
            { const f32x4 c0 = *(const f32x4*)(ROPE + tok * 16), c1 = *(const f32x4*)(ROPE + tok * 16 + 4), s0 = *(const f32x4*)(ROPE + tok * 16 + 8), s1 = *(const f32x4*)(ROPE + tok * 16 + 12);
#pragma unroll
              for (int e = 0; e < 4; ++e) { rc[e] = c0[e]; rc[4 + e] = c1[e]; rs[e] = s0[e]; rs[4 + e] = s1[e]; } }
            { const u32x4 w0 = *(const u32x4*)(zr + C_V + 16 * lane), w1 = *(const u32x4*)(zr + C_V + 16 * lane + 8); float f[16];
#pragma unroll
              for (int e = 0; e < 4; ++e) { f[2 * e] = bflo(w0[e]); f[2 * e + 1] = bfhi(w0[e]); f[8 + 2 * e] = bflo(w1[e]); f[8 + 2 * e + 1] = bfhi(w1[e]); }
              float s = 0.f;
#pragma unroll
              for (int e = 0; e < 16; ++e) { f[e] = gelu_t(f[e]); s += f[e]; }
              const float mean = wave_sum(s) * (1.f / 1024.f); float s2 = 0.f;
#pragma unroll
              for (int e = 0; e < 16; ++e) { f[e] -= mean; s2 += f[e] * f[e]; }
              const float rstd = 1.f / sqrtf(wave_sum(s2) * (1.f / 1024.f) + LN_EPS);
              const float* gg = a.in[6] + 16 * lane; const float* bb = a.in[7] + 16 * lane; u32x4 o0, o1;
#pragma unroll
              for (int e = 0; e < 4; ++e) { o0[e] = pk2(f[2 * e] * rstd * gg[2 * e] + bb[2 * e], f[2 * e + 1] * rstd * gg[2 * e + 1] + bb[2 * e + 1]);
                                            o1[e] = pk2(f[8 + 2 * e] * rstd * gg[8 + 2 * e] + bb[8 + 2 * e], f[9 + 2 * e] * rstd * gg[9 + 2 * e] + bb[9 + 2 * e]); }
              *(u32x4*)(zr + C_V + 16 * lane) = o0; *(u32x4*)(zr + C_V + 16 * lane + 8) = o1; }
            { const u32x4 w0 = *(const u32x4*)(zr + C_Q + 16 * lane), w1 = *(const u32x4*)(zr + C_Q + 16 * lane + 8); float f[16];
#pragma unroll
              for (int e = 0; e < 4; ++e) { f[2 * e] = bflo(w0[e]); f[2 * e + 1] = bfhi(w0[e]); f[8 + 2 * e] = bflo(w1[e]); f[8 + 2 * e + 1] = bfhi(w1[e]); }
              if ((lane & 3) == 0) {
#pragma unroll
                  for (int i = 0; i < 8; ++i) { const float x1 = f[i], x2 = f[8 + i]; f[i] = x1 * rc[i] - x2 * rs[i]; f[8 + i] = x2 * rc[i] + x1 * rs[i]; } }
              u32x4 o0, o1;
#pragma unroll
              for (int e = 0; e < 4; ++e) { o0[e] = pk2(f[2 * e] * QSCALE, f[2 * e + 1] * QSCALE); o1[e] = pk2(f[8 + 2 * e] * QSCALE, f[9 + 2 * e] * QSCALE); }
              *(u32x4*)(zr + C_Q + 16 * lane) = o0; *(u32x4*)(zr + C_Q + 16 * lane + 8) = o1; }
            { const int h = lane >> 4, r = lane & 15; const size_t bh = (size_t)(b * 4 + h);
              const f32x4 rcl = *(const f32x4*)(ROPE + tok * 16 + 4 * (r & 1)), rsl = *(const f32x4*)(ROPE + tok * 16 + 8 + 4 * (r & 1));
#pragma unroll
              for (int sg = 0; sg < 6; ++sg) {
                  const u32x2 w = *(const u32x2*)(zr + C_KCMP + sg * 256 + 4 * lane);
                  if (sg == 0) *(u32x2*)(KCMPT + (bh * 8192 + t) * 64 + 4 * r) = w;
                  else if (sg == 1) *(u32x2*)(VCMPT + (bh * 8192 + t) * 64 + 4 * r) = w;
                  else if (sg == 2 || sg == 4) {
                      float x[4] = {bflo(w.x), bfhi(w.x), bflo(w.y), bfhi(w.y)}; float y[4];
#pragma unroll
                      for (int e = 0; e < 4; ++e) { const float other = __shfl_xor(x[e], 2); const float c = rcl[e], sn = rsl[e];
                          y[e] = (r < 2) ? (x[e] * c - other * sn) : ((r < 4) ? (x[e] * c + other * sn) : x[e]); }
                      u32x2 o; o.x = pk2(y[0], y[1]); o.y = pk2(y[2], y[3]); *(u32x2*)(zr + C_KCMP + sg * 256 + 4 * lane) = o;
                  }
              } }
        }
        for (int i = gtid; i < 512 * 128; i += NGT) { const int mrow = i >> 7, cgp = i & 127; const u32x4 w = *(const u32x4*)((const bf16_t*)(dout + DO_XKV) + (size_t)mrow * 2048 + 1024 + 8 * cgp);
            bf16_t* p = (bf16_t*)(dout + DO_XVT) + ((size_t)((mrow >> 8) * 1024 + 8 * cgp)) * 256 + (mrow & 255);
#pragma unroll
            for (int e = 0; e < 4; ++e) { p[(2 * e) * 256] = (bf16_t)(w[e] & 0xffffu); p[(2 * e + 1) * 256] = (bf16_t)(w[e] >> 16); } }
    }
    SYNC(2);

    if (IN(3)) RPT(3) {
        const bf16_t* WSTRIL = (const bf16_t*)(ws + WS_WSTRIL);
        for (int un = blockIdx.x; un < 1024; un += G) {
            const int chunk = un >> 3, g = un & 7; const size_t tokbase = (size_t)chunk * 128;
            LAS bf16_t* vT = (LAS bf16_t*)lds;
#pragma unroll
            for (int i = 0; i < 4; ++i) { const int p = tid + 512 * i, s = p >> 4, c0 = (p & 15) * 8; const u32x4 w = *(const u32x4*)(Z + (tokbase + s) * ZC + C_V + g * 128 + c0);
#pragma unroll
                for (int e = 0; e < 4; ++e) { vT[(c0 + 2 * e) * 136 + s] = (bf16_t)(w[e] & 0xffffu); vT[(c0 + 2 * e + 1) * 136 + s] = (bf16_t)(w[e] >> 16); } }
            __syncthreads();
            const int j = lane & 15, q4 = lane >> 4, t = 16 * wid + j;
            f32x4 acc[8];
#pragma unroll
            for (int it = 0; it < 8; ++it) acc[it] = (f32x4){0.f, 0.f, 0.f, 0.f};
            const int nks = (16 * wid + 15) / 32 + 1;
            for (int ks = 0; ks < nks; ++ks) { const bf16x8 wf = *(const bf16x8*)(WSTRIL + (size_t)g * 16384 + t * 128 + 32 * ks + 8 * q4);
#pragma unroll
                for (int it = 0; it < 8; ++it) { const bf16x8 vf = *(const LAS bf16x8*)(vT + (16 * it + j) * 136 + 32 * ks + 8 * q4); acc[it] = MFMA16(vf, wf, acc[it]); } }
            const float bsv = a.in[9][g * 128 + t]; bf16_t* zr = Z + (tokbase + t) * ZC;
#pragma unroll
            for (int it = 0; it < 8; ++it) { const int c = g * 128 + 16 * it + 4 * q4; const u32x2 uw = *(const u32x2*)(zr + C_U + c), gaw = *(const u32x2*)(zr + C_GA + c);
                const float u0 = bflo(uw.x), u1 = bfhi(uw.x), u2 = bflo(uw.y), u3 = bfhi(uw.y), g0 = bflo(gaw.x), g1 = bfhi(gaw.x), g2 = bflo(gaw.y), g3 = bfhi(gaw.y);
                u32x2 o; o.x = pk2(gelu_t(u0) * (acc[it][0] + bsv) * sigm(g0), gelu_t(u1) * (acc[it][1] + bsv) * sigm(g1)); o.y = pk2(gelu_t(u2) * (acc[it][2] + bsv) * sigm(g2), gelu_t(u3) * (acc[it][3] + bsv) * sigm(g3));
                *(u32x2*)(zr + C_U + c) = o; }
            __syncthreads();
        }
        { pg8::Gemm g{(const bf16_t*)(ws + WS_KCMPT), (const bf16_t*)(dout + DO_W1KT), 4096, 256, 2048, 1024}; pg8::StaticOrder So; So.init(4096, 256, G, (int)blockIdx.x);
          pg8::EpiBf16<2> E{(bf16_t*)(ws + WS_HDNK), 256, (const float*)(ws + WS_C1), 1.f}; pg8::gemm_phase<pg8::EpiBf16<2>, pg8::StaticOrder, true>(lds, g, So, E); }
        { pg8::Gemm g{(const bf16_t*)(ws + WS_VCMPT), (const bf16_t*)(dout + DO_W1VT), 4096, 256, 2048, 1024}; pg8::StaticOrder So; So.init(4096, 256, G, (G - 1) - (int)blockIdx.x);
          pg8::EpiBf16<2> E{(bf16_t*)(ws + WS_HDNV), 256, (const float*)(ws + WS_C1) + 256, 1.f}; pg8::gemm_phase<pg8::EpiBf16<2>, pg8::StaticOrder, true>(lds, g, So, E); }
    }
    SYNC(3);

    if (IN(4)) RPT(4) {
        for (int u = gw; u < 512; u += NGW) {
            const int mat = u >> 8, r0 = (u & 255) * 16, j = lane & 15, q4 = lane >> 4;
            const bf16_t* HDN = (const bf16_t*)(ws + (mat ? WS_HDNV : WS_HDNK)); const bf16_t* W2T = (const bf16_t*)(ws + (mat ? WS_W2VT : WS_W2KT)); const float* b2 = a.in[mat ? 19 : 14];
            f32x4 acc[4];
#pragma unroll
            for (int it = 0; it < 4; ++it) acc[it] = (f32x4){0.f, 0.f, 0.f, 0.f};
#pragma unroll
            for (int ks = 0; ks < 8; ++ks) { const bf16x8 hb = *(const bf16x8*)(HDN + (size_t)(r0 + j) * 256 + 32 * ks + 8 * q4);
#pragma unroll
                for (int it = 0; it < 4; ++it) { const bf16x8 wf = *(const bf16x8*)(W2T + (16 * it + j) * 256 + 32 * ks + 8 * q4); acc[it] = MFMA16(wf, hb, acc[it]); } }
            const int r = r0 + j, bh = r >> 9, n = r & 511, b = bh >> 2;
#pragma unroll
            for (int it = 0; it < 4; ++it) { const f32x4 bv = *(const f32x4*)(b2 + 16 * it + 4 * q4); acc[it] = acc[it] + bv; }
            if (mat == 0) {
                const int pt = 16 * n + 31; const float* rt = ROPE + (size_t)(b * 8192 + (pt < 8192 ? pt : 8191)) * 16;
#pragma unroll
                for (int e = 0; e < 4; ++e) { const float x = acc[0][e], other = __shfl_xor(x, 32); const int fi = 4 * (q4 & 1) + e; const float c = rt[fi], sn = rt[8 + fi];
                    acc[0][e] = (q4 < 2) ? (x * c - other * sn) : (x * c + other * sn); }
#pragma unroll
                for (int it = 0; it < 4; ++it) { u32x2 o; o.x = pk2(acc[it][0], acc[it][1]); o.y = pk2(acc[it][2], acc[it][3]); if (n == 511) { o.x = 0u; o.y = 0u; }
                    *(u32x2*)((bf16_t*)(ws + WS_KC) + (size_t)r * 64 + 16 * it + 4 * q4) = o; }
            } else {
#pragma unroll
                for (int it = 0; it < 4; ++it) { u32x2 o; o.x = pk2(acc[it][0], acc[it][1]); o.y = pk2(acc[it][2], acc[it][3]); if (n == 511) { o.x = 0u; o.y = 0u; }
                    *(u32x2*)((bf16_t*)(ws + WS_VCT) + (size_t)r * 64 + 16 * it + 4 * q4) = o; }
            }
        }
    }
    SYNC(4);

    if (IN(5)) RPT(5) {
        const bf16_t* KC = (const bf16_t*)(ws + WS_KC); const bf16_t* VC = (const bf16_t*)(ws + WS_VCT);
        bf16_t* MIX = (bf16_t*)(dout + DO_MIX);
        LAS bf16_t* const KBb = (LAS bf16_t*)lds; LAS bf16_t* const VBb = (LAS bf16_t*)(lds + 18432);
        LAS float* wl = (LAS float*)(lds + 36864 + wid * 4352);
        LAS unsigned* wgum = (LAS unsigned*)(lds + 36864 + 8 * 4352);
        LAS unsigned char* blist = (LAS unsigned char*)(wgum + 8);
        const int j = lane & 15, q4 = lane >> 4, tk = j >> 2, hd = j & 3;
        const int skey = tid >> 3, sc = tid & 7;
#define STG_K(R, base, pitch) R.k = *(const u32x4*)((base) + (size_t)skey * (pitch) + 8 * sc)
#define STG_V(R, base, pitch) R.v = *(const u32x4*)((base) + (size_t)skey * (pitch) + 8 * sc)
#define STS_K(R, buf) *(LAS u32x4*)(KBb + (buf) * 4608 + skey * 72 + 8 * sc) = R.k
#define STS_V(R, buf) do { LAS bf16_t* vb_ = VBb + (buf) * 4608 + (8 * sc) * 72 + (skey ^ (sc << 3)); _Pragma("unroll") for (int e_ = 0; e_ < 4; ++e_) { vb_[(2 * e_) * 72] = (bf16_t)(R.v[e_] & 0xffffu); vb_[(2 * e_ + 1) * 72] = (bf16_t)(R.v[e_] >> 16); } } while (0)
#define QK_LDS(buf, kl, s0, s1) do { const LAS bf16_t* p_ = KBb + (buf) * 4608 + ((kl) + j) * 72 + 8 * q4; const f32x4 z_ = {0.f, 0.f, 0.f, 0.f}; \
            const bf16x8 k00_ = *(const LAS bf16x8*)p_, k01_ = *(const LAS bf16x8*)(p_ + 32), k10_ = *(const LAS bf16x8*)(p_ + 16 * 72), k11_ = *(const LAS bf16x8*)(p_ + 16 * 72 + 32); \
            s0 = MFMA16(k00_, qf0, z_); s0 = MFMA16(k01_, qf1, s0); s1 = MFMA16(k10_, qf0, z_); s1 = MFMA16(k11_, qf1, s1); } while (0)
#define PV_LDS(buf, kl, pb, o) do { _Pragma("unroll") for (int dt_ = 0; dt_ < 4; ++dt_) { const int cx_ = ((2 * dt_ + (j >> 3)) & 7) << 3; const LAS bf16_t* v_ = VBb + (buf) * 4608 + (16 * dt_ + j) * 72; \
            const u32x2 lo_ = *(const LAS u32x2*)(v_ + (((kl) + 4 * q4) ^ cx_)), hi_ = *(const LAS u32x2*)(v_ + (((kl) + 16 + 4 * q4) ^ cx_)); u32x4 w_; w_.x = lo_.x; w_.y = lo_.y; w_.z = hi_.x; w_.w = hi_.y; \
            o[dt_] = MFMA16(__builtin_bit_cast(bf16x8, w_), pb, o[dt_]); } } while (0)
        struct StageRegs { u32x4 k, v; };
        for (int uu = blockIdx.x; uu < 2048; uu += G) {
            const int bhu = uu >> 8; int tb = uu & 255; if (bhu & 1) tb = 255 - tb;
            const int b = bhu >> 2, kvh = bhu & 3, t0w = 32 * tb, t0 = t0w + 4 * wid, t = t0 + tk; const size_t tok = (size_t)b * S + t, bh = (size_t)bhu;
            const bf16_t* zr = Z + tok * ZC; const int head = kvh * 4 + hd;
            const bf16x8 qf0 = *(const bf16x8*)(zr + C_Q + head * 64 + 8 * q4), qf1 = *(const bf16x8*)(zr + C_Q + head * 64 + 32 + 8 * q4);
            for (int i = lane; i < 1040; i += 64) wl[i] = 0.f;
            if (tid < 8) wgum[tid] = 0u;
            const float gcm = sigm(bf1(zr[C_GN + head * 3 + 0])), gsl = sigm(bf1(zr[C_GN + head * 3 + 1])), gwn = sigm(bf1(zr[C_GN + head * 3 + 2]));
            f32x4 yb[4];
#pragma unroll
            for (int dt = 0; dt < 4; ++dt) yb[dt] = (f32x4){0.f, 0.f, 0.f, 0.f};
            __syncthreads();
            const int ncw = (t0w + 31 >= 31) ? (((t0w + 31 - 31) >> 4) + 1) : 0;
            const int ncmax = (t0 + 3 >= 31) ? (((t0 + 3 - 31) >> 4) + 1) : 0;
            const int nvalid = (t >= 31) ? (((t - 31) >> 4) + 1) : 0;
            const int nb_c = (ncw + 63) >> 6;
            {
                float m = -1e30f, l = 0.f;
                const bf16_t* kcb = KC + bh * 512 * 64;
                { StageRegs R; STG_K(R, kcb, 64);
                  for (int n = 0; n < nb_c; ++n) { const int buf = n & 1; STS_K(R, buf); __syncthreads(); if (n + 1 < nb_c) STG_K(R, kcb + (size_t)(n + 1) * 4096, 64);
#pragma unroll
                    for (int hf = 0; hf < 2; ++hf) { const int kb = 64 * n + 32 * hf; if (kb < ncmax) { f32x4 s0, s1; QK_LDS(buf, 32 * hf, s0, s1);
                        float mx = -1e30f;
#pragma unroll
                        for (int e = 0; e < 4; ++e) { if (kb + 4 * q4 + e < nvalid) mx = fmaxf(mx, s0[e]); if (kb + 16 + 4 * q4 + e < nvalid) mx = fmaxf(mx, s1[e]); }
                        mx = fmaxf(mx, __shfl_xor(mx, 16)); mx = fmaxf(mx, __shfl_xor(mx, 32));
                        const float mn = fmaxf(m, mx); float ps = 0.f;
#pragma unroll
                        for (int e = 0; e < 4; ++e) { if (kb + 4 * q4 + e < nvalid) ps += __builtin_amdgcn_exp2f(s0[e] - mn); if (kb + 16 + 4 * q4 + e < nvalid) ps += __builtin_amdgcn_exp2f(s1[e] - mn); }
                        l = l * __builtin_amdgcn_exp2f(m - mn) + ps; m = mn; } } } }
                l += __shfl_xor(l, 16); l += __shfl_xor(l, 32);
                const float invl = l > 0.f ? 1.f / l : 0.f;
                f32x4 o[4];
#pragma unroll
                for (int dt = 0; dt < 4; ++dt) o[dt] = (f32x4){0.f, 0.f, 0.f, 0.f};
                __syncthreads();
                const bf16_t* vcb = VC + bh * 512 * 64;
                { StageRegs R; STG_K(R, kcb, 64); STG_V(R, vcb, 64);
                  for (int n = 0; n < nb_c; ++n) { const int buf = n & 1; STS_K(R, buf); STS_V(R, buf); __syncthreads(); if (n + 1 < nb_c) { STG_K(R, kcb + (size_t)(n + 1) * 4096, 64); STG_V(R, vcb + (size_t)(n + 1) * 4096, 64); }
#pragma unroll
                    for (int hf = 0; hf < 2; ++hf) { const int kb = 64 * n + 32 * hf; if (kb < ncmax) { f32x4 s0, s1; QK_LDS(buf, 32 * hf, s0, s1);
                        float p[8];
#pragma unroll
                        for (int e = 0; e < 4; ++e) { p[e] = (kb + 4 * q4 + e < nvalid) ? __builtin_amdgcn_exp2f(s0[e] - m) * invl : 0.f; p[4 + e] = (kb + 16 + 4 * q4 + e < nvalid) ? __builtin_amdgcn_exp2f(s1[e] - m) * invl : 0.f; }
                        float a0 = (p[0] + p[1]) + (p[2] + p[3]), a1 = (p[4] + p[5]) + (p[6] + p[7]), x0 = p[3], x1 = p[7];
                        a0 += __shfl_xor(a0, 1); a0 += __shfl_xor(a0, 2); a1 += __shfl_xor(a1, 1); a1 += __shfl_xor(a1, 2);
                        x0 += __shfl_xor(x0, 1); x0 += __shfl_xor(x0, 2); x1 += __shfl_xor(x1, 1); x1 += __shfl_xor(x1, 2);
                        if (hd == 0) { const int jj0 = (kb >> 2) + q4, jj1 = jj0 + 4; wl[tk * 128 + jj0] = a0; wl[tk * 128 + jj1] = a1; wl[512 + tk * 132 + jj0 + 1] = x0; wl[512 + tk * 132 + jj1 + 1] = x1; }
                        const bf16x8 pb = pack_p(p); PV_LDS(buf, 32 * hf, pb, o); } } } }
#pragma unroll
                for (int dt = 0; dt < 4; ++dt) yb[dt] = yb[dt] + o[dt] * gcm;
            }
            LDS_WAIT();
            unsigned mysel[4], um[4];
            {
                const int tk2 = lane >> 4, r = lane & 15, cur = t0 >> 6;
                float val[8];
#pragma unroll
                for (int mm = 0; mm < 8; ++mm) { const int jj = r + 16 * mm; const float pvv = wl[tk2 * 128 + jj] + wl[512 + tk2 * 132 + jj];
                    const bool forced = (jj == 0) | (jj == cur) | (jj == cur - 1);
                    val[mm] = forced ? __builtin_inff() : (jj <= cur ? pvv : -__builtin_inff()); }
                LDS_WAIT();
#pragma unroll
                for (int mm = 0; mm < 8; ++mm) wl[tk2 * 128 + r + 16 * mm] = val[mm];
                LDS_WAIT();
                int rank[8];
#pragma unroll
                for (int mm = 0; mm < 8; ++mm) rank[mm] = 0;
                for (int jp = 0; jp <= cur; ++jp) { const float vp = wl[tk2 * 128 + jp];
#pragma unroll
                    for (int mm = 0; mm < 8; ++mm) rank[mm] += ((vp > val[mm]) || (vp == val[mm] && jp < r + 16 * mm)) ? 1 : 0; }
                unsigned long long bm[8];
#pragma unroll
                for (int mm = 0; mm < 8; ++mm) bm[mm] = __ballot((r + 16 * mm <= cur) && rank[mm] < 16);
#pragma unroll
                for (int w = 0; w < 4; ++w) { const unsigned long long b0 = bm[2 * w], b1 = bm[2 * w + 1];
                    mysel[w] = (unsigned)((b0 >> (16 * tk)) & 0xFFFFull) | ((unsigned)((b1 >> (16 * tk)) & 0xFFFFull) << 16);
                    const unsigned u0 = (unsigned)((b0 | (b0 >> 16) | (b0 >> 32) | (b0 >> 48)) & 0xFFFFull), u1 = (unsigned)((b1 | (b1 >> 16) | (b1 >> 32) | (b1 >> 48)) & 0xFFFFull);
                    um[w] = (unsigned)__builtin_amdgcn_readfirstlane((int)(u0 | (u1 << 16))); }
                if (lane < 4) { const unsigned v = lane == 0 ? um[0] : (lane == 1 ? um[1] : (lane == 2 ? um[2] : um[3])); atomicOr((unsigned*)(wgum + lane), v); }
            }
            __syncthreads();
            if (tid < 128) { const int w = tid >> 5, bi = tid & 31; const unsigned w0 = wgum[0], w1 = wgum[1], w2 = wgum[2], w3 = wgum[3]; const unsigned word = w == 0 ? w0 : (w == 1 ? w1 : (w == 2 ? w2 : w3));
                if ((word >> bi) & 1u) { const int pos = (w > 0 ? __builtin_popcount(w0) : 0) + (w > 1 ? __builtin_popcount(w1) : 0) + (w > 2 ? __builtin_popcount(w2) : 0) + __builtin_popcount(word & ((1u << bi) - 1u)); blist[pos] = (unsigned char)tid; }
                if (tid == 0) wgum[4] = (unsigned)(__builtin_popcount(w0) + __builtin_popcount(w1) + __builtin_popcount(w2) + __builtin_popcount(w3)); }
            __syncthreads();
            {
                float m = -1e30f, l = 0.f; f32x4 o[4];
#pragma unroll
                for (int dt = 0; dt < 4; ++dt) o[dt] = (f32x4){0.f, 0.f, 0.f, 0.f};
                const int nb_s = (int)wgum[4];
                const bf16_t* ksb = Z + (size_t)b * S * ZC + C_KSLC + kvh * 64; const bf16_t* vsb = Z + (size_t)b * S * ZC + C_VSLC + kvh * 64;
                StageRegs R; { const int jj0 = blist[0]; STG_K(R, ksb + (size_t)(64 * jj0) * ZC, ZC); STG_V(R, vsb + (size_t)(64 * jj0) * ZC, ZC); }
                for (int n = 0; n < nb_s; ++n) { const int buf = n & 1; const int jj = blist[n]; STS_K(R, buf); STS_V(R, buf); __syncthreads();
                    if (n + 1 < nb_s) { const int jn = blist[n + 1]; STG_K(R, ksb + (size_t)(64 * jn) * ZC, ZC); STG_V(R, vsb + (size_t)(64 * jn) * ZC, ZC); }
                    const unsigned uw = jj < 32 ? um[0] : (jj < 64 ? um[1] : (jj < 96 ? um[2] : um[3]));
                    if ((uw >> (jj & 31)) & 1u) { const unsigned mw = jj < 32 ? mysel[0] : (jj < 64 ? mysel[1] : (jj < 96 ? mysel[2] : mysel[3])); const bool mine = (mw >> (jj & 31)) & 1u;
#pragma unroll
                        for (int hf = 0; hf < 2; ++hf) { const int kb = 64 * jj + 32 * hf;
                            unsigned vm = 0u;
#pragma unroll
                            for (int e = 0; e < 4; ++e) { vm |= (mine && (kb + 4 * q4 + e <= t)) ? (1u << e) : 0u; vm |= (mine && (kb + 16 + 4 * q4 + e <= t)) ? (1u << (4 + e)) : 0u; }
                            if (__ballot(vm != 0u) != 0ull) { f32x4 s0, s1; QK_LDS(buf, 32 * hf, s0, s1); const bf16x8 pb = osm_step(s0, s1, vm, m, l, o); PV_LDS(buf, 32 * hf, pb, o); } } } }
                l += __shfl_xor(l, 16); l += __shfl_xor(l, 32); const float sc2 = (l > 0.f ? 1.f / l : 0.f) * gsl;
#pragma unroll
                for (int dt = 0; dt < 4; ++dt) yb[dt] = yb[dt] + o[dt] * sc2;
            }
            __syncthreads();
            {
                float m = -1e30f, l = 0.f; f32x4 o[4];
#pragma unroll
                for (int dt = 0; dt < 4; ++dt) o[dt] = (f32x4){0.f, 0.f, 0.f, 0.f};
                const int kws = ((t0w - 511 > 0) ? (t0w - 511) : 0) & ~63; const int nb_w = ((t0w + 31 - kws) >> 6) + 1;
                const bf16_t* kwb = Z + ((size_t)b * S + kws) * ZC + C_KWIN + kvh * 64; const bf16_t* vwb = Z + ((size_t)b * S + kws) * ZC + C_VWIN + kvh * 64;
                StageRegs R; STG_K(R, kwb, ZC); STG_V(R, vwb, ZC);
                for (int n = 0; n < nb_w; ++n) { const int buf = n & 1; STS_K(R, buf); STS_V(R, buf); __syncthreads();
                    if (n + 1 < nb_w) { STG_K(R, kwb + (size_t)(64 * (n + 1)) * ZC, ZC); STG_V(R, vwb + (size_t)(64 * (n + 1)) * ZC, ZC); }
                    const int key0 = kws + 64 * n;
                    if (key0 + 63 >= t0 - 511 && key0 <= t0 + 3) {
#pragma unroll
                        for (int hf = 0; hf < 2; ++hf) { const int kb = key0 + 32 * hf;
                            unsigned vm = 0u;
#pragma unroll
                            for (int e = 0; e < 4; ++e) { const int k0 = kb + 4 * q4 + e, k1 = k0 + 16; vm |= (k0 <= t && k0 > t - 512) ? (1u << e) : 0u; vm |= (k1 <= t && k1 > t - 512) ? (1u << (4 + e)) : 0u; }
                            if (__ballot(vm != 0u) != 0ull) { f32x4 s0, s1; QK_LDS(buf, 32 * hf, s0, s1); const bf16x8 pb = osm_step(s0, s1, vm, m, l, o); PV_LDS(buf, 32 * hf, pb, o); } } } }
                l += __shfl_xor(l, 16); l += __shfl_xor(l, 32); const float sc2 = (l > 0.f ? 1.f / l : 0.f) * gwn;
#pragma unroll
                for (int dt = 0; dt < 4; ++dt) yb[dt] = yb[dt] + o[dt] * sc2;
            }
#pragma unroll
            for (int dt = 0; dt < 4; ++dt) { const int c = head * 64 + 16 * dt + 4 * q4; const u32x2 mw = *(const u32x2*)(zr + C_U + c), gw2 = *(const u32x2*)(zr + C_GB + c);
                u32x2 o2; o2.x = pk2(bflo(mw.x) + sigm(bflo(gw2.x)) * yb[dt][0], bfhi(mw.x) + sigm(bfhi(gw2.x)) * yb[dt][1]); o2.y = pk2(bflo(mw.y) + sigm(bflo(gw2.y)) * yb[dt][2], bfhi(mw.y) + sigm(bfhi(gw2.y)) * yb[dt][3]);
                *(u32x2*)(MIX + tok * 1024 + c) = o2; }
            __syncthreads();
        }
#undef STG_K
#undef STG_V
#undef STS_K
#undef STS_V
#undef QK_LDS
#undef PV_LDS
    }
    SYNC(5);

    if (IN(6)) RPT(6) { pg8::Gemm g{(const bf16_t*)(dout + DO_MIX), (const bf16_t*)(ws + WS_WOUT_T), T, D, D, D}; pg8::StaticOrder So; So.init(T, D, G, (int)blockIdx.x);
        pg8::EpiF32 E{(float*)(ws + WS_ACCF), D}; pg8::gemm_phase<pg8::EpiF32, pg8::StaticOrder, true>(lds, g, So, E); }
    SYNC(6);

    if (IN(7)) RPT(7) {
        for (int m = gw; m < T; m += NGW) { f32x4 v[4], ac[4]; row_load(v, a.in[0] + (size_t)m * D, lane); row_load(ac, (const float*)(ws + WS_ACCF) + (size_t)m * D, lane); ln_apply(v, a.in[3], a.in[4], lane);
#pragma unroll
            for (int jx = 0; jx < 4; ++jx) v[jx] = v[jx] * ALPHA + ac[jx];
            ln_apply(v, a.in[21], a.in[22], lane); row_store_f32(v, (float*)(ws + WS_HF) + (size_t)m * D, lane); row_store_bf16(v, (bf16_t*)(ws + WS_HB) + (size_t)m * D, lane); }
        LAS float* scr = (LAS float*)(lds + wid * 8448);
        constexpr int I_SQ = 16 * 32, I_F1 = 16 * 128, I_F2 = 64 * 32;
        for (int it = gw; it < 2 * I_SQ + I_F1 + I_F2; it += NGW) { int r = it;
            if (r < I_SQ) { tr_item(a.in[23], 1024, 1024, 1024, (bf16_t*)(ws + WS_WXQ_T), scr, r, lane); continue; } r -= I_SQ;
            if (r < I_SQ) { tr_item(a.in[25], 1024, 1024, 1024, (bf16_t*)(ws + WS_WXO_T), scr, r, lane); continue; } r -= I_SQ;
            if (r < I_F1) { tr_item(a.in[28], 1024, 4096, 4096, (bf16_t*)(ws + WS_WFF1_T), scr, r, lane); continue; } r -= I_F1;
            tr_item(a.in[29], 4096, 1024, 1024, (bf16_t*)(ws + WS_WFF2_T), scr, r, lane); }
    }
    SYNC(7);

    if (IN(8)) RPT(8) { pg8::Gemm g{(const bf16_t*)(ws + WS_HB), (const bf16_t*)(ws + WS_WXQ_T), T, D, D, D}; pg8::StaticOrder So; So.init(T, D, G, (int)blockIdx.x);
        pg8::EpiBf16<0> E{(bf16_t*)(ws + WS_XQ), D, nullptr, XSCALE}; pg8::gemm_phase<pg8::EpiBf16<0>, pg8::StaticOrder, true>(lds, g, So, E); }
    SYNC(8);

    if (IN(9)) RPT(9) {
        const bf16_t* XQ = (const bf16_t*)(ws + WS_XQ); const bf16_t* XKV = (const bf16_t*)(dout + DO_XKV); const bf16_t* XVT = (const bf16_t*)(dout + DO_XVT); bf16_t* XO = (bf16_t*)(ws + WS_XO);
        const int j = lane & 15, q4 = lane >> 4;
        for (int u = gw; u < 4096; u += NGW) { const int hx = u & 3, tok0 = (u >> 2) * 16, b = tok0 >> 13;
            bf16x8 qf[8];
#pragma unroll
            for (int ks = 0; ks < 8; ++ks) qf[ks] = *(const bf16x8*)(XQ + (size_t)(tok0 + j) * 1024 + hx * 256 + 32 * ks + 8 * q4);
            f32x4 s[16];
#pragma unroll
            for (int kt = 0; kt < 16; ++kt) { const bf16_t* kp = XKV + (size_t)(b * 256 + 16 * kt + j) * 2048 + hx * 256 + 8 * q4; s[kt] = (f32x4){0.f, 0.f, 0.f, 0.f};
#pragma unroll
                for (int ks = 0; ks < 8; ++ks) s[kt] = MFMA16(*(const bf16x8*)(kp + 32 * ks), qf[ks], s[kt]); }
            float mx = -1e30f;
#pragma unroll
            for (int kt = 0; kt < 16; ++kt) mx = fmaxf(fmaxf(mx, fmaxf(s[kt][0], s[kt][1])), fmaxf(s[kt][2], s[kt][3]));
            mx = fmaxf(mx, __shfl_xor(mx, 16)); mx = fmaxf(mx, __shfl_xor(mx, 32));
            float l = 0.f; bf16x8 pf[8];
#pragma unroll
            for (int kk = 0; kk < 8; ++kk) { float p[8];
#pragma unroll
                for (int e = 0; e < 4; ++e) { p[e] = __builtin_amdgcn_exp2f(s[2 * kk][e] - mx); p[4 + e] = __builtin_amdgcn_exp2f(s[2 * kk + 1][e] - mx); l += p[e] + p[4 + e]; }
                pf[kk] = pack_p(p); }
            l += __shfl_xor(l, 16); l += __shfl_xor(l, 32); const float invl = 1.f / l;
#pragma unroll 2
            for (int dt = 0; dt < 16; ++dt) { f32x4 o = {0.f, 0.f, 0.f, 0.f}; const bf16_t* vp = XVT + (size_t)(b * 1024 + hx * 256 + 16 * dt + j) * 256 + 4 * q4;
#pragma unroll
                for (int kk = 0; kk < 8; ++kk) { const u32x2 vlo = *(const u32x2*)(vp + 32 * kk), vhi = *(const u32x2*)(vp + 32 * kk + 16); u32x4 w; w.x = vlo.x; w.y = vlo.y; w.z = vhi.x; w.w = vhi.y;
                    o = MFMA16(__builtin_bit_cast(bf16x8, w), pf[kk], o); }
                u32x2 ow; ow.x = pk2(o[0] * invl, o[1] * invl); ow.y = pk2(o[2] * invl, o[3] * invl);
                *(u32x2*)(XO + (size_t)(tok0 + j) * 1024 + hx * 256 + 16 * dt + 4 * q4) = ow; }
        }
    }
    SYNC(9);

    if (IN(10)) RPT(10) { pg8::Gemm g{(const bf16_t*)(ws + WS_XO), (const bf16_t*)(ws + WS_WXO_T), T, D, D, D}; pg8::StaticOrder So; So.init(T, D, G, (int)blockIdx.x);
        pg8::EpiF32 E{(float*)(ws + WS_ACCF), D}; pg8::gemm_phase<pg8::EpiF32, pg8::StaticOrder, true>(lds, g, So, E); }
    SYNC(10);

    if (IN(11)) RPT(11) {
        for (int m = gw; m < T; m += NGW) { f32x4 v[4], ac[4]; row_load(v, (const float*)(ws + WS_HF) + (size_t)m * D, lane); row_load(ac, (const float*)(ws + WS_ACCF) + (size_t)m * D, lane);
#pragma unroll
            for (int jx = 0; jx < 4; ++jx) v[jx] = v[jx] * ALPHA + ac[jx];
            ln_apply(v, a.in[26], a.in[27], lane); row_store_f32(v, (float*)(ws + WS_HF) + (size_t)m * D, lane); row_store_bf16(v, (bf16_t*)(ws + WS_HB) + (size_t)m * D, lane); }
    }
    SYNC(11);

    if (IN(12)) RPT(12) { pg8::Gemm g{(const bf16_t*)(ws + WS_HB), (const bf16_t*)(ws + WS_WFF1_T), T, FF, D, D}; pg8::StaticOrder So; So.init(T, FF, G, (int)blockIdx.x);
        pg8::EpiBf16<3> E{(bf16_t*)(ws + WS_FFB), FF, nullptr, 1.f}; pg8::gemm_phase<pg8::EpiBf16<3>, pg8::StaticOrder, true>(lds, g, So, E); }
    SYNC(12);

    if (IN(13)) RPT(13) { pg8::Gemm g{(const bf16_t*)(ws + WS_FFB), (const bf16_t*)(ws + WS_WFF2_T), T, D, FF, FF}; pg8::StaticOrder So; So.init(T, D, G, (int)blockIdx.x);
        pg8::EpiF32 E{a.out, D}; pg8::gemm_phase<pg8::EpiF32, pg8::StaticOrder, true>(lds, g, So, E); }
    SYNC(13);

    if (IN(14)) RPT(14) {
        for (int m = gw; m < T; m += NGW) { f32x4 v[4], ac[4]; row_load(v, (const float*)(ws + WS_HF) + (size_t)m * D, lane); row_load(ac, a.out + (size_t)m * D, lane);
#pragma unroll
            for (int jx = 0; jx < 4; ++jx) v[jx] = v[jx] * ALPHA + ac[jx];
            ln_apply(v, a.in[30], a.in[31], lane); row_store_f32(v, a.out + (size_t)m * D, lane); }
    }
#undef IN
#undef SYNC
}

constexpr int NPHASE = 15;
extern "C" void kernel_launch(void* const* d_in, const int* in_sizes, int n_in, void* d_out, int out_size, void* d_ws, size_t ws_size, hipStream_t stream) {
    static int grid = 0;
    if (grid == 0) {
        if (n_in != 32 || out_size != T * D || ws_size < 256 * MiB) { fprintf(stderr, "kernel_launch: unexpected shapes (n_in %d out %d ws %zu)\n", n_in, out_size, ws_size); grid = -1; return; }
        int dev = 0, cus = 0, per_cu = 0;
        hipGetDevice(&dev); hipDeviceGetAttribute(&cus, hipDeviceAttributeMultiprocessorCount, dev);
        hipFuncSetAttribute((const void*)mk_fwd, hipFuncAttributeMaxDynamicSharedMemorySize, LDS_BYTES);
        hipOccupancyMaxActiveBlocksPerMultiprocessor(&per_cu, (const void*)mk_fwd, 512, LDS_BYTES);
        (void)hipGetLastError();
        if (per_cu < 1) fprintf(stderr, "kernel_launch: occupancy query says %d blocks per CU\n", per_cu);
        grid = cus > 0 ? cus : 256;
    }
    if (grid < 0) return;
    Args a{};
    for (int i = 0; i < 32; ++i) a.in[i] = (const float*)d_in[i];
    a.out = (float*)d_out; a.ws = (unsigned char*)d_ws; a.ph_lo = 0; a.ph_hi = NPHASE;
    void* args[] = {&a};
    hipError_t e = hipLaunchCooperativeKernel((const void*)mk_fwd, dim3(grid), dim3(512), args, LDS_BYTES, stream);
    if (e != hipSuccess) fprintf(stderr, "cooperative launch failed: %s (grid %d)\n", hipGetErrorString(e), grid);
}
```

```cpp
#include <hip/hip_runtime.h>
#include <hip/hip_cooperative_groups.h>
#include <cstdio>
#include <cstdint>
namespace cg = cooperative_groups;

#define LAS __attribute__((address_space(3)))
typedef unsigned short bf16_t;
typedef short bf16x8 __attribute__((ext_vector_type(8)));
typedef float f32x4 __attribute__((ext_vector_type(4)));
typedef float f32x2 __attribute__((ext_vector_type(2)));
typedef unsigned u32x4 __attribute__((ext_vector_type(4)));
typedef unsigned u32x2 __attribute__((ext_vector_type(2)));

__device__ __forceinline__ unsigned f2bf(float f) { unsigned u = __builtin_bit_cast(unsigned, f); return (u + 0x7fffu + ((u >> 16) & 1u)) >> 16; }
__device__ __forceinline__ unsigned pk2(float lo, float hi) { return f2bf(lo) | (f2bf(hi) << 16); }
__device__ __forceinline__ float bflo(unsigned w) { return __builtin_bit_cast(float, w << 16); }
__device__ __forceinline__ float bfhi(unsigned w) { return __builtin_bit_cast(float, w & 0xffff0000u); }
__device__ __forceinline__ float bf1(bf16_t h) { return __builtin_bit_cast(float, ((unsigned)h) << 16); }
__device__ __forceinline__ float gelu_t(float x) { const float u = x * (1.f + 0.044715f * x * x); const float e = __builtin_amdgcn_exp2f(-2.3022081986f * u); return x * __builtin_amdgcn_rcpf(1.f + e); }
__device__ __forceinline__ float sigm(float x) { return __builtin_amdgcn_rcpf(1.f + __builtin_amdgcn_exp2f(-1.4426950409f * x)); }
__device__ __forceinline__ float wave_sum(float v) {
#pragma unroll
    for (int o = 1; o < 64; o <<= 1) v += __shfl_xor(v, o);
    return v;
}
#define LDS_WAIT() asm volatile("s_waitcnt lgkmcnt(0)" ::: "memory")

namespace pg8 {
constexpr int BM = 256, BK = 64, HALF = 128, HTB = HALF * BK * 2, STAGE_BYTES = 8 * HTB, NXCD = 8, WGM = 8;
__host__ __device__ __forceinline__ int lds_byte(int r, int c) { const int st = (r >> 4) * 2 + (c >> 5), rr = r & 15, cc = c & 31, ob = rr * 64 + cc * 2; return st * 1024 + (ob ^ (((ob >> 9) & 1) << 5)); }
__host__ __device__ __forceinline__ void stage_rc(int b, int& R, int& C) { const int st = b / 1024, sb = b % 1024, swz = sb ^ (((sb >> 9) & 1) << 5); R = (st >> 1) * 16 + swz / 64; C = (st & 1) * 32 + (swz % 64) / 2; }
__host__ __device__ __forceinline__ int perm32(int rho) { const int n = rho >> 4, i = rho & 15; return 8 * (i >> 2) + 4 * n + (i & 3); }
struct Unit { int pm, pn; };
struct Gemm { const bf16_t* A; const bf16_t* Bt; int M, N, K, lda; };
struct StaticOrder {
    int nM, nN, nwg, G, c;
    __device__ void init(int M, int N, int G_, int c_) { nM = M / BM; nN = N / BM; nwg = nM * nN; G = G_; c = c_; }
    __device__ bool next(int i, Unit& u) const {
        const long L = (long)i * G + c; if (L >= nwg) return false;
        int wgid = (int)L; { const int q = nwg / NXCD, r = nwg % NXCD, xcd = wgid % NXCD, off = wgid / NXCD; wgid = (xcd < r ? xcd * (q + 1) : r * (q + 1) + (xcd - r) * q) + off; }
        const int nig = WGM * nN, gid = wgid / nig, fm = gid * WGM, gsz = (nM - fm) < WGM ? (nM - fm) : WGM;
        u.pm = fm + ((wgid % nig) % gsz); u.pn = (wgid % nig) / gsz; return true;
    }
};
__device__ __forceinline__ unsigned cvt_pk_bf16(float lo, float hi) { unsigned r; asm volatile("v_cvt_pk_bf16_f32 %0, %1, %2" : "=v"(r) : "v"(lo), "v"(hi)); return r; }

template <int ACT> struct EpiBf16 {
    static constexpr bool PERM = true;
    bf16_t* O; int ldc; const float* bias; float scale;
    __device__ __forceinline__ void operator()(const f32x4 (&acc)[2][2][4][2], const Unit& u, int wr, int wc, int fr, int fq) const {
        const int row0 = u.pm * BM + wr * 64 + fr; const int col0 = u.pn * BM + wc * 32 + 8 * fq;
        f32x4 bv[2][2];
#pragma unroll
        for (int bj = 0; bj < 2; ++bj)
#pragma unroll
            for (int n = 0; n < 2; ++n) bv[bj][n] = bias ? *(const f32x4*)(bias + col0 + bj * HALF + 4 * n) : (f32x4){0.f, 0.f, 0.f, 0.f};
#pragma unroll
        for (int ai = 0; ai < 2; ++ai)
#pragma unroll
            for (int m = 0; m < 4; ++m) { bf16_t* rowp = O + (size_t)(row0 + ai * HALF + m * 16) * ldc + col0;
#pragma unroll
                for (int bj = 0; bj < 2; ++bj) { f32x4 v0 = acc[ai][bj][m][0] + bv[bj][0], v1 = acc[ai][bj][m][1] + bv[bj][1];
                    if (ACT == 2) {
#pragma unroll
                        for (int e = 0; e < 4; ++e) { v0[e] = gelu_t(v0[e]); v1[e] = gelu_t(v1[e]); } }
                    if (ACT == 3) {
#pragma unroll
                        for (int e = 0; e < 4; ++e) { float a0 = v0[e] > 0.f ? v0[e] : 0.f, a1 = v1[e] > 0.f ? v1[e] : 0.f; v0[e] = a0 * a0; v1[e] = a1 * a1; } }
                    v0 = v0 * scale; v1 = v1 * scale; u32x4 w; w.x = cvt_pk_bf16(v0[0], v0[1]); w.y = cvt_pk_bf16(v0[2], v0[3]); w.z = cvt_pk_bf16(v1[0], v1[1]); w.w = cvt_pk_bf16(v1[2], v1[3]);
                    *(u32x4*)(rowp + bj * HALF) = w; } }
    }
};
struct EpiF32 {
    static constexpr bool PERM = false;
    float* O; int ldc;
    __device__ __forceinline__ void operator()(const f32x4 (&acc)[2][2][4][2], const Unit& u, int wr, int wc, int fr, int fq) const {
        const int row0 = u.pm * BM + wr * 64 + fr; const int col0 = u.pn * BM + wc * 32 + 4 * fq;
#pragma unroll
        for (int ai = 0; ai < 2; ++ai)
#pragma unroll
            for (int m = 0; m < 4; ++m) { float* rowp = O + (size_t)(row0 + ai * HALF + m * 16) * ldc + col0;
#pragma unroll
                for (int bj = 0; bj < 2; ++bj)
#pragma unroll
                    for (int n = 0; n < 2; ++n) *(f32x4*)(rowp + bj * HALF + n * 16) = acc[ai][bj][m][n]; }
    }
};

template <class Epi, class Sched, bool ALIGN_EPI>
__device__ __forceinline__ void gemm_phase(LAS unsigned char* lds, const Gemm g, const Sched& S, const Epi& E) {
    const int tid = threadIdx.x, wid = __builtin_amdgcn_readfirstlane(tid >> 6), lane = tid & 63, wr = wid >> 2, wc = wid & 3, fr = lane & 15, fq = lane >> 4;
    const int K = g.K, nt = K / BK, lda = g.lda;
    unsigned voffA[2], voffB[2];
#pragma unroll
    for (int i = 0; i < 2; ++i) { int R, C; stage_rc(tid * 16 + i * 8192, R, C); const int Rb = Epi::PERM ? ((R & ~31) + perm32(R & 31)) : R;
        voffA[i] = (unsigned)(R * lda + C) * 2u; voffB[i] = (unsigned)(Rb * K + C) * 2u; }
    const size_t kstep = (size_t)(BK * 2);
    const size_t hstepA = (size_t)HALF * lda * 2, hstepB = (size_t)HALF * K * 2;
    const size_t tstepA = 2 * hstepA, tstepB = 2 * hstepB;
    const unsigned ldsw = (unsigned)wid * 1024u;
    const int aoff = lds_byte(wr * 64 + fr, fq * 8), boff = lds_byte(wc * 32 + fr, fq * 8);
#define PG8_SA(b, h) (((b) * 2 + (h)) * HTB)
#define PG8_SB(b, h) ((4 + (b) * 2 + (h)) * HTB)
#define PG8_STAGE(bufoff, gbase, voff) do { _Pragma("unroll") for (int _i = 0; _i < 2; ++_i) \
        __builtin_amdgcn_global_load_lds((const unsigned*)((const char*)(gbase) + (voff)[_i]), (LAS unsigned*)(lds + (bufoff) + ldsw + _i * 8192), 16, 0, 0); } while (0)
#define PG8_LDA(dst, b, h) do { _Pragma("unroll") for (int m = 0; m < 4; ++m) _Pragma("unroll") for (int k = 0; k < 2; ++k) dst[m][k] = *(const LAS bf16x8*)(lds + PG8_SA(b, h) + aoff + m * 2048 + k * 1024); } while (0)
#define PG8_LDB(dst, b, h) do { _Pragma("unroll") for (int n = 0; n < 2; ++n) _Pragma("unroll") for (int k = 0; k < 2; ++k) dst[n][k] = *(const LAS bf16x8*)(lds + PG8_SB(b, h) + boff + n * 2048 + k * 1024); } while (0)
#define PG8_MMA(ai, bj, At, Bt) do { __builtin_amdgcn_s_setprio(1); _Pragma("unroll") for (int m = 0; m < 4; ++m) _Pragma("unroll") for (int n = 0; n < 2; ++n) _Pragma("unroll") for (int k = 0; k < 2; ++k) \
        acc[ai][bj][m][n] = __builtin_amdgcn_mfma_f32_16x16x32_bf16(Bt[n][k], At[m][k], acc[ai][bj][m][n], 0, 0, 0); __builtin_amdgcn_s_setprio(0); } while (0)
#define PG8_WAIT_V(n) asm volatile("s_waitcnt vmcnt(" #n ")" ::: "memory")
#define PG8_WAIT_L(n) asm volatile("s_waitcnt lgkmcnt(" #n ")" ::: "memory")
#define PG8_BAR __builtin_amdgcn_s_barrier()
#define PG8_SCHED __builtin_amdgcn_sched_barrier(0)
    Unit cur, nxt; int ui = 0;
    if (!S.next(0, cur)) return;
    f32x4 acc[2][2][4][2];
#pragma unroll
    for (int a = 0; a < 2; ++a)
#pragma unroll
        for (int b = 0; b < 2; ++b)
#pragma unroll
            for (int m = 0; m < 4; ++m)
#pragma unroll
                for (int n = 0; n < 2; ++n) acc[a][b][m][n] = (f32x4){0.f, 0.f, 0.f, 0.f};
    bf16x8 At[4][2], B0[2][2], B1[2][2];
    const char* cA = (const char*)g.A + (size_t)cur.pm * tstepA; const char* cB = (const char*)g.Bt + (size_t)cur.pn * tstepB;
    PG8_STAGE(PG8_SB(0, 0), cB, voffB); PG8_STAGE(PG8_SB(0, 1), cB + hstepB, voffB); PG8_STAGE(PG8_SA(0, 0), cA, voffA); PG8_STAGE(PG8_SA(0, 1), cA + hstepA, voffA);
    if (wr == 1) PG8_BAR;
    PG8_WAIT_V(2); PG8_BAR;
    PG8_STAGE(PG8_SB(1, 0), cB + kstep, voffB); PG8_STAGE(PG8_SA(1, 0), cA + kstep, voffA); PG8_STAGE(PG8_SB(1, 1), cB + hstepB + kstep, voffB);
    PG8_WAIT_V(6); PG8_BAR;
    for (;;) {
        const bool has_next = S.next(ui + 1, nxt);
        const char* nA = has_next ? (const char*)g.A + (size_t)nxt.pm * tstepA : cA; const char* nB = has_next ? (const char*)g.Bt + (size_t)nxt.pn * tstepB : cB;
        for (int t = 0; t < nt; t += 2) {
            const bool last = (t == nt - 2);
            const char* a1 = cA + (size_t)(t + 1) * kstep;
            const char* a2 = last ? nA : cA + (size_t)(t + 2) * kstep; const char* b2 = last ? nB : cB + (size_t)(t + 2) * kstep;
            const char* a3 = a2 + kstep; const char* b3 = b2 + kstep;
            PG8_LDB(B0, 0, 0); PG8_LDB(B1, 0, 1); PG8_SCHED; PG8_LDA(At, 0, 0); PG8_STAGE(PG8_SA(1, 1), a1 + hstepA, voffA);
            PG8_WAIT_V(8); PG8_WAIT_L(0); PG8_BAR; PG8_MMA(0, 0, At, B0); PG8_MMA(0, 1, At, B1); PG8_BAR; PG8_SCHED;
            PG8_LDA(At, 0, 1); PG8_STAGE(PG8_SB(0, 0), b2, voffB); PG8_STAGE(PG8_SB(0, 1), b2 + hstepB, voffB); PG8_STAGE(PG8_SA(0, 0), a2, voffA);
            PG8_WAIT_V(8); PG8_WAIT_L(0); PG8_BAR; PG8_MMA(1, 0, At, B0); PG8_MMA(1, 1, At, B1); PG8_BAR; PG8_SCHED;
            PG8_LDB(B0, 1, 0); PG8_LDB(B1, 1, 1); PG8_SCHED; PG8_LDA(At, 1, 0); PG8_STAGE(PG8_SA(0, 1), a2 + hstepA, voffA);
            PG8_WAIT_V(8); PG8_WAIT_L(0); PG8_BAR; PG8_MMA(0, 0, At, B0); PG8_MMA(0, 1, At, B1); PG8_BAR; PG8_SCHED;
            PG8_LDA(At, 1, 1); PG8_STAGE(PG8_SB(1, 0), b3, voffB); PG8_STAGE(PG8_SB(1, 1), b3 + hstepB, voffB); PG8_STAGE(PG8_SA(1, 0), a3, voffA);
            PG8_WAIT_V(8); PG8_WAIT_L(0); PG8_BAR; PG8_MMA(1, 0, At, B0); PG8_MMA(1, 1, At, B1); PG8_BAR; PG8_SCHED;
        }
        if constexpr (ALIGN_EPI) { if (wr == 0) PG8_BAR; }
        E(acc, cur, wr, wc, fr, fq);
        if (!has_next) break;
#pragma unroll
        for (int a = 0; a < 2; ++a)
#pragma unroll
            for (int b = 0; b < 2; ++b)
#pragma unroll
                for (int m = 0; m < 4; ++m)
#pragma unroll
                    for (int n = 0; n < 2; ++n) acc[a][b][m][n] = (f32x4){0.f, 0.f, 0.f, 0.f};
        cur = nxt; cA = nA; cB = nB; ++ui;
        if constexpr (ALIGN_EPI) { if (wr == 1) PG8_BAR; }
    }
    PG8_WAIT_V(0);
    if constexpr (!ALIGN_EPI) { if (wr == 0) PG8_BAR; }
    PG8_BAR;
#undef PG8_SA
#undef PG8_SB
#undef PG8_STAGE
#undef PG8_LDA
#undef PG8_LDB
#undef PG8_MMA
#undef PG8_WAIT_V
#undef PG8_WAIT_L
#undef PG8_BAR
#undef PG8_SCHED
}
}

constexpr int NB = 2, S = 8192, D = 1024, T = NB * S, FF = 4096;
constexpr int ZC = 6912;
constexpr int C_U = 0, C_V = 1024, C_Q = 2048, C_KCMP = 3072, C_VCMP = 3328, C_KSLC = 3584, C_VSLC = 3840, C_KWIN = 4096, C_VWIN = 4352, C_GN = 4608, C_GA = 4656, C_GB = 5680;
constexpr float ALPHA = 1.189207115002721f;
constexpr float QSCALE = 0.125f * 1.4426950408889634f;
constexpr float XSCALE = 0.0625f * 1.4426950408889634f;
constexpr float LN_EPS = 1e-5f;
constexpr size_t MiB = 1u << 20;
constexpr size_t WS_Z = 0, WS_KCMPT = 216 * MiB, WS_VCMPT = 224 * MiB, WS_VSLCT = 232 * MiB, WS_VWINT = 240 * MiB, WS_HDNK = 248 * MiB, WS_HDNV = 250 * MiB,
                 WS_KC = 252 * MiB, WS_VCT = 252 * MiB + 512 * 1024, WS_WOUT_T = 253 * MiB, WS_C1 = 255 * MiB, WS_W2KT = 255 * MiB + 4096, WS_W2VT = 255 * MiB + 65536, WS_WSTRIL = 255 * MiB + 131072, WS_C1P = 255 * MiB + 524288;
constexpr size_t WS_HF = 0, WS_HB = 64 * MiB, WS_XQ = 96 * MiB, WS_XO = 128 * MiB, WS_ACCF = 160 * MiB, WS_FFB = 96 * MiB,
                 WS_WXQ_T = 224 * MiB, WS_WXO_T = 226 * MiB, WS_WFF1_T = 228 * MiB, WS_WFF2_T = 236 * MiB;
constexpr size_t DO_H0B = 0, DO_MIX = 0, DO_WIN_T = 32 * MiB, DO_WXKV_T = 46 * MiB, DO_MEMB = 50 * MiB, DO_XKV = 51 * MiB, DO_XVT = 53 * MiB, DO_ROPE = 54 * MiB, DO_W1KT = 55 * MiB, DO_W1VT = 56 * MiB;
constexpr int LDS_BYTES = 147456;

struct Args { const float* in[32]; float* out; unsigned char* ws; int ph_lo, ph_hi; };

__device__ __forceinline__ void tr_item(const float* W, int K, int N, int Npad, bf16_t* WT, LAS float* scr, int item, int lane) {
    const int nblk = Npad / 32, kb = item / nblk, nb = item % nblk, k0 = 64 * kb, n0 = 32 * nb;
    const int cc = n0 + (lane & 31);
#pragma unroll 8
    for (int i = 0; i < 32; ++i) { const int kk = 2 * i + (lane >> 5); scr[kk * 33 + (lane & 31)] = (cc < N) ? W[(size_t)(k0 + kk) * N + cc] : 0.f; }
    LDS_WAIT();
    const int c = lane & 7;
#pragma unroll
    for (int j = 0; j < 4; ++j) { const int n = (lane >> 3) + 8 * j; const LAS float* s = scr + (8 * c) * 33 + n;
        u32x4 o; o.x = pk2(s[0 * 33], s[1 * 33]); o.y = pk2(s[2 * 33], s[3 * 33]); o.z = pk2(s[4 * 33], s[5 * 33]); o.w = pk2(s[6 * 33], s[7 * 33]);
        *(u32x4*)(WT + (size_t)(n0 + n) * K + k0 + 8 * c) = o; }
    LDS_WAIT();
}

__device__ __forceinline__ void ln_apply(f32x4 (&v)[4], const float* g, const float* b, int lane) {
    float s = 0.f;
#pragma unroll
    for (int j = 0; j < 4; ++j) s += (v[j].x + v[j].y) + (v[j].z + v[j].w);
    const float mean = wave_sum(s) * (1.f / 1024.f); float s2 = 0.f;
#pragma unroll
    for (int j = 0; j < 4; ++j) { v[j] = v[j] - mean; s2 += (v[j].x * v[j].x + v[j].y * v[j].y) + (v[j].z * v[j].z + v[j].w * v[j].w); }
    const float rstd = 1.f / sqrtf(wave_sum(s2) * (1.f / 1024.f) + LN_EPS);
#pragma unroll
    for (int j = 0; j < 4; ++j) { const f32x4 gg = *(const f32x4*)(g + 4 * lane + 256 * j), bb = *(const f32x4*)(b + 4 * lane + 256 * j); v[j] = v[j] * rstd * gg + bb; }
}
__device__ __forceinline__ void row_load(f32x4 (&v)[4], const float* p, int lane) {
#pragma unroll
    for (int j = 0; j < 4; ++j) v[j] = *(const f32x4*)(p + 4 * lane + 256 * j);
}
__device__ __forceinline__ void row_store_f32(const f32x4 (&v)[4], float* p, int lane) {
#pragma unroll
    for (int j = 0; j < 4; ++j) *(f32x4*)(p + 4 * lane + 256 * j) = v[j];
}
__device__ __forceinline__ void row_store_bf16(const f32x4 (&v)[4], bf16_t* p, int lane) {
#pragma unroll
    for (int j = 0; j < 4; ++j) { u32x2 w; w.x = pk2(v[j].x, v[j].y); w.y = pk2(v[j].z, v[j].w); *(u32x2*)(p + 4 * lane + 256 * j) = w; }
}

#define MFMA16(a, b, c) __builtin_amdgcn_mfma_f32_16x16x32_bf16((a), (b), (c), 0, 0, 0)

__device__ __forceinline__ void qk32(const bf16_t* kp, size_t t1off, bf16x8 qf0, bf16x8 qf1, f32x4& s0, f32x4& s1) {
    const bf16x8 k00 = *(const bf16x8*)(kp), k01 = *(const bf16x8*)(kp + 32), k10 = *(const bf16x8*)(kp + t1off), k11 = *(const bf16x8*)(kp + t1off + 32);
    const f32x4 z = {0.f, 0.f, 0.f, 0.f};
    s0 = MFMA16(k00, qf0, z); s0 = MFMA16(k01, qf1, s0); s1 = MFMA16(k10, qf0, z); s1 = MFMA16(k11, qf1, s1);
}
__device__ __forceinline__ void pv32(const bf16_t* vp, size_t dtoff, bf16x8 pb, f32x4 (&o)[4]) {
#pragma unroll
    for (int dt = 0; dt < 4; ++dt) { const u32x2 lo = *(const u32x2*)(vp + dt * dtoff), hi = *(const u32x2*)(vp + dt * dtoff + 16);
        u32x4 w; w.x = lo.x; w.y = lo.y; w.z = hi.x; w.w = hi.y; o[dt] = MFMA16(__builtin_bit_cast(bf16x8, w), pb, o[dt]); }
}
__device__ __forceinline__ unsigned cvtpk(float lo, float hi) { unsigned r; asm volatile("v_cvt_pk_bf16_f32 %0, %1, %2" : "=v"(r) : "v"(lo), "v"(hi)); return r; }
__device__ __forceinline__ bf16x8 pack_p(const float (&p)[8]) { u32x4 w; w.x = cvtpk(p[0], p[1]); w.y = cvtpk(p[2], p[3]); w.z = cvtpk(p[4], p[5]); w.w = cvtpk(p[6], p[7]); return __builtin_bit_cast(bf16x8, w); }
__device__ __forceinline__ float dpp_xor1(float v) { return __builtin_bit_cast(float, __builtin_amdgcn_mov_dpp(__builtin_bit_cast(int, v), 0xB1, 0xF, 0xF, true)); }
__device__ __forceinline__ float dpp_xor2(float v) { return __builtin_bit_cast(float, __builtin_amdgcn_mov_dpp(__builtin_bit_cast(int, v), 0x4E, 0xF, 0xF, true)); }
__device__ __forceinline__ bf16x8 osm_step(f32x4 s0, f32x4 s1, unsigned vm, float& m, float& l, f32x4 (&o)[4]) {
    const float NINF = -__builtin_inff();
#pragma unroll
    for (int e = 0; e < 4; ++e) { s0[e] = ((vm >> e) & 1u) ? s0[e] : NINF; s1[e] = ((vm >> (4 + e)) & 1u) ? s1[e] : NINF; }
    float mx = fmaxf(fmaxf(fmaxf(s0[0], s0[1]), fmaxf(s0[2], s0[3])), fmaxf(fmaxf(s1[0], s1[1]), fmaxf(s1[2], s1[3])));
    if (__ballot(mx > m + 8.f) != 0ull) {
        float r = fmaxf(mx, __shfl_xor(mx, 16)); r = fmaxf(r, __shfl_xor(r, 32));
        const float mn = fmaxf(m, r), alpha = __builtin_amdgcn_exp2f(m - mn); m = mn; l *= alpha;
#pragma unroll
        for (int dt = 0; dt < 4; ++dt) o[dt] = o[dt] * alpha;
    }
    float p[8];
#pragma unroll
    for (int e = 0; e < 4; ++e) { p[e] = __builtin_amdgcn_exp2f(s0[e] - m); p[4 + e] = __builtin_amdgcn_exp2f(s1[e] - m); }
    l += ((p[0] + p[1]) + (p[2] + p[3])) + ((p[4] + p[5]) + (p[6] + p[7]));
    return pack_p(p);
}

__global__ void __launch_bounds__(512, 2) mk_fwd(Args a) {
    extern __shared__ __attribute__((aligned(16))) unsigned char lds_raw[];
    LAS unsigned char* lds = (LAS unsigned char*)lds_raw;
    cg::grid_group grid = cg::this_grid();
    const int tid = threadIdx.x, lane = tid & 63, wid = __builtin_amdgcn_readfirstlane(tid >> 6);
    const int G = gridDim.x, gw = blockIdx.x * 8 + wid, NGW = G * 8, gtid = blockIdx.x * 512 + tid, NGT = G * 512;
    unsigned char* ws = a.ws; unsigned char* dout = (unsigned char*)a.out;
    const int lo = a.ph_lo, hi = a.ph_hi;
#define IN(k) (lo <= (k) && (k) < hi)
#define SYNC(k) do { if (IN(k) && IN((k) + 1)) grid.sync(); } while (0)
#ifndef PROBE_PH
#define PROBE_PH -1
#endif
#ifndef PROBE_N
#define PROBE_N 2
#endif
#define RPT(k) for (int rp_ = 0; rp_ < ((k) == PROBE_PH ? PROBE_N : 1); ++rp_, ((k) == PROBE_PH && rp_ < PROBE_N) ? grid.sync() : (void)0)
    bf16_t* const Z = (bf16_t*)(ws + WS_Z);
    float* const ROPE = (float*)(dout + DO_ROPE);

    if (IN(0)) RPT(0) {
        LAS float* scr = (LAS float*)(lds + wid * 8448);
        constexpr int I_WIN = 16 * 216, I_XKV = 16 * 64, I_W1 = 32 * 8, I_W2 = 4 * 2, I_WOUT = 16 * 32;
        constexpr int NIT = I_WIN + I_XKV + 2 * I_W1 + 2 * I_W2 + I_WOUT;
        for (int it = gw; it < NIT; it += NGW) { int r = it;
            if (r < I_WIN) { tr_item(a.in[5], 1024, 6704, 6912, (bf16_t*)(dout + DO_WIN_T), scr, r, lane); continue; } r -= I_WIN;
            if (r < I_XKV) { tr_item(a.in[24], 1024, 2048, 2048, (bf16_t*)(dout + DO_WXKV_T), scr, r, lane); continue; } r -= I_XKV;
            if (r < I_W1) { tr_item(a.in[11], 2048, 256, 256, (bf16_t*)(dout + DO_W1KT), scr, r, lane); continue; } r -= I_W1;
            if (r < I_W1) { tr_item(a.in[16], 2048, 256, 256, (bf16_t*)(dout + DO_W1VT), scr, r, lane); continue; } r -= I_W1;
            if (r < I_W2) { tr_item(a.in[13], 256, 64, 64, (bf16_t*)(ws + WS_W2KT), scr, r, lane); continue; } r -= I_W2;
            if (r < I_W2) { tr_item(a.in[18], 256, 64, 64, (bf16_t*)(ws + WS_W2VT), scr, r, lane); continue; } r -= I_W2;
            tr_item(a.in[20], 1024, 1024, 1024, (bf16_t*)(ws + WS_WOUT_T), scr, r, lane);
        }
        for (int m = gw; m < T; m += NGW) { f32x4 v[4]; row_load(v, a.in[0] + (size_t)m * D, lane); ln_apply(v, a.in[3], a.in[4], lane); row_store_bf16(v, (bf16_t*)(dout + DO_H0B) + (size_t)m * D, lane); }
        for (int i = gtid; i < 512 * 1024 / 4; i += NGT) { const f32x4 v = *(const f32x4*)(a.in[1] + 4 * (size_t)i); u32x2 w; w.x = pk2(v.x, v.y); w.y = pk2(v.z, v.w); *(u32x2*)((bf16_t*)(dout + DO_MEMB) + 4 * (size_t)i) = w; }
        for (int i = gtid; i < T * 8; i += NGT) { const int tok = i >> 3, fi = i & 7; const int pos = ((const int*)a.in[2])[tok];
            float inv = 1.0f;
            inv = fi == 1 ? 0.19392274474868576f : inv; inv = fi == 2 ? 0.03760603093086393f : inv; inv = fi == 3 ? 0.007292664737217109f : inv; inv = fi == 4 ? 0.001414213562373095f : inv;
            inv = fi == 5 ? 0.0002742481756762073f : inv; inv = fi == 6 ? 5.318295896944988e-05f : inv; inv = fi == 7 ? 1.031338537721246e-05f : inv;
            const float ang = (float)pos * inv; ROPE[tok * 16 + fi] = cosf(ang); ROPE[tok * 16 + 8 + fi] = sinf(ang); }
        for (int i = gtid; i < 8 * 128 * 128; i += NGT) { const int t = (i >> 7) & 127, s = i & 127; const float w = a.in[8][i]; ((bf16_t*)(ws + WS_WSTRIL))[i] = (bf16_t)(s <= t ? f2bf(w) : 0u); }
        for (int job = blockIdx.x; job < 64; job += G) if (tid < 256) { const int mat = job >> 5, ks = job & 31; const float* pe = a.in[mat ? 15 : 10] + ks * 64; const float* w1 = a.in[mat ? 16 : 11] + (size_t)ks * 64 * 256 + tid; float sum = 0.f;
#pragma unroll 16
            for (int k = 0; k < 64; ++k) sum += pe[k] * w1[(size_t)k * 256];
            ((float*)(ws + WS_C1P))[job * 256 + tid] = sum; }
    }
    SYNC(0);

    if (IN(1)) RPT(1) {
        { pg8::Gemm g{(const bf16_t*)(dout + DO_H0B), (const bf16_t*)(dout + DO_WIN_T), T, ZC, D, D}; pg8::StaticOrder So; So.init(T, ZC, G, (int)blockIdx.x);
          pg8::EpiBf16<0> E{Z, ZC, nullptr, 1.f}; pg8::gemm_phase<pg8::EpiBf16<0>, pg8::StaticOrder, true>(lds, g, So, E); }
        { pg8::Gemm g{(const bf16_t*)(dout + DO_MEMB), (const bf16_t*)(dout + DO_WXKV_T), 512, 2048, D, D}; pg8::StaticOrder So; So.init(512, 2048, G, (G - 1) - (int)blockIdx.x);
          pg8::EpiBf16<0> E{(bf16_t*)(dout + DO_XKV), 2048, nullptr, 1.f}; pg8::gemm_phase<pg8::EpiBf16<0>, pg8::StaticOrder, true>(lds, g, So, E); }
    }
    SYNC(1);

    if (IN(2)) RPT(2) {
        bf16_t* const KCMPT = (bf16_t*)(ws + WS_KCMPT); bf16_t* const VCMPT = (bf16_t*)(ws + WS_VCMPT);
        for (int tok = gw; tok < T; tok += NGW) {
            bf16_t* zr = Z + (size_t)tok * ZC; const int b = tok >> 13, t = tok & 8191;
            float rc[8], rs[8];
            { const f32x4 c0 = *(const f32x4*)(ROPE + tok * 16), c1 = *(const f32x4*)(ROPE + tok * 16 + 4), s0 = *(const f32x4*)(ROPE + tok * 16 + 8), s1 = *(const f32x4*)(ROPE + tok * 16 + 12);
#pragma unroll
              for (int e = 0; e < 4; ++e) { rc[e] = c0[e]; rc[4 + e] = c1[e]; rs[e] = s0[e]; rs[4 + e] = s1[e]; } }
            { const u32x4 w0 = *(const u32x4*)(zr + C_V + 16 * lane), w1 = *(const u32x4*)(zr + C_V + 16 * lane + 8); float f[16];
#pragma unroll
              for (int e = 0; e < 4; ++e) { f[2 * e] = bflo(w0[e]); f[2 * e + 1] = bfhi(w0[e]); f[8 + 2 * e] = bflo(w1[e]); f[8 + 2 * e + 1] = bfhi(w1[e]); }
              float s = 0.f;
#pragma unroll
              for (int e = 0; e < 16; ++e) { f[e] = gelu_t(f[e]); s += f[e]; }
              const float mean = wave_sum(s) * (1.f / 1024.f); float s2 = 0.f;
#pragma unroll
              for (int e = 0; e < 16; ++e) { f[e] -= mean; s2 += f[e] * f[e]; }
              const float rstd = 1.f / sqrtf(wave_sum(s2) * (1.f / 1024.f) + LN_EPS);
              const float* gg = a.in[6] + 16 * lane; const float* bb = a.in[7] + 16 * lane; u32x4 o0, o1;
#pragma unroll
              for (int e = 0; e < 4; ++e) { o0[e] = pk2(f[2 * e] * rstd * gg[2 * e] + bb[2 * e], f[2 * e + 1] * rstd * gg[2 * e + 1] + bb[2 * e + 1]);
                                            o1[e] = pk2(f[8 + 2 * e] * rstd * gg[8 + 2 * e] + bb[8 + 2 * e], f[9 + 2 * e] * rstd * gg[9 + 2 * e] + bb[9 + 2 * e]); }
              *(u32x4*)(zr + C_V + 16 * lane) = o0; *(u32x4*)(zr + C_V + 16 * lane + 8) = o1; }
            { const u32x4 w0 = *(const u32x4*)(zr + C_Q + 16 * lane), w1 = *(const u32x4*)(zr + C_Q + 16 * lane + 8); float f[16];
#pragma unroll
              for (int e = 0; e < 4; ++e) { f[2 * e] = bflo(w0[e]); f[2 * e + 1] = bfhi(w0[e]); f[8 + 2 * e] = bflo(w1[e]); f[8 + 2 * e + 1] = bfhi(w1[e]); }
              if ((lane & 3) == 0) {
#pragma unroll
                  for (int i = 0; i < 8; ++i) { const float x1 = f[i], x2 = f[8 + i]; f[i] = x1 * rc[i] - x2 * rs[i]; f[8 + i] = x2 * rc[i] + x1 * rs[i]; } }
              u32x4 o0, o1;
#pragma unroll
              for (int e = 0; e < 4; ++e) { o0[e] = pk2(f[2 * e] * QSCALE, f[2 * e + 1] * QSCALE); o1[e] = pk2(f[8 + 2 * e] * QSCALE, f[9 + 2 * e] * QSCALE); }
              *(u32x4*)(zr + C_Q + 16 * lane) = o0; *(u32x4*)(zr + C_Q + 16 * lane + 8) = o1; }
            { const int h = lane >> 4, r = lane & 15; const size_t bh = (size_t)(b * 4 + h);
              const f32x4 rcl = *(const f32x4*)(ROPE + tok * 16 + 4 * (r & 1)), rsl = *(const f32x4*)(ROPE + tok * 16 + 8 + 4 * (r & 1));
#pragma unroll
              for (int sg = 0; sg < 6; ++sg) {
                  const u32x2 w = *(const u32x2*)(zr + C_KCMP + sg * 256 + 4 * lane);
                  if (sg == 0) *(u32x2*)(KCMPT + (bh * 8192 + t) * 64 + 4 * r) = w;
                  else if (sg == 1) *(u32x2*)(VCMPT + (bh * 8192 + t) * 64 + 4 * r) = w;
                  else if (sg == 2 || sg == 4) {
                      float x[4] = {bflo(w.x), bfhi(w.x), bflo(w.y), bfhi(w.y)}; float y[4];
#pragma unroll
                      for (int e = 0; e < 4; ++e) { const float other = __shfl_xor(x[e], 2); const float c = rcl[e], sn = rsl[e];
                          y[e] = (r < 2) ? (x[e] * c - other * sn) : ((r < 4) ? (x[e] * c + other * sn) : x[e]); }
                      u32x2 o; o.x = pk2(y[0], y[1]); o.y = pk2(y[2], y[3]); *(u32x2*)(zr + C_KCMP + sg * 256 + 4 * lane) = o;
                  }
              } }
        }
        if (gtid < 512) { const int mat = gtid >> 8, col = gtid & 255; float sum = a.in[mat ? 17 : 12][col];
            for (int ks = 0; ks < 32; ++ks) sum += ((const float*)(ws + WS_C1P))[(mat * 32 + ks) * 256 + col];
            ((float*)(ws + WS_C1))[gtid] = sum; }
        for (int i = gtid; i < 512 * 128; i += NGT) { const int mrow = i >> 7, cgp = i & 127; const u32x4 w = *(const u32x4*)((const bf16_t*)(dout + DO_XKV) + (size_t)mrow * 2048 + 1024 + 8 * cgp);
            bf16_t* p = (bf16_t*)(dout + DO_XVT) + ((size_t)((mrow >> 8) * 1024 + 8 * cgp)) * 256 + (mrow & 255);
#pragma unroll
            for (int e = 0; e < 4; ++e) { p[(2 * e) * 256] = (bf16_t)(w[e] & 0xffffu); p[(2 * e + 1) * 256] = (bf16_t)(w[e] >> 16); } }
    }
    SYNC(2);

    if (IN(3)) RPT(3) {
        const bf16_t* WSTRIL = (const bf16_t*)(ws + WS_WSTRIL);
        for (int un = blockIdx.x; un < 1024; un += G) {
            const int chunk = un >> 3, g = un & 7; const size_t tokbase = (size_t)chunk * 128;
            LAS bf16_t* vT = (LAS bf16_t*)lds;
#pragma unroll
            for (int i = 0; i < 4; ++i) { const int p = tid + 512 * i, s = p >> 4, c0 = (p & 15) * 8; const u32x4 w = *(const u32x4*)(Z + (tokbase + s) * ZC + C_V + g * 128 + c0);
#pragma unroll
                for (int e = 0; e < 4; ++e) { vT[(c0 + 2 * e) * 136 + s] = (bf16_t)(w[e] & 0xffffu); vT[(c0 + 2 * e + 1) * 136 + s] = (bf16_t)(w[e] >> 16); } }
            __syncthreads();
            const int j = lane & 15, q4 = lane >> 4, t = 16 * wid + j;
            f32x4 acc[8];
#pragma unroll
            for (int it = 0; it < 8; ++it) acc[it] = (f32x4){0.f, 0.f, 0.f, 0.f};
            const int nks = (16 * wid + 15) / 32 + 1;
            for (int ks = 0; ks < nks; ++ks) { const bf16x8 wf = *(const bf16x8*)(WSTRIL + (size_t)g * 16384 + t * 128 + 32 * ks + 8 * q4);
#pragma unroll
                for (int it = 0; it < 8; ++it) { const bf16x8 vf = *(const LAS bf16x8*)(vT + (16 * it + j) * 136 + 32 * ks + 8 * q4); acc[it] = MFMA16(vf, wf, acc[it]); } }
            const float bsv = a.in[9][g * 128 + t]; bf16_t* zr = Z + (tokbase + t) * ZC;
#pragma unroll
            for (int it = 0; it < 8; ++it) { const int c = g * 128 + 16 * it + 4 * q4; const u32x2 uw = *(const u32x2*)(zr + C_U + c), gaw = *(const u32x2*)(zr + C_GA + c);
                const float u0 = bflo(uw.x), u1 = bfhi(uw.x), u2 = bflo(uw.y), u3 = bfhi(uw.y), g0 = bflo(gaw.x), g1 = bfhi(gaw.x), g2 = bflo(gaw.y), g3 = bfhi(gaw.y);
                u32x2 o; o.x = pk2(gelu_t(u0) * (acc[it][0] + bsv) * sigm(g0), gelu_t(u1) * (acc[it][1] + bsv) * sigm(g1)); o.y = pk2(gelu_t(u2) * (acc[it][2] + bsv) * sigm(g2), gelu_t(u3) * (acc[it][3] + bsv) * sigm(g3));
                *(u32x2*)(zr + C_U + c) = o; }
            __syncthreads();
        }
        { pg8::Gemm g{(const bf16_t*)(ws + WS_KCMPT), (const bf16_t*)(dout + DO_W1KT), 4096, 256, 2048, 1024}; pg8::StaticOrder So; So.init(4096, 256, G, (int)blockIdx.x);
          pg8::EpiBf16<2> E{(bf16_t*)(ws + WS_HDNK), 256, (const float*)(ws + WS_C1), 1.f}; pg8::gemm_phase<pg8::EpiBf16<2>, pg8::StaticOrder, true>(lds, g, So, E); }
        { pg8::Gemm g{(const bf16_t*)(ws + WS_VCMPT), (const bf16_t*)(dout + DO_W1VT), 4096, 256, 2048, 1024}; pg8::StaticOrder So; So.init(4096, 256, G, (G - 1) - (int)blockIdx.x);
          pg8::EpiBf16<2> E{(bf16_t*)(ws + WS_HDNV), 256, (const float*)(ws + WS_C1) + 256, 1.f}; pg8::gemm_phase<pg8::EpiBf16<2>, pg8::StaticOrder, true>(lds, g, So, E); }
    }
    SYNC(3);

    if (IN(4)) RPT(4) {
        for (int u = gw; u < 512; u += NGW) {
            const int mat = u >> 8, r0 = (u & 255) * 16, j = lane & 15, q4 = lane >> 4;
            const bf16_t* HDN = (const bf16_t*)(ws + (mat ? WS_HDNV : WS_HDNK)); const bf16_t* W2T = (const bf16_t*)(ws + (mat ? WS_W2VT : WS_W2KT)); const float* b2 = a.in[mat ? 19 : 14];
            f32x4 acc[4];
#pragma unroll
            for (int it = 0; it < 4; ++it) acc[it] = (f32x4){0.f, 0.f, 0.f, 0.f};
#pragma unroll
            for (int ks = 0; ks < 8; ++ks) { const bf16x8 hb = *(const bf16x8*)(HDN + (size_t)(r0 + j) * 256 + 32 * ks + 8 * q4);
#pragma unroll
                for (int it = 0; it < 4; ++it) { const bf16x8 wf = *(const bf16x8*)(W2T + (16 * it + j) * 256 + 32 * ks + 8 * q4); acc[it] = MFMA16(wf, hb, acc[it]); } }
            const int r = r0 + j, bh = r >> 9, n = r & 511, b = bh >> 2;
#pragma unroll
            for (int it = 0; it < 4; ++it) { const f32x4 bv = *(const f32x4*)(b2 + 16 * it + 4 * q4); acc[it] = acc[it] + bv; }
            if (mat == 0) {
                const int pt = 16 * n + 31; const float* rt = ROPE + (size_t)(b * 8192 + (pt < 8192 ? pt : 8191)) * 16;
#pragma unroll
                for (int e = 0; e < 4; ++e) { const float x = acc[0][e], other = __shfl_xor(x, 32); const int fi = 4 * (q4 & 1) + e; const float c = rt[fi], sn = rt[8 + fi];
                    acc[0][e] = (q4 < 2) ? (x * c - other * sn) : (x * c + other * sn); }
#pragma unroll
                for (int it = 0; it < 4; ++it) { u32x2 o; o.x = pk2(acc[it][0], acc[it][1]); o.y = pk2(acc[it][2], acc[it][3]); if (n == 511) { o.x = 0u; o.y = 0u; }
                    *(u32x2*)((bf16_t*)(ws + WS_KC) + (size_t)r * 64 + 16 * it + 4 * q4) = o; }
            } else {
#pragma unroll
                for (int it = 0; it < 4; ++it) { u32x2 o; o.x = pk2(acc[it][0], acc[it][1]); o.y = pk2(acc[it][2], acc[it][3]); if (n == 511) { o.x = 0u; o.y = 0u; }
                    *(u32x2*)((bf16_t*)(ws + WS_VCT) + (size_t)r * 64 + 16 * it + 4 * q4) = o; }
            }
        }
    }
    SYNC(4);

    if (IN(5)) RPT(5) {
        const bf16_t* KC = (const bf16_t*)(ws + WS_KC); const bf16_t* VC = (const bf16_t*)(ws + WS_VCT);
        bf16_t* MIX = (bf16_t*)(dout + DO_MIX);
        LAS bf16_t* const KBb = (LAS bf16_t*)lds; LAS bf16_t* const VBb = (LAS bf16_t*)(lds + 18432);
        LAS float* wl = (LAS float*)(lds + 36864 + wid * 4352);
        LAS unsigned* wgum = (LAS unsigned*)(lds + 36864 + 8 * 4352);
        LAS unsigned char* blist = (LAS unsigned char*)(wgum + 8);
        const int j = lane & 15, q4 = lane >> 4, tk = j >> 2, hd = j & 3;
        const int skey = tid >> 3, sc = tid & 7;
#define STG_K(R, base, pitch) R.k = *(const u32x4*)((base) + (size_t)skey * (pitch) + 8 * sc)
#define STG_V(R, base, pitch) R.v = *(const u32x4*)((base) + (size_t)skey * (pitch) + 8 * sc)
#define STS_K(R, buf) *(LAS u32x4*)(KBb + (buf) * 4608 + skey * 72 + 8 * sc) = R.k
#define STS_V(R, buf) do { LAS bf16_t* vb_ = VBb + (buf) * 4608 + (8 * sc) * 72 + (skey ^ (sc << 3)); _Pragma("unroll") for (int e_ = 0; e_ < 4; ++e_) { vb_[(2 * e_) * 72] = (bf16_t)(R.v[e_] & 0xffffu); vb_[(2 * e_ + 1) * 72] = (bf16_t)(R.v[e_] >> 16); } } while (0)
#define QK_LDS(buf, kl, s0, s1) do { const LAS bf16_t* p_ = KBb + (buf) * 4608 + ((kl) + j) * 72 + 8 * q4; const f32x4 z_ = {0.f, 0.f, 0.f, 0.f}; \
            const bf16x8 k00_ = *(const LAS bf16x8*)p_, k01_ = *(const LAS bf16x8*)(p_ + 32), k10_ = *(const LAS bf16x8*)(p_ + 16 * 72), k11_ = *(const LAS bf16x8*)(p_ + 16 * 72 + 32); \
            s0 = MFMA16(k00_, qf0, z_); s0 = MFMA16(k01_, qf1, s0); s1 = MFMA16(k10_, qf0, z_); s1 = MFMA16(k11_, qf1, s1); } while (0)
#define PV_LDS(buf, kl, pb, o) do { _Pragma("unroll") for (int dt_ = 0; dt_ < 4; ++dt_) { const int cx_ = ((2 * dt_ + (j >> 3)) & 7) << 3; const LAS bf16_t* v_ = VBb + (buf) * 4608 + (16 * dt_ + j) * 72; \
            const u32x2 lo_ = *(const LAS u32x2*)(v_ + (((kl) + 4 * q4) ^ cx_)), hi_ = *(const LAS u32x2*)(v_ + (((kl) + 16 + 4 * q4) ^ cx_)); u32x4 w_; w_.x = lo_.x; w_.y = lo_.y; w_.z = hi_.x; w_.w = hi_.y; \
            o[dt_] = MFMA16(__builtin_bit_cast(bf16x8, w_), pb, o[dt_]); } } while (0)
        struct StageRegs { u32x4 k, v; };
        for (int uu = blockIdx.x; uu < 2048; uu += G) {
            const int bhu = uu >> 8; int tb = uu & 255; if (bhu & 1) tb = 255 - tb;
            const int b = bhu >> 2, kvh = bhu & 3, t0w = 32 * tb, t0 = t0w + 4 * wid, t = t0 + tk; const size_t tok = (size_t)b * S + t, bh = (size_t)bhu;
            const bf16_t* zr = Z + tok * ZC; const int head = kvh * 4 + hd;
            const bf16x8 qf0 = *(const bf16x8*)(zr + C_Q + head * 64 + 8 * q4), qf1 = *(const bf16x8*)(zr + C_Q + head * 64 + 32 + 8 * q4);
            for (int i = lane; i < 1040; i += 64) wl[i] = 0.f;
            if (tid < 8) wgum[tid] = 0u;
            const float gcm = sigm(bf1(zr[C_GN + head * 3 + 0])), gsl = sigm(bf1(zr[C_GN + head * 3 + 1])), gwn = sigm(bf1(zr[C_GN + head * 3 + 2]));
            f32x4 yb[4];
#pragma unroll
            for (int dt = 0; dt < 4; ++dt) yb[dt] = (f32x4){0.f, 0.f, 0.f, 0.f};
            __syncthreads();
            const int ncw = (t0w + 31 >= 31) ? (((t0w + 31 - 31) >> 4) + 1) : 0;
            const int ncmax = (t0 + 3 >= 31) ? (((t0 + 3 - 31) >> 4) + 1) : 0;
            const int nvalid = (t >= 31) ? (((t - 31) >> 4) + 1) : 0;
            const int nb_c = (ncw + 63) >> 6;
            {
                float m = -1e30f, l = 0.f;
                const bf16_t* kcb = KC + bh * 512 * 64;
                { StageRegs R; STG_K(R, kcb, 64);
                  for (int n = 0; n < nb_c; ++n) { const int buf = n & 1; STS_K(R, buf); __syncthreads(); if (n + 1 < nb_c) STG_K(R, kcb + (size_t)(n + 1) * 4096, 64);
#pragma unroll
                    for (int hf = 0; hf < 2; ++hf) { const int kb = 64 * n + 32 * hf; if (kb < ncmax) { f32x4 s0, s1; QK_LDS(buf, 32 * hf, s0, s1);
                        float mx = -1e30f;
#pragma unroll
                        for (int e = 0; e < 4; ++e) { if (kb + 4 * q4 + e < nvalid) mx = fmaxf(mx, s0[e]); if (kb + 16 + 4 * q4 + e < nvalid) mx = fmaxf(mx, s1[e]); }
                        mx = fmaxf(mx, __shfl_xor(mx, 16)); mx = fmaxf(mx, __shfl_xor(mx, 32));
                        const float mn = fmaxf(m, mx); float ps = 0.f;
#pragma unroll
                        for (int e = 0; e < 4; ++e) { if (kb + 4 * q4 + e < nvalid) ps += __builtin_amdgcn_exp2f(s0[e] - mn); if (kb + 16 + 4 * q4 + e < nvalid) ps += __builtin_amdgcn_exp2f(s1[e] - mn); }
                        l = l * __builtin_amdgcn_exp2f(m - mn) + ps; m = mn; } } } }
                l += __shfl_xor(l, 16); l += __shfl_xor(l, 32);
                const float invl = l > 0.f ? 1.f / l : 0.f;
                f32x4 o[4];
#pragma unroll
                for (int dt = 0; dt < 4; ++dt) o[dt] = (f32x4){0.f, 0.f, 0.f, 0.f};
                __syncthreads();
                const bf16_t* vcb = VC + bh * 512 * 64;
                { StageRegs R; STG_K(R, kcb, 64); STG_V(R, vcb, 64);
                  for (int n = 0; n < nb_c; ++n) { const int buf = n & 1; STS_K(R, buf); STS_V(R, buf); __syncthreads(); if (n + 1 < nb_c) { STG_K(R, kcb + (size_t)(n + 1) * 4096, 64); STG_V(R, vcb + (size_t)(n + 1) * 4096, 64); }
#pragma unroll
                    for (int hf = 0; hf < 2; ++hf) { const int kb = 64 * n + 32 * hf; if (kb < ncmax) { f32x4 s0, s1; QK_LDS(buf, 32 * hf, s0, s1);
                        float p[8];
#pragma unroll
                        for (int e = 0; e < 4; ++e) { p[e] = (kb + 4 * q4 + e < nvalid) ? __builtin_amdgcn_exp2f(s0[e] - m) * invl : 0.f; p[4 + e] = (kb + 16 + 4 * q4 + e < nvalid) ? __builtin_amdgcn_exp2f(s1[e] - m) * invl : 0.f; }
                        float a0 = (p[0] + p[1]) + (p[2] + p[3]), a1 = (p[4] + p[5]) + (p[6] + p[7]), x0 = p[3], x1 = p[7];
                        a0 += dpp_xor1(a0); a0 += dpp_xor2(a0); a1 += dpp_xor1(a1); a1 += dpp_xor2(a1);
                        x0 += dpp_xor1(x0); x0 += dpp_xor2(x0); x1 += dpp_xor1(x1); x1 += dpp_xor2(x1);
                        if (hd == 0) { const int jj0 = (kb >> 2) + q4, jj1 = jj0 + 4; wl[tk * 128 + jj0] = a0; wl[tk * 128 + jj1] = a1; wl[512 + tk * 132 + jj0 + 1] = x0; wl[512 + tk * 132 + jj1 + 1] = x1; }
                        const bf16x8 pb = pack_p(p); PV_LDS(buf, 32 * hf, pb, o); } } } }
#pragma unroll
                for (int dt = 0; dt < 4; ++dt) yb[dt] = yb[dt] + o[dt] * gcm;
            }
            LDS_WAIT();
            unsigned mysel[4], um[4];
            {
                const int tk2 = lane >> 4, r = lane & 15, cur = t0 >> 6;
                float val[8];
#pragma unroll
                for (int mm = 0; mm < 8; ++mm) { const int jj = r + 16 * mm; const float pvv = wl[tk2 * 128 + jj] + wl[512 + tk2 * 132 + jj];
                    const bool forced = (jj == 0) | (jj == cur) | (jj == cur - 1);
                    val[mm] = forced ? __builtin_inff() : (jj <= cur ? pvv : -__builtin_inff()); }
                LDS_WAIT();
#pragma unroll
                for (int mm = 0; mm < 8; ++mm) wl[tk2 * 128 + r + 16 * mm] = val[mm];
                LDS_WAIT();
                int rank[8];
#pragma unroll
                for (int mm = 0; mm < 8; ++mm) rank[mm] = 0;
                for (int jp = 0; jp <= cur; ++jp) { const float vp = wl[tk2 * 128 + jp];
#pragma unroll
                    for (int mm = 0; mm < 8; ++mm) rank[mm] += ((vp > val[mm]) || (vp == val[mm] && jp < r + 16 * mm)) ? 1 : 0; }
                unsigned long long bm[8];
#pragma unroll
                for (int mm = 0; mm < 8; ++mm) bm[mm] = __ballot((r + 16 * mm <= cur) && rank[mm] < 16);
#pragma unroll
                for (int w = 0; w < 4; ++w) { const unsigned long long b0 = bm[2 * w], b1 = bm[2 * w + 1];
                    mysel[w] = (unsigned)((b0 >> (16 * tk)) & 0xFFFFull) | ((unsigned)((b1 >> (16 * tk)) & 0xFFFFull) << 16);
                    const unsigned u0 = (unsigned)((b0 | (b0 >> 16) | (b0 >> 32) | (b0 >> 48)) & 0xFFFFull), u1 = (unsigned)((b1 | (b1 >> 16) | (b1 >> 32) | (b1 >> 48)) & 0xFFFFull);
                    um[w] = (unsigned)__builtin_amdgcn_readfirstlane((int)(u0 | (u1 << 16))); }
                if (lane < 4) { const unsigned v = lane == 0 ? um[0] : (lane == 1 ? um[1] : (lane == 2 ? um[2] : um[3])); atomicOr((unsigned*)(wgum + lane), v); }
            }
            __syncthreads();
            if (tid < 128) { const int w = tid >> 5, bi = tid & 31; const unsigned w0 = wgum[0], w1 = wgum[1], w2 = wgum[2], w3 = wgum[3]; const unsigned word = w == 0 ? w0 : (w == 1 ? w1 : (w == 2 ? w2 : w3));
                if ((word >> bi) & 1u) { const int pos = (w > 0 ? __builtin_popcount(w0) : 0) + (w > 1 ? __builtin_popcount(w1) : 0) + (w > 2 ? __builtin_popcount(w2) : 0) + __builtin_popcount(word & ((1u << bi) - 1u)); blist[pos] = (unsigned char)tid; }
                if (tid == 0) wgum[4] = (unsigned)(__builtin_popcount(w0) + __builtin_popcount(w1) + __builtin_popcount(w2) + __builtin_popcount(w3)); }
            __syncthreads();
            {
                float m = -1e30f, l = 0.f; f32x4 o[4];
#pragma unroll
                for (int dt = 0; dt < 4; ++dt) o[dt] = (f32x4){0.f, 0.f, 0.f, 0.f};
                const int nb_s = (int)wgum[4];
                const bf16_t* ksb = Z + (size_t)b * S * ZC + C_KSLC + kvh * 64; const bf16_t* vsb = Z + (size_t)b * S * ZC + C_VSLC + kvh * 64;
                StageRegs R; { const int jj0 = blist[0]; STG_K(R, ksb + (size_t)(64 * jj0) * ZC, ZC); STG_V(R, vsb + (size_t)(64 * jj0) * ZC, ZC); }
                for (int n = 0; n < nb_s; ++n) { const int buf = n & 1; const int jj = blist[n]; STS_K(R, buf); STS_V(R, buf); __syncthreads();
                    if (n + 1 < nb_s) { const int jn = blist[n + 1]; STG_K(R, ksb + (size_t)(64 * jn) * ZC, ZC); STG_V(R, vsb + (size_t)(64 * jn) * ZC, ZC); }
                    const unsigned uw = jj < 32 ? um[0] : (jj < 64 ? um[1] : (jj < 96 ? um[2] : um[3]));
                    if ((uw >> (jj & 31)) & 1u) { const unsigned mw = jj < 32 ? mysel[0] : (jj < 64 ? mysel[1] : (jj < 96 ? mysel[2] : mysel[3])); const bool mine = (mw >> (jj & 31)) & 1u;
#pragma unroll
                        for (int hf = 0; hf < 2; ++hf) { const int kb = 64 * jj + 32 * hf;
                            unsigned vm = 0u;
#pragma unroll
                            for (int e = 0; e < 4; ++e) { vm |= (mine && (kb + 4 * q4 + e <= t)) ? (1u << e) : 0u; vm |= (mine && (kb + 16 + 4 * q4 + e <= t)) ? (1u << (4 + e)) : 0u; }
                            if (__ballot(vm != 0u) != 0ull) { f32x4 s0, s1; QK_LDS(buf, 32 * hf, s0, s1); const bf16x8 pb = osm_step(s0, s1, vm, m, l, o); PV_LDS(buf, 32 * hf, pb, o); } } } }
                l += __shfl_xor(l, 16); l += __shfl_xor(l, 32); const float sc2 = (l > 0.f ? 1.f / l : 0.f) * gsl;
#pragma unroll
                for (int dt = 0; dt < 4; ++dt) yb[dt] = yb[dt] + o[dt] * sc2;
            }
            __syncthreads();
            {
                float m = -1e30f, l = 0.f; f32x4 o[4];
#pragma unroll
                for (int dt = 0; dt < 4; ++dt) o[dt] = (f32x4){0.f, 0.f, 0.f, 0.f};
                const int kws = ((t0w - 511 > 0) ? (t0w - 511) : 0) & ~63; const int nb_w = ((t0w + 31 - kws) >> 6) + 1;
                const bf16_t* kwb = Z + ((size_t)b * S + kws) * ZC + C_KWIN + kvh * 64; const bf16_t* vwb = Z + ((size_t)b * S + kws) * ZC + C_VWIN + kvh * 64;
                StageRegs R; STG_K(R, kwb, ZC); STG_V(R, vwb, ZC);
                for (int n = 0; n < nb_w; ++n) { const int buf = n & 1; STS_K(R, buf); STS_V(R, buf); __syncthreads();
                    if (n + 1 < nb_w) { STG_K(R, kwb + (size_t)(64 * (n + 1)) * ZC, ZC); STG_V(R, vwb + (size_t)(64 * (n + 1)) * ZC, ZC); }
                    const int key0 = kws + 64 * n;
                    if (key0 + 63 >= t0 - 511 && key0 <= t0 + 3) {
#pragma unroll
                        for (int hf = 0; hf < 2; ++hf) { const int kb = key0 + 32 * hf;
                            unsigned vm = 0u;
#pragma unroll
                            for (int e = 0; e < 4; ++e) { const int k0 = kb + 4 * q4 + e, k1 = k0 + 16; vm |= (k0 <= t && k0 > t - 512) ? (1u << e) : 0u; vm |= (k1 <= t && k1 > t - 512) ? (1u << (4 + e)) : 0u; }
                            if (__ballot(vm != 0u) != 0ull) { f32x4 s0, s1; QK_LDS(buf, 32 * hf, s0, s1); const bf16x8 pb = osm_step(s0, s1, vm, m, l, o); PV_LDS(buf, 32 * hf, pb, o); } } } }
                l += __shfl_xor(l, 16); l += __shfl_xor(l, 32); const float sc2 = (l > 0.f ? 1.f / l : 0.f) * gwn;
#pragma unroll
                for (int dt = 0; dt < 4; ++dt) yb[dt] = yb[dt] + o[dt] * sc2;
            }
#pragma unroll
            for (int dt = 0; dt < 4; ++dt) { const int c = head * 64 + 16 * dt + 4 * q4; const u32x2 mw = *(const u32x2*)(zr + C_U + c), gw2 = *(const u32x2*)(zr + C_GB + c);
                u32x2 o2; o2.x = pk2(bflo(mw.x) + sigm(bflo(gw2.x)) * yb[dt][0], bfhi(mw.x) + sigm(bfhi(gw2.x)) * yb[dt][1]); o2.y = pk2(bflo(mw.y) + sigm(bflo(gw2.y)) * yb[dt][2], bfhi(mw.y) + sigm(bfhi(gw2.y)) * yb[dt][3]);
                *(u32x2*)(MIX + tok * 1024 + c) = o2; }
            __syncthreads();
        }
#undef STG_K
#undef STG_V
#undef STS_K
#undef STS_V
#undef QK_LDS
#undef PV_LDS
    }
    SYNC(5);

    if (IN(6)) RPT(6) { pg8::Gemm g{(const bf16_t*)(dout + DO_MIX), (const bf16_t*)(ws + WS_WOUT_T), T, D, D, D}; pg8::StaticOrder So; So.init(T, D, G, (int)blockIdx.x);
        pg8::EpiF32 E{(float*)(ws + WS_ACCF), D}; pg8::gemm_phase<pg8::EpiF32, pg8::StaticOrder, true>(lds, g, So, E); }
    SYNC(6);

    if (IN(7)) RPT(7) {
        for (int m = gw; m < T; m += NGW) { f32x4 v[4], ac[4]; row_load(v, a.in[0] + (size_t)m * D, lane); row_load(ac, (const float*)(ws + WS_ACCF) + (size_t)m * D, lane); ln_apply(v, a.in[3], a.in[4], lane);
#pragma unroll
            for (int jx = 0; jx < 4; ++jx) v[jx] = v[jx] * ALPHA + ac[jx];
            ln_apply(v, a.in[21], a.in[22], lane); row_store_f32(v, (float*)(ws + WS_HF) + (size_t)m * D, lane); row_store_bf16(v, (bf16_t*)(ws + WS_HB) + (size_t)m * D, lane); }
        LAS float* scr = (LAS float*)(lds + wid * 8448);
        constexpr int I_SQ = 16 * 32, I_F1 = 16 * 128, I_F2 = 64 * 32;
        for (int it = gw; it < 2 * I_SQ + I_F1 + I_F2; it += NGW) { int r = it;
            if (r < I_SQ) { tr_item(a.in[23], 1024, 1024, 1024, (bf16_t*)(ws + WS_WXQ_T), scr, r, lane); continue; } r -= I_SQ;
            if (r < I_SQ) { tr_item(a.in[25], 1024, 1024, 1024, (bf16_t*)(ws + WS_WXO_T), scr, r, lane); continue; } r -= I_SQ;
            if (r < I_F1) { tr_item(a.in[28], 1024, 4096, 4096, (bf16_t*)(ws + WS_WFF1_T), scr, r, lane); continue; } r -= I_F1;
            tr_item(a.in[29], 4096, 1024, 1024, (bf16_t*)(ws + WS_WFF2_T), scr, r, lane); }
    }
    SYNC(7);

    if (IN(8)) RPT(8) { pg8::Gemm g{(const bf16_t*)(ws + WS_HB), (const bf16_t*)(ws + WS_WXQ_T), T, D, D, D}; pg8::StaticOrder So; So.init(T, D, G, (int)blockIdx.x);
        pg8::EpiBf16<0> E{(bf16_t*)(ws + WS_XQ), D, nullptr, XSCALE}; pg8::gemm_phase<pg8::EpiBf16<0>, pg8::StaticOrder, true>(lds, g, So, E); }
    SYNC(8);

    if (IN(9)) RPT(9) {
        const bf16_t* XQ = (const bf16_t*)(ws + WS_XQ); const bf16_t* XKV = (const bf16_t*)(dout + DO_XKV); const bf16_t* XVT = (const bf16_t*)(dout + DO_XVT); bf16_t* XO = (bf16_t*)(ws + WS_XO);
        const int j = lane & 15, q4 = lane >> 4;
        for (int u = gw; u < 4096; u += NGW) { const int hx = u & 3, tok0 = (u >> 2) * 16, b = tok0 >> 13;
            bf16x8 qf[8];
#pragma unroll
            for (int ks = 0; ks < 8; ++ks) qf[ks] = *(const bf16x8*)(XQ + (size_t)(tok0 + j) * 1024 + hx * 256 + 32 * ks + 8 * q4);
            f32x4 s[16];
#pragma unroll
            for (int kt = 0; kt < 16; ++kt) { const bf16_t* kp = XKV + (size_t)(b * 256 + 16 * kt + j) * 2048 + hx * 256 + 8 * q4; s[kt] = (f32x4){0.f, 0.f, 0.f, 0.f};
#pragma unroll
                for (int ks = 0; ks < 8; ++ks) s[kt] = MFMA16(*(const bf16x8*)(kp + 32 * ks), qf[ks], s[kt]); }
            float mx = -1e30f;
#pragma unroll
            for (int kt = 0; kt < 16; ++kt) mx = fmaxf(fmaxf(mx, fmaxf(s[kt][0], s[kt][1])), fmaxf(s[kt][2], s[kt][3]));
            mx = fmaxf(mx, __shfl_xor(mx, 16)); mx = fmaxf(mx, __shfl_xor(mx, 32));
            float l = 0.f; bf16x8 pf[8];
#pragma unroll
            for (int kk = 0; kk < 8; ++kk) { float p[8];
#pragma unroll
                for (int e = 0; e < 4; ++e) { p[e] = __builtin_amdgcn_exp2f(s[2 * kk][e] - mx); p[4 + e] = __builtin_amdgcn_exp2f(s[2 * kk + 1][e] - mx); l += p[e] + p[4 + e]; }
                pf[kk] = pack_p(p); }
            l += __shfl_xor(l, 16); l += __shfl_xor(l, 32); const float invl = 1.f / l;
#pragma unroll 2
            for (int dt = 0; dt < 16; ++dt) { f32x4 o = {0.f, 0.f, 0.f, 0.f}; const bf16_t* vp = XVT + (size_t)(b * 1024 + hx * 256 + 16 * dt + j) * 256 + 4 * q4;
#pragma unroll
                for (int kk = 0; kk < 8; ++kk) { const u32x2 vlo = *(const u32x2*)(vp + 32 * kk), vhi = *(const u32x2*)(vp + 32 * kk + 16); u32x4 w; w.x = vlo.x; w.y = vlo.y; w.z = vhi.x; w.w = vhi.y;
                    o = MFMA16(__builtin_bit_cast(bf16x8, w), pf[kk], o); }
                u32x2 ow; ow.x = pk2(o[0] * invl, o[1] * invl); ow.y = pk2(o[2] * invl, o[3] * invl);
                *(u32x2*)(XO + (size_t)(tok0 + j) * 1024 + hx * 256 + 16 * dt + 4 * q4) = ow; }
        }
    }
    SYNC(9);

    if (IN(10)) RPT(10) { pg8::Gemm g{(const bf16_t*)(ws + WS_XO), (const bf16_t*)(ws + WS_WXO_T), T, D, D, D}; pg8::StaticOrder So; So.init(T, D, G, (int)blockIdx.x);
        pg8::EpiF32 E{(float*)(ws + WS_ACCF), D}; pg8::gemm_phase<pg8::EpiF32, pg8::StaticOrder, true>(lds, g, So, E); }
    SYNC(10);

    if (IN(11)) RPT(11) {
        for (int m = gw; m < T; m += NGW) { f32x4 v[4], ac[4]; row_load(v, (const float*)(ws + WS_HF) + (size_t)m * D, lane); row_load(ac, (const float*)(ws + WS_ACCF) + (size_t)m * D, lane);
#pragma unroll
            for (int jx = 0; jx < 4; ++jx) v[jx] = v[jx] * ALPHA + ac[jx];
            ln_apply(v, a.in[26], a.in[27], lane); row_store_f32(v, (float*)(ws + WS_HF) + (size_t)m * D, lane); row_store_bf16(v, (bf16_t*)(ws + WS_HB) + (size_t)m * D, lane); }
    }
    SYNC(11);

    if (IN(12)) RPT(12) { pg8::Gemm g{(const bf16_t*)(ws + WS_HB), (const bf16_t*)(ws + WS_WFF1_T), T, FF, D, D}; pg8::StaticOrder So; So.init(T, FF, G, (int)blockIdx.x);
        pg8::EpiBf16<3> E{(bf16_t*)(ws + WS_FFB), FF, nullptr, 1.f}; pg8::gemm_phase<pg8::EpiBf16<3>, pg8::StaticOrder, true>(lds, g, So, E); }
    SYNC(12);

    if (IN(13)) RPT(13) { pg8::Gemm g{(const bf16_t*)(ws + WS_FFB), (const bf16_t*)(ws + WS_WFF2_T), T, D, FF, FF}; pg8::StaticOrder So; So.init(T, D, G, (int)blockIdx.x);
        pg8::EpiF32 E{a.out, D}; pg8::gemm_phase<pg8::EpiF32, pg8::StaticOrder, true>(lds, g, So, E); }
    SYNC(13);

    if (IN(14)) RPT(14) {
        for (int m = gw; m < T; m += NGW) { f32x4 v[4], ac[4]; row_load(v, (const float*)(ws + WS_HF) + (size_t)m * D, lane); row_load(ac, a.out + (size_t)m * D, lane);
#pragma unroll
            for (int jx = 0; jx < 4; ++jx) v[jx] = v[jx] * ALPHA + ac[jx];
            ln_apply(v, a.in[30], a.in[31], lane); row_store_f32(v, a.out + (size_t)m * D, lane); }
    }
#undef IN
#undef SYNC
}

constexpr int NPHASE = 15;
extern "C" void kernel_launch(void* const* d_in, const int* in_sizes, int n_in, void* d_out, int out_size, void* d_ws, size_t ws_size, hipStream_t stream) {
    static int grid = 0;
    if (grid == 0) {
        if (n_in != 32 || out_size != T * D || ws_size < 256 * MiB) { fprintf(stderr, "kernel_launch: unexpected shapes (n_in %d out %d ws %zu)\n", n_in, out_size, ws_size); grid = -1; return; }
        int dev = 0, cus = 0, per_cu = 0;
        hipGetDevice(&dev); hipDeviceGetAttribute(&cus, hipDeviceAttributeMultiprocessorCount, dev);
        hipFuncSetAttribute((const void*)mk_fwd, hipFuncAttributeMaxDynamicSharedMemorySize, LDS_BYTES);
        hipOccupancyMaxActiveBlocksPerMultiprocessor(&per_cu, (const void*)mk_fwd, 512, LDS_BYTES);
        (void)hipGetLastError();
        if (per_cu < 1) fprintf(stderr, "kernel_launch: occupancy query says %d blocks per CU\n", per_cu);
        grid = cus > 0 ? cus : 256;
    }
    if (grid < 0) return;
    Args a{};
    for (int i = 0; i < 32; ++i) a.in[i] = (const float*)d_in[i];
    a.out = (float*)d_out; a.ws = (unsigned char*)d_ws; a.ph_lo = 0; a.ph_hi = NPHASE;
    void* args[] = {&a};
    hipError_t e = hipLaunchCooperativeKernel((const void*)mk_fwd, dim3(grid), dim3(512), args, LDS_BYTES, stream);
    if (e != hipSuccess) fprintf(stderr, "cooperative launch failed: %s (grid %d)\n", hipGetErrorString(e), grid);
}
```

```cpp
#include <hip/hip_runtime.h>
#include <hip/hip_cooperative_groups.h>
#include <cstdio>
#include <cstdint>
namespace cg = cooperative_groups;

#define LAS __attribute__((address_space(3)))
typedef unsigned short bf16_t;
typedef short bf16x8 __attribute__((ext_vector_type(8)));
typedef float f32x4 __attribute__((ext_vector_type(4)));
typedef float f32x2 __attribute__((ext_vector_type(2)));
typedef unsigned u32x4 __attribute__((ext_vector_type(4)));
typedef unsigned u32x2 __attribute__((ext_vector_type(2)));

__device__ __forceinline__ unsigned f2bf(float f) { unsigned u = __builtin_bit_cast(unsigned, f); return (u + 0x7fffu + ((u >> 16) & 1u)) >> 16; }
__device__ __forceinline__ unsigned pk2(float lo, float hi) { return f2bf(lo) | (f2bf(hi) << 16); }
__device__ __forceinline__ float bflo(unsigned w) { return __builtin_bit_cast(float, w << 16); }
__device__ __forceinline__ float bfhi(unsigned w) { return __builtin_bit_cast(float, w & 0xffff0000u); }
__device__ __forceinline__ float bf1(bf16_t h) { return __builtin_bit_cast(float, ((unsigned)h) << 16); }
__device__ __forceinline__ float gelu_t(float x) { const float u = x * (1.f + 0.044715f * x * x); const float e = __builtin_amdgcn_exp2f(-2.3022081986f * u); return x * __builtin_amdgcn_rcpf(1.f + e); }
__device__ __forceinline__ float sigm(float x) { return __builtin_amdgcn_rcpf(1.f + __builtin_amdgcn_exp2f(-1.4426950409f * x)); }
__device__ __forceinline__ float wave_sum(float v) {
#pragma unroll
    for (int o = 1; o < 64; o <<= 1) v += __shfl_xor(v, o);
    return v;
}
#define LDS_WAIT() asm volatile("s_waitcnt lgkmcnt(0)" ::: "memory")

namespace pg8 {
constexpr int BM = 256, BK = 64, HALF = 128, HTB = HALF * BK * 2, STAGE_BYTES = 8 * HTB, NXCD = 8, WGM = 8;
__host__ __device__ __forceinline__ int lds_byte(int r, int c) { const int st = (r >> 4) * 2 + (c >> 5), rr = r & 15, cc = c & 31, ob = rr * 64 + cc * 2; return st * 1024 + (ob ^ (((ob >> 9) & 1) << 5)); }
__host__ __device__ __forceinline__ void stage_rc(int b, int& R, int& C) { const int st = b / 1024, sb = b % 1024, swz = sb ^ (((sb >> 9) & 1) << 5); R = (st >> 1) * 16 + swz / 64; C = (st & 1) * 32 + (swz % 64) / 2; }
__host__ __device__ __forceinline__ int perm32(int rho) { const int n = rho >> 4, i = rho & 15; return 8 * (i >> 2) + 4 * n + (i & 3); }
struct Unit { int pm, pn; };
struct Gemm { const bf16_t* A; const bf16_t* Bt; int M, N, K, lda; };
struct StaticOrder {
    int nM, nN, nwg, G, c;
    __device__ void init(int M, int N, int G_, int c_) { nM = M / BM; nN = N / BM; nwg = nM * nN; G = G_; c = c_; }
    __device__ bool next(int i, Unit& u) const {
        const long L = (long)i * G + c; if (L >= nwg) return false;
        int wgid = (int)L; { const int q = nwg / NXCD, r = nwg % NXCD, xcd = wgid % NXCD, off = wgid / NXCD; wgid = (xcd < r ? xcd * (q + 1) : r * (q + 1) + (xcd - r) * q) + off; }
        const int nig = WGM * nN, gid = wgid / nig, fm = gid * WGM, gsz = (nM - fm) < WGM ? (nM - fm) : WGM;
        u.pm = fm + ((wgid % nig) % gsz); u.pn = (wgid % nig) / gsz; return true;
    }
};
__device__ __forceinline__ unsigned cvt_pk_bf16(float lo, float hi) { unsigned r; asm volatile("v_cvt_pk_bf16_f32 %0, %1, %2" : "=v"(r) : "v"(lo), "v"(hi)); return r; }

template <int ACT> struct EpiBf16 {
    static constexpr bool PERM = true;
    bf16_t* O; int ldc; const float* bias; float scale;
    __device__ __forceinline__ void operator()(const f32x4 (&acc)[2][2][4][2], const Unit& u, int wr, int wc, int fr, int fq) const {
        const int row0 = u.pm * BM + wr * 64 + fr; const int col0 = u.pn * BM + wc * 32 + 8 * fq;
        f32x4 bv[2][2];
#pragma unroll
        for (int bj = 0; bj < 2; ++bj)
#pragma unroll
            for (int n = 0; n < 2; ++n) bv[bj][n] = bias ? *(const f32x4*)(bias + col0 + bj * HALF + 4 * n) : (f32x4){0.f, 0.f, 0.f, 0.f};
#pragma unroll
        for (int ai = 0; ai < 2; ++ai)
#pragma unroll
            for (int m = 0; m < 4; ++m) { bf16_t* rowp = O + (size_t)(row0 + ai * HALF + m * 16) * ldc + col0;
#pragma unroll
                for (int bj = 0; bj < 2; ++bj) { f32x4 v0 = acc[ai][bj][m][0] + bv[bj][0], v1 = acc[ai][bj][m][1] + bv[bj][1];
                    if (ACT == 2) {
#pragma unroll
                        for (int e = 0; e < 4; ++e) { v0[e] = gelu_t(v0[e]); v1[e] = gelu_t(v1[e]); } }
                    if (ACT == 3) {
#pragma unroll
                        for (int e = 0; e < 4; ++e) { float a0 = v0[e] > 0.f ? v0[e] : 0.f, a1 = v1[e] > 0.f ? v1[e] : 0.f; v0[e] = a0 * a0; v1[e] = a1 * a1; } }
                    v0 = v0 * scale; v1 = v1 * scale; u32x4 w; w.x = cvt_pk_bf16(v0[0], v0[1]); w.y = cvt_pk_bf16(v0[2], v0[3]); w.z = cvt_pk_bf16(v1[0], v1[1]); w.w = cvt_pk_bf16(v1[2], v1[3]);
                    *(u32x4*)(rowp + bj * HALF) = w; } }
    }
};
struct EpiF32 {
    static constexpr bool PERM = false;
    float* O; int ldc;
    __device__ __forceinline__ void operator()(const f32x4 (&acc)[2][2][4][2], const Unit& u, int wr, int wc, int fr, int fq) const {
        const int row0 = u.pm * BM + wr * 64 + fr; const int col0 = u.pn * BM + wc * 32 + 4 * fq;
#pragma unroll
        for (int ai = 0; ai < 2; ++ai)
#pragma unroll
            for (int m = 0; m < 4; ++m) { float* rowp = O + (size_t)(row0 + ai * HALF + m * 16) * ldc + col0;
#pragma unroll
                for (int bj = 0; bj < 2; ++bj)
#pragma unroll
                    for (int n = 0; n < 2; ++n) *(f32x4*)(rowp + bj * HALF + n * 16) = acc[ai][bj][m][n]; }
    }
};

template <class Epi, class Sched, bool ALIGN_EPI>
__device__ __forceinline__ void gemm_phase(LAS unsigned char* lds, const Gemm g, const Sched& S, const Epi& E) {
    const int tid = threadIdx.x, wid = __builtin_amdgcn_readfirstlane(tid >> 6), lane = tid & 63, wr = wid >> 2, wc = wid & 3, fr = lane & 15, fq = lane >> 4;
    const int K = g.K, nt = K / BK, lda = g.lda;
    unsigned voffA[2], voffB[2];
#pragma unroll
    for (int i = 0; i < 2; ++i) { int R, C; stage_rc(tid * 16 + i * 8192, R, C); const int Rb = Epi::PERM ? ((R & ~31) + perm32(R & 31)) : R;
        voffA[i] = (unsigned)(R * lda + C) * 2u; voffB[i] = (unsigned)(Rb * K + C) * 2u; }
    const size_t kstep = (size_t)(BK * 2);
    const size_t hstepA = (size_t)HALF * lda * 2, hstepB = (size_t)HALF * K * 2;
    const size_t tstepA = 2 * hstepA, tstepB = 2 * hstepB;
    const unsigned ldsw = (unsigned)wid * 1024u;
    const int aoff = lds_byte(wr * 64 + fr, fq * 8), boff = lds_byte(wc * 32 + fr, fq * 8);
#define PG8_SA(b, h) (((b) * 2 + (h)) * HTB)
#define PG8_SB(b, h) ((4 + (b) * 2 + (h)) * HTB)
#define PG8_STAGE(bufoff, gbase, voff) do { _Pragma("unroll") for (int _i = 0; _i < 2; ++_i) \
        __builtin_amdgcn_global_load_lds((const unsigned*)((const char*)(gbase) + (voff)[_i]), (LAS unsigned*)(lds + (bufoff) + ldsw + _i * 8192), 16, 0, 0); } while (0)
#define PG8_LDA(dst, b, h) do { _Pragma("unroll") for (int m = 0; m < 4; ++m) _Pragma("unroll") for (int k = 0; k < 2; ++k) dst[m][k] = *(const LAS bf16x8*)(lds + PG8_SA(b, h) + aoff + m * 2048 + k * 1024); } while (0)
#define PG8_LDB(dst, b, h) do { _Pragma("unroll") for (int n = 0; n < 2; ++n) _Pragma("unroll") for (int k = 0; k < 2; ++k) dst[n][k] = *(const LAS bf16x8*)(lds + PG8_SB(b, h) + boff + n * 2048 + k * 1024); } while (0)
#define PG8_MMA(ai, bj, At, Bt) do { __builtin_amdgcn_s_setprio(1); _Pragma("unroll") for (int m = 0; m < 4; ++m) _Pragma("unroll") for (int n = 0; n < 2; ++n) _Pragma("unroll") for (int k = 0; k < 2; ++k) \
        acc[ai][bj][m][n] = __builtin_amdgcn_mfma_f32_16x16x32_bf16(Bt[n][k], At[m][k], acc[ai][bj][m][n], 0, 0, 0); __builtin_amdgcn_s_setprio(0); } while (0)
#define PG8_WAIT_V(n) asm volatile("s_waitcnt vmcnt(" #n ")" ::: "memory")
#define PG8_WAIT_L(n) asm volatile("s_waitcnt lgkmcnt(" #n ")" ::: "memory")
#define PG8_BAR __builtin_amdgcn_s_barrier()
#define PG8_SCHED __builtin_amdgcn_sched_barrier(0)
    Unit cur, nxt; int ui = 0;
    if (!S.next(0, cur)) return;
    f32x4 acc[2][2][4][2];
#pragma unroll
    for (int a = 0; a < 2; ++a)
#pragma unroll
        for (int b = 0; b < 2; ++b)
#pragma unroll
            for (int m = 0; m < 4; ++m)
#pragma unroll
                for (int n = 0; n < 2; ++n) acc[a][b][m][n] = (f32x4){0.f, 0.f, 0.f, 0.f};
    bf16x8 At[4][2], B0[2][2], B1[2][2];
    const char* cA = (const char*)g.A + (size_t)cur.pm * tstepA; const char* cB = (const char*)g.Bt + (size_t)cur.pn * tstepB;
    PG8_STAGE(PG8_SB(0, 0), cB, voffB); PG8_STAGE(PG8_SB(0, 1), cB + hstepB, voffB); PG8_STAGE(PG8_SA(0, 0), cA, voffA); PG8_STAGE(PG8_SA(0, 1), cA + hstepA, voffA);
    if (wr == 1) PG8_BAR;
    PG8_WAIT_V(2); PG8_BAR;
    PG8_STAGE(PG8_SB(1, 0), cB + kstep, voffB); PG8_STAGE(PG8_SA(1, 0), cA + kstep, voffA); PG8_STAGE(PG8_SB(1, 1), cB + hstepB + kstep, voffB);
    PG8_WAIT_V(6); PG8_BAR;
    for (;;) {
        const bool has_next = S.next(ui + 1, nxt);
        const char* nA = has_next ? (const char*)g.A + (size_t)nxt.pm * tstepA : cA; const char* nB = has_next ? (const char*)g.Bt + (size_t)nxt.pn * tstepB : cB;
        for (int t = 0; t < nt; t += 2) {
            const bool last = (t == nt - 2);
            const char* a1 = cA + (size_t)(t + 1) * kstep;
            const char* a2 = last ? nA : cA + (size_t)(t + 2) * kstep; const char* b2 = last ? nB : cB + (size_t)(t + 2) * kstep;
            const char* a3 = a2 + kstep; const char* b3 = b2 + kstep;
            PG8_LDB(B0, 0, 0); PG8_LDB(B1, 0, 1); PG8_SCHED; PG8_LDA(At, 0, 0); PG8_STAGE(PG8_SA(1, 1), a1 + hstepA, voffA);
            PG8_WAIT_V(8); PG8_WAIT_L(0); PG8_BAR; PG8_MMA(0, 0, At, B0); PG8_MMA(0, 1, At, B1); PG8_BAR; PG8_SCHED;
            PG8_LDA(At, 0, 1); PG8_STAGE(PG8_SB(0, 0), b2, voffB); PG8_STAGE(PG8_SB(0, 1), b2 + hstepB, voffB); PG8_STAGE(PG8_SA(0, 0), a2, voffA);
            PG8_WAIT_V(8); PG8_WAIT_L(0); PG8_BAR; PG8_MMA(1, 0, At, B0); PG8_MMA(1, 1, At, B1); PG8_BAR; PG8_SCHED;
            PG8_LDB(B0, 1, 0); PG8_LDB(B1, 1, 1); PG8_SCHED; PG8_LDA(At, 1, 0); PG8_STAGE(PG8_SA(0, 1), a2 + hstepA, voffA);
            PG8_WAIT_V(8); PG8_WAIT_L(0); PG8_BAR; PG8_MMA(0, 0, At, B0); PG8_MMA(0, 1, At, B1); PG8_BAR; PG8_SCHED;
            PG8_LDA(At, 1, 1); PG8_STAGE(PG8_SB(1, 0), b3, voffB); PG8_STAGE(PG8_SB(1, 1), b3 + hstepB, voffB); PG8_STAGE(PG8_SA(1, 0), a3, voffA);
            PG8_WAIT_V(8); PG8_WAIT_L(0); PG8_BAR; PG8_MMA(1, 0, At, B0); PG8_MMA(1, 1, At, B1); PG8_BAR; PG8_SCHED;
        }
        if constexpr (ALIGN_EPI) { if (wr == 0) PG8_BAR; }
        E(acc, cur, wr, wc, fr, fq);
        if (!has_next) break;
#pragma unroll
        for (int a = 0; a < 2; ++a)
#pragma unroll
            for (int b = 0; b < 2; ++b)
#pragma unroll
                for (int m = 0; m < 4; ++m)
#pragma unroll
                    for (int n = 0; n < 2; ++n) acc[a][b][m][n] = (f32x4){0.f, 0.f, 0.f, 0.f};
        cur = nxt; cA = nA; cB = nB; ++ui;
        if constexpr (ALIGN_EPI) { if (wr == 1) PG8_BAR; }
    }
    PG8_WAIT_V(0);
    if constexpr (!ALIGN_EPI) { if (wr == 0) PG8_BAR; }
    PG8_BAR;
#undef PG8_SA
#undef PG8_SB
#undef PG8_STAGE
#undef PG8_LDA
#undef PG8_LDB
#undef PG8_MMA
#undef PG8_WAIT_V
#undef PG8_WAIT_L
#undef PG8_BAR
#undef PG8_SCHED
}
}

constexpr int NB = 2, S = 8192, D = 1024, T = NB * S, FF = 4096;
constexpr int ZC = 6912;
constexpr int C_U = 0, C_V = 1024, C_Q = 2048, C_KCMP = 3072, C_VCMP = 3328, C_KSLC = 3584, C_VSLC = 3840, C_KWIN = 4096, C_VWIN = 4352, C_GN = 4608, C_GA = 4656, C_GB = 5680;
constexpr float ALPHA = 1.189207115002721f;
constexpr float QSCALE = 0.125f * 1.4426950408889634f;
constexpr float XSCALE = 0.0625f * 1.4426950408889634f;
constexpr float LN_EPS = 1e-5f;
constexpr size_t MiB = 1u << 20;
constexpr size_t WS_Z = 0, WS_KCMPT = 216 * MiB, WS_VCMPT = 224 * MiB, WS_VSLCT = 232 * MiB, WS_VWINT = 240 * MiB, WS_HDNK = 248 * MiB, WS_HDNV = 250 * MiB,
                 WS_KC = 252 * MiB, WS_VCT = 252 * MiB + 512 * 1024, WS_WOUT_T = 253 * MiB, WS_C1 = 255 * MiB, WS_W2KT = 255 * MiB + 4096, WS_W2VT = 255 * MiB + 65536, WS_WSTRIL = 255 * MiB + 131072, WS_C1P = 255 * MiB + 524288;
constexpr size_t WS_HF = 0, WS_HB = 64 * MiB, WS_XQ = 96 * MiB, WS_XO = 128 * MiB, WS_ACCF = 160 * MiB, WS_FFB = 96 * MiB,
                 WS_WXQ_T = 224 * MiB, WS_WXO_T = 226 * MiB, WS_WFF1_T = 228 * MiB, WS_WFF2_T = 236 * MiB;
constexpr size_t DO_H0B = 0, DO_MIX = 0, DO_WIN_T = 32 * MiB, DO_WXKV_T = 46 * MiB, DO_MEMB = 50 * MiB, DO_XKV = 51 * MiB, DO_XVT = 53 * MiB, DO_ROPE = 54 * MiB, DO_W1KT = 55 * MiB, DO_W1VT = 56 * MiB;
constexpr int LDS_BYTES = 147456;

struct Args { const float* in[32]; float* out; unsigned char* ws; int ph_lo, ph_hi; };

__device__ __forceinline__ void tr_item(const float* W, int K, int N, int Npad, bf16_t* WT, LAS float* scr, int item, int lane) {
    const int nblk = Npad / 32, kb = item / nblk, nb = item % nblk, k0 = 64 * kb, n0 = 32 * nb;
    const int cc = n0 + (lane & 31);
#pragma unroll 8
    for (int i = 0; i < 32; ++i) { const int kk = 2 * i + (lane >> 5); scr[kk * 33 + (lane & 31)] = (cc < N) ? W[(size_t)(k0 + kk) * N + cc] : 0.f; }
    LDS_WAIT();
    const int c = lane & 7;
#pragma unroll
    for (int j = 0; j < 4; ++j) { const int n = (lane >> 3) + 8 * j; const LAS float* s = scr + (8 * c) * 33 + n;
        u32x4 o; o.x = pk2(s[0 * 33], s[1 * 33]); o.y = pk2(s[2 * 33], s[3 * 33]); o.z = pk2(s[4 * 33], s[5 * 33]); o.w = pk2(s[6 * 33], s[7 * 33]);
        *(u32x4*)(WT + (size_t)(n0 + n) * K + k0 + 8 * c) = o; }
    LDS_WAIT();
}

__device__ __forceinline__ void ln_apply(f32x4 (&v)[4], const float* g, const float* b, int lane) {
    float s = 0.f;
#pragma unroll
    for (int j = 0; j < 4; ++j) s += (v[j].x + v[j].y) + (v[j].z + v[j].w);
    const float mean = wave_sum(s) * (1.f / 1024.f); float s2 = 0.f;
#pragma unroll
    for (int j = 0; j < 4; ++j) { v[j] = v[j] - mean; s2 += (v[j].x * v[j].x + v[j].y * v[j].y) + (v[j].z * v[j].z + v[j].w * v[j].w); }
    const float rstd = 1.f / sqrtf(wave_sum(s2) * (1.f / 1024.f) + LN_EPS);
#pragma unroll
    for (int j = 0; j < 4; ++j) { const f32x4 gg = *(const f32x4*)(g + 4 * lane + 256 * j), bb = *(const f32x4*)(b + 4 * lane + 256 * j); v[j] = v[j] * rstd * gg + bb; }
}
__device__ __forceinline__ void row_load(f32x4 (&v)[4], const float* p, int lane) {
#pragma unroll
    for (int j = 0; j < 4; ++j) v[j] = *(const f32x4*)(p + 4 * lane + 256 * j);
}
__device__ __forceinline__ void row_store_f32(const f32x4 (&v)[4], float* p, int lane) {
#pragma unroll
    for (int j = 0; j < 4; ++j) *(f32x4*)(p + 4 * lane + 256 * j) = v[j];
}
__device__ __forceinline__ void row_store_bf16(const f32x4 (&v)[4], bf16_t* p, int lane) {
#pragma unroll
    for (int j = 0; j < 4; ++j) { u32x2 w; w.x = pk2(v[j].x, v[j].y); w.y = pk2(v[j].z, v[j].w); *(u32x2*)(p + 4 * lane + 256 * j) = w; }
}

#define MFMA16(a, b, c) __builtin_amdgcn_mfma_f32_16x16x32_bf16((a), (b), (c), 0, 0, 0)

__device__ __forceinline__ void qk32(const bf16_t* kp, size_t t1off, bf16x8 qf0, bf16x8 qf1, f32x4& s0, f32x4& s1) {
    const bf16x8 k00 = *(const bf16x8*)(kp), k01 = *(const bf16x8*)(kp + 32), k10 = *(const bf16x8*)(kp + t1off), k11 = *(const bf16x8*)(kp + t1off + 32);
    const f32x4 z = {0.f, 0.f, 0.f, 0.f};
    s0 = MFMA16(k00, qf0, z); s0 = MFMA16(k01, qf1, s0); s1 = MFMA16(k10, qf0, z); s1 = MFMA16(k11, qf1, s1);
}
__device__ __forceinline__ void pv32(const bf16_t* vp, size_t dtoff, bf16x8 pb, f32x4 (&o)[4]) {
#pragma unroll
    for (int dt = 0; dt < 4; ++dt) { const u32x2 lo = *(const u32x2*)(vp + dt * dtoff), hi = *(const u32x2*)(vp + dt * dtoff + 16);
        u32x4 w; w.x = lo.x; w.y = lo.y; w.z = hi.x; w.w = hi.y; o[dt] = MFMA16(__builtin_bit_cast(bf16x8, w), pb, o[dt]); }
}
__device__ __forceinline__ unsigned cvtpk(float lo, float hi) { unsigned r; asm volatile("v_cvt_pk_bf16_f32 %0, %1, %2" : "=v"(r) : "v"(lo), "v"(hi)); return r; }
__device__ __forceinline__ bf16x8 pack_p(const float (&p)[8]) { u32x4 w; w.x = cvtpk(p[0], p[1]); w.y = cvtpk(p[2], p[3]); w.z = cvtpk(p[4], p[5]); w.w = cvtpk(p[6], p[7]); return __builtin_bit_cast(bf16x8, w); }
__device__ __forceinline__ float dpp_xor1(float v) { return __builtin_bit_cast(float, __builtin_amdgcn_mov_dpp(__builtin_bit_cast(int, v), 0xB1, 0xF, 0xF, true)); }
__device__ __forceinline__ float dpp_xor2(float v) { return __builtin_bit_cast(float, __builtin_amdgcn_mov_dpp(__builtin_bit_cast(int, v), 0x4E, 0xF, 0xF, true)); }
__device__ __forceinline__ bf16x8 osm_step(f32x4 s0, f32x4 s1, unsigned vm, float& m, float& l, f32x4 (&o)[4]) {
    const float NINF = -__builtin_inff();
#pragma unroll
    for (int e = 0; e < 4; ++e) { s0[e] = ((vm >> e) & 1u) ? s0[e] : NINF; s1[e] = ((vm >> (4 + e)) & 1u) ? s1[e] : NINF; }
    float mx = fmaxf(fmaxf(fmaxf(s0[0], s0[1]), fmaxf(s0[2], s0[3])), fmaxf(fmaxf(s1[0], s1[1]), fmaxf(s1[2], s1[3])));
    if (__ballot(mx > m + 8.f) != 0ull) {
        float r = fmaxf(mx, __shfl_xor(mx, 16)); r = fmaxf(r, __shfl_xor(r, 32));
        const float mn = fmaxf(m, r), alpha = __builtin_amdgcn_exp2f(m - mn); m = mn; l *= alpha;
#pragma unroll
        for (int dt = 0; dt < 4; ++dt) o[dt] = o[dt] * alpha;
    }
    float p[8];
#pragma unroll
    for (int e = 0; e < 4; ++e) { p[e] = __builtin_amdgcn_exp2f(s0[e] - m); p[4 + e] = __builtin_amdgcn_exp2f(s1[e] - m); }
    l += ((p[0] + p[1]) + (p[2] + p[3])) + ((p[4] + p[5]) + (p[6] + p[7]));
    return pack_p(p);
}

__device__ __forceinline__ void osm_step64(f32x4 (&s)[4], unsigned vm, float& m, float& l, f32x4 (&o)[4], bf16x8& pb0, bf16x8& pb1) {
    const float NINF = -__builtin_inff();
#pragma unroll
    for (int qd = 0; qd < 4; ++qd)
#pragma unroll
        for (int e = 0; e < 4; ++e) s[qd][e] = ((vm >> (4 * qd + e)) & 1u) ? s[qd][e] : NINF;
    const float mx = fmaxf(fmaxf(fmaxf(fmaxf(s[0][0], s[0][1]), fmaxf(s[0][2], s[0][3])), fmaxf(fmaxf(s[1][0], s[1][1]), fmaxf(s[1][2], s[1][3]))),
                           fmaxf(fmaxf(fmaxf(s[2][0], s[2][1]), fmaxf(s[2][2], s[2][3])), fmaxf(fmaxf(s[3][0], s[3][1]), fmaxf(s[3][2], s[3][3]))));
    if (__ballot(mx > m + 8.f) != 0ull) {
        float r = fmaxf(mx, __shfl_xor(mx, 16)); r = fmaxf(r, __shfl_xor(r, 32));
        const float mn = fmaxf(m, r), alpha = __builtin_amdgcn_exp2f(m - mn); m = mn; l *= alpha;
#pragma unroll
        for (int dt = 0; dt < 4; ++dt) o[dt] = o[dt] * alpha;
    }
    float p[8], q[8];
#pragma unroll
    for (int e = 0; e < 4; ++e) { p[e] = __builtin_amdgcn_exp2f(s[0][e] - m); p[4 + e] = __builtin_amdgcn_exp2f(s[1][e] - m); q[e] = __builtin_amdgcn_exp2f(s[2][e] - m); q[4 + e] = __builtin_amdgcn_exp2f(s[3][e] - m); }
    l += (((p[0] + p[1]) + (p[2] + p[3])) + ((p[4] + p[5]) + (p[6] + p[7]))) + (((q[0] + q[1]) + (q[2] + q[3])) + ((q[4] + q[5]) + (q[6] + q[7])));
    pb0 = pack_p(p); pb1 = pack_p(q);
}

__global__ void __launch_bounds__(512, 2) mk_fwd(Args a) {
    extern __shared__ __attribute__((aligned(16))) unsigned char lds_raw[];
    LAS unsigned char* lds = (LAS unsigned char*)lds_raw;
    cg::grid_group grid = cg::this_grid();
    const int tid = threadIdx.x, lane = tid & 63, wid = __builtin_amdgcn_readfirstlane(tid >> 6);
    const int G = gridDim.x, gw = blockIdx.x * 8 + wid, NGW = G * 8, gtid = blockIdx.x * 512 + tid, NGT = G * 512;
    unsigned char* ws = a.ws; unsigned char* dout = (unsigned char*)a.out;
    const int lo = a.ph_lo, hi = a.ph_hi;
#define IN(k) (lo <= (k) && (k) < hi)
#define SYNC(k) do { if (IN(k) && IN((k) + 1)) grid.sync(); } while (0)
#ifndef PROBE_PH
#define PROBE_PH -1
#endif
#ifndef PROBE_N
#define PROBE_N 2
#endif
#define RPT(k) for (int rp_ = 0; rp_ < ((k) == PROBE_PH ? PROBE_N : 1); ++rp_, ((k) == PROBE_PH && rp_ < PROBE_N) ? grid.sync() : (void)0)
    bf16_t* const Z = (bf16_t*)(ws + WS_Z);
    float* const ROPE = (float*)(dout + DO_ROPE);

    if (IN(0)) RPT(0) {
        LAS float* scr = (LAS float*)(lds + wid * 8448);
        constexpr int I_WIN = 16 * 216, I_XKV = 16 * 64, I_W1 = 32 * 8, I_W2 = 4 * 2, I_WOUT = 16 * 32;
        constexpr int NIT = I_WIN + I_XKV + 2 * I_W1 + 2 * I_W2 + I_WOUT;
        for (int it = gw; it < NIT; it += NGW) { int r = it;
            if (r < I_WIN) { tr_item(a.in[5], 1024, 6704, 6912, (bf16_t*)(dout + DO_WIN_T), scr, r, lane); continue; } r -= I_WIN;
            if (r < I_XKV) { tr_item(a.in[24], 1024, 2048, 2048, (bf16_t*)(dout + DO_WXKV_T), scr, r, lane); continue; } r -= I_XKV;
            if (r < I_W1) { tr_item(a.in[11], 2048, 256, 256, (bf16_t*)(dout + DO_W1KT), scr, r, lane); continue; } r -= I_W1;
            if (r < I_W1) { tr_item(a.in[16], 2048, 256, 256, (bf16_t*)(dout + DO_W1VT), scr, r, lane); continue; } r -= I_W1;
            if (r < I_W2) { tr_item(a.in[13], 256, 64, 64, (bf16_t*)(ws + WS_W2KT), scr, r, lane); continue; } r -= I_W2;
            if (r < I_W2) { tr_item(a.in[18], 256, 64, 64, (bf16_t*)(ws + WS_W2VT), scr, r, lane); continue; } r -= I_W2;
            tr_item(a.in[20], 1024, 1024, 1024, (bf16_t*)(ws + WS_WOUT_T), scr, r, lane);
        }
        for (int m = gw; m < T; m += NGW) { f32x4 v[4]; row_load(v, a.in[0] + (size_t)m * D, lane); ln_apply(v, a.in[3], a.in[4], lane); row_store_bf16(v, (bf16_t*)(dout + DO_H0B) + (size_t)m * D, lane); }
        for (int i = gtid; i < 512 * 1024 / 4; i += NGT) { const f32x4 v = *(const f32x4*)(a.in[1] + 4 * (size_t)i); u32x2 w; w.x = pk2(v.x, v.y); w.y = pk2(v.z, v.w); *(u32x2*)((bf16_t*)(dout + DO_MEMB) + 4 * (size_t)i) = w; }
        for (int i = gtid; i < T * 8; i += NGT) { const int tok = i >> 3, fi = i & 7; const int pos = ((const int*)a.in[2])[tok];
            float inv = 1.0f;
            inv = fi == 1 ? 0.19392274474868576f : inv; inv = fi == 2 ? 0.03760603093086393f : inv; inv = fi == 3 ? 0.007292664737217109f : inv; inv = fi == 4 ? 0.001414213562373095f : inv;
            inv = fi == 5 ? 0.0002742481756762073f : inv; inv = fi == 6 ? 5.318295896944988e-05f : inv; inv = fi == 7 ? 1.031338537721246e-05f : inv;
            const float ang = (float)pos * inv; ROPE[tok * 16 + fi] = cosf(ang); ROPE[tok * 16 + 8 + fi] = sinf(ang); }
        for (int i = gtid; i < 8 * 128 * 128; i += NGT) { const int t = (i >> 7) & 127, s = i & 127; const float w = a.in[8][i]; ((bf16_t*)(ws + WS_WSTRIL))[i] = (bf16_t)(s <= t ? f2bf(w) : 0u); }
        for (int job = blockIdx.x; job < 64; job += G) if (tid < 256) { const int mat = job >> 5, ks = job & 31; const float* pe = a.in[mat ? 15 : 10] + ks * 64; const float* w1 = a.in[mat ? 16 : 11] + (size_t)ks * 64 * 256 + tid; float sum = 0.f;
#pragma unroll 16
            for (int k = 0; k < 64; ++k) sum += pe[k] * w1[(size_t)k * 256];
            ((float*)(ws + WS_C1P))[job * 256 + tid] = sum; }
    }
    SYNC(0);

    if (IN(1)) RPT(1) {
        { pg8::Gemm g{(const bf16_t*)(dout + DO_H0B), (const bf16_t*)(dout + DO_WIN_T), T, ZC, D, D}; pg8::StaticOrder So; So.init(T, ZC, G, (int)blockIdx.x);
          pg8::EpiBf16<0> E{Z, ZC, nullptr, 1.f}; pg8::gemm_phase<pg8::EpiBf16<0>, pg8::StaticOrder, true>(lds, g, So, E); }
        { pg8::Gemm g{(const bf16_t*)(dout + DO_MEMB), (const bf16_t*)(dout + DO_WXKV_T), 512, 2048, D, D}; pg8::StaticOrder So; So.init(512, 2048, G, (G - 1) - (int)blockIdx.x);
          pg8::EpiBf16<0> E{(bf16_t*)(dout + DO_XKV), 2048, nullptr, 1.f}; pg8::gemm_phase<pg8::EpiBf16<0>, pg8::StaticOrder, true>(lds, g, So, E); }
    }
    SYNC(1);

    if (IN(2)) RPT(2) {
        bf16_t* const KCMPT = (bf16_t*)(ws + WS_KCMPT); bf16_t* const VCMPT = (bf16_t*)(ws + WS_VCMPT);
        for (int tok = gw; tok < T; tok += NGW) {
            bf16_t* zr = Z + (size_t)tok * ZC; const int b = tok >> 13, t = tok & 8191;
            float rc[8], rs[8];
            { const f32x4 c0 = *(const f32x4*)(ROPE + tok * 16), c1 = *(const f32x4*)(ROPE + tok * 16 + 4), s0 = *(const f32x4*)(ROPE + tok * 16 + 8), s1 = *(const f32x4*)(ROPE + tok * 16 + 12);
#pragma unroll
              for (int e = 0; e < 4; ++e) { rc[e] = c0[e]; rc[4 + e] = c1[e]; rs[e] = s0[e]; rs[4 + e] = s1[e]; } }
            { const u32x4 w0 = *(const u32x4*)(zr + C_V + 16 * lane), w1 = *(const u32x4*)(zr + C_V + 16 * lane + 8); float f[16];
#pragma unroll
              for (int e = 0; e < 4; ++e) { f[2 * e] = bflo(w0[e]); f[2 * e + 1] = bfhi(w0[e]); f[8 + 2 * e] = bflo(w1[e]); f[8 + 2 * e + 1] = bfhi(w1[e]); }
              float s = 0.f;
#pragma unroll
              for (int e = 0; e < 16; ++e) { f[e] = gelu_t(f[e]); s += f[e]; }
              const float mean = wave_sum(s) * (1.f / 1024.f); float s2 = 0.f;
#pragma unroll
              for (int e = 0; e < 16; ++e) { f[e] -= mean; s2 += f[e] * f[e]; }
              const float rstd = 1.f / sqrtf(wave_sum(s2) * (1.f / 1024.f) + LN_EPS);
              const float* gg = a.in[6] + 16 * lane; const float* bb = a.in[7] + 16 * lane; u32x4 o0, o1;
#pragma unroll
              for (int e = 0; e < 4; ++e) { o0[e] = pk2(f[2 * e] * rstd * gg[2 * e] + bb[2 * e], f[2 * e + 1] * rstd * gg[2 * e + 1] + bb[2 * e + 1]);
                                            o1[e] = pk2(f[8 + 2 * e] * rstd * gg[8 + 2 * e] + bb[8 + 2 * e], f[9 + 2 * e] * rstd * gg[9 + 2 * e] + bb[9 + 2 * e]); }
              *(u32x4*)(zr + C_V + 16 * lane) = o0; *(u32x4*)(zr + C_V + 16 * lane + 8) = o1; }
            { const u32x4 w0 = *(const u32x4*)(zr + C_Q + 16 * lane), w1 = *(const u32x4*)(zr + C_Q + 16 * lane + 8); float f[16];
#pragma unroll
              for (int e = 0; e < 4; ++e) { f[2 * e] = bflo(w0[e]); f[2 * e + 1] = bfhi(w0[e]); f[8 + 2 * e] = bflo(w1[e]); f[8 + 2 * e + 1] = bfhi(w1[e]); }
              if ((lane & 3) == 0) {
#pragma unroll
                  for (int i = 0; i < 8; ++i) { const float x1 = f[i], x2 = f[8 + i]; f[i] = x1 * rc[i] - x2 * rs[i]; f[8 + i] = x2 * rc[i] + x1 * rs[i]; } }
              u32x4 o0, o1;
#pragma unroll
              for (int e = 0; e < 4; ++e) { o0[e] = pk2(f[2 * e] * QSCALE, f[2 * e + 1] * QSCALE); o1[e] = pk2(f[8 + 2 * e] * QSCALE, f[9 + 2 * e] * QSCALE); }
              *(u32x4*)(zr + C_Q + 16 * lane) = o0; *(u32x4*)(zr + C_Q + 16 * lane + 8) = o1; }
            { const int h = lane >> 4, r = lane & 15; const size_t bh = (size_t)(b * 4 + h);
              const f32x4 rcl = *(const f32x4*)(ROPE + tok * 16 + 4 * (r & 1)), rsl = *(const f32x4*)(ROPE + tok * 16 + 8 + 4 * (r & 1));
#pragma unroll
              for (int sg = 0; sg < 6; ++sg) {
                  const u32x2 w = *(const u32x2*)(zr + C_KCMP + sg * 256 + 4 * lane);
                  if (sg == 0) *(u32x2*)(KCMPT + (bh * 8192 + t) * 64 + 4 * r) = w;
                  else if (sg == 1) *(u32x2*)(VCMPT + (bh * 8192 + t) * 64 + 4 * r) = w;
                  else if (sg == 2 || sg == 4) {
                      float x[4] = {bflo(w.x), bfhi(w.x), bflo(w.y), bfhi(w.y)}; float y[4];
#pragma unroll
                      for (int e = 0; e < 4; ++e) { const float other = __shfl_xor(x[e], 2); const float c = rcl[e], sn = rsl[e];
                          y[e] = (r < 2) ? (x[e] * c - other * sn) : ((r < 4) ? (x[e] * c + other * sn) : x[e]); }
                      u32x2 o; o.x = pk2(y[0], y[1]); o.y = pk2(y[2], y[3]); *(u32x2*)(zr + C_KCMP + sg * 256 + 4 * lane) = o;
                  }
              } }
        }
        if (gtid < 512) { const int mat = gtid >> 8, col = gtid & 255; float sum = a.in[mat ? 17 : 12][col];
            for (int ks = 0; ks < 32; ++ks) sum += ((const float*)(ws + WS_C1P))[(mat * 32 + ks) * 256 + col];
            ((float*)(ws + WS_C1))[gtid] = sum; }
        for (int i = gtid; i < 512 * 128; i += NGT) { const int mrow = i >> 7, cgp = i & 127; const u32x4 w = *(const u32x4*)((const bf16_t*)(dout + DO_XKV) + (size_t)mrow * 2048 + 1024 + 8 * cgp);
            bf16_t* p = (bf16_t*)(dout + DO_XVT) + ((size_t)((mrow >> 8) * 1024 + 8 * cgp)) * 256 + (mrow & 255);
#pragma unroll
            for (int e = 0; e < 4; ++e) { p[(2 * e) * 256] = (bf16_t)(w[e] & 0xffffu); p[(2 * e + 1) * 256] = (bf16_t)(w[e] >> 16); } }
    }
    SYNC(2);

    if (IN(3)) RPT(3) {
        const bf16_t* WSTRIL = (const bf16_t*)(ws + WS_WSTRIL);
        for (int un = blockIdx.x; un < 1024; un += G) {
            const int chunk = un >> 3, g = un & 7; const size_t tokbase = (size_t)chunk * 128;
            LAS bf16_t* vT = (LAS bf16_t*)lds;
#pragma unroll
            for (int i = 0; i < 4; ++i) { const int p = tid + 512 * i, s = p >> 4, c0 = (p & 15) * 8; const u32x4 w = *(const u32x4*)(Z + (tokbase + s) * ZC + C_V + g * 128 + c0);
#pragma unroll
                for (int e = 0; e < 4; ++e) { vT[(c0 + 2 * e) * 136 + s] = (bf16_t)(w[e] & 0xffffu); vT[(c0 + 2 * e + 1) * 136 + s] = (bf16_t)(w[e] >> 16); } }
            __syncthreads();
            const int j = lane & 15, q4 = lane >> 4, t = 16 * wid + j;
            f32x4 acc[8];
#pragma unroll
            for (int it = 0; it < 8; ++it) acc[it] = (f32x4){0.f, 0.f, 0.f, 0.f};
            const int nks = (16 * wid + 15) / 32 + 1;
            for (int ks = 0; ks < nks; ++ks) { const bf16x8 wf = *(const bf16x8*)(WSTRIL + (size_t)g * 16384 + t * 128 + 32 * ks + 8 * q4);
#pragma unroll
                for (int it = 0; it < 8; ++it) { const bf16x8 vf = *(const LAS bf16x8*)(vT + (16 * it + j) * 136 + 32 * ks + 8 * q4); acc[it] = MFMA16(vf, wf, acc[it]); } }
            const float bsv = a.in[9][g * 128 + t]; bf16_t* zr = Z + (tokbase + t) * ZC;
#pragma unroll
            for (int it = 0; it < 8; ++it) { const int c = g * 128 + 16 * it + 4 * q4; const u32x2 uw = *(const u32x2*)(zr + C_U + c), gaw = *(const u32x2*)(zr + C_GA + c);
                const float u0 = bflo(uw.x), u1 = bfhi(uw.x), u2 = bflo(uw.y), u3 = bfhi(uw.y), g0 = bflo(gaw.x), g1 = bfhi(gaw.x), g2 = bflo(gaw.y), g3 = bfhi(gaw.y);
                u32x2 o; o.x = pk2(gelu_t(u0) * (acc[it][0] + bsv) * sigm(g0), gelu_t(u1) * (acc[it][1] + bsv) * sigm(g1)); o.y = pk2(gelu_t(u2) * (acc[it][2] + bsv) * sigm(g2), gelu_t(u3) * (acc[it][3] + bsv) * sigm(g3));
                *(u32x2*)(zr + C_U + c) = o; }
            __syncthreads();
        }
        { pg8::Gemm g{(const bf16_t*)(ws + WS_KCMPT), (const bf16_t*)(dout + DO_W1KT), 4096, 256, 2048, 1024}; pg8::StaticOrder So; So.init(4096, 256, G, (int)blockIdx.x);
          pg8::EpiBf16<2> E{(bf16_t*)(ws + WS_HDNK), 256, (const float*)(ws + WS_C1), 1.f}; pg8::gemm_phase<pg8::EpiBf16<2>, pg8::StaticOrder, true>(lds, g, So, E); }
        { pg8::Gemm g{(const bf16_t*)(ws + WS_VCMPT), (const bf16_t*)(dout + DO_W1VT), 4096, 256, 2048, 1024}; pg8::StaticOrder So; So.init(4096, 256, G, (G - 1) - (int)blockIdx.x);
          pg8::EpiBf16<2> E{(bf16_t*)(ws + WS_HDNV), 256, (const float*)(ws + WS_C1) + 256, 1.f}; pg8::gemm_phase<pg8::EpiBf16<2>, pg8::StaticOrder, true>(lds, g, So, E); }
    }
    SYNC(3);

    if (IN(4)) RPT(4) {
        for (int u = gw; u < 512; u += NGW) {
            const int mat = u >> 8, r0 = (u & 255) * 16, j = lane & 15, q4 = lane >> 4;
            const bf16_t* HDN = (const bf16_t*)(ws + (mat ? WS_HDNV : WS_HDNK)); const bf16_t* W2T = (const bf16_t*)(ws + (mat ? WS_W2VT : WS_W2KT)); const float* b2 = a.in[mat ? 19 : 14];
            f32x4 acc[4];
#pragma unroll
            for (int it = 0; it < 4; ++it) acc[it] = (f32x4){0.f, 0.f, 0.f, 0.f};
#pragma unroll
            for (int ks = 0; ks < 8; ++ks) { const bf16x8 hb = *(const bf16x8*)(HDN + (size_t)(r0 + j) * 256 + 32 * ks + 8 * q4);
#pragma unroll
                for (int it = 0; it < 4; ++it) { const bf16x8 wf = *(const bf16x8*)(W2T + (16 * it + j) * 256 + 32 * ks + 8 * q4); acc[it] = MFMA16(wf, hb, acc[it]); } }
            const int r = r0 + j, bh = r >> 9, n = r & 511, b = bh >> 2;
#pragma unroll
            for (int it = 0; it < 4; ++it) { const f32x4 bv = *(const f32x4*)(b2 + 16 * it + 4 * q4); acc[it] = acc[it] + bv; }
            if (mat == 0) {
                const int pt = 16 * n + 31; const float* rt = ROPE + (size_t)(b * 8192 + (pt < 8192 ? pt : 8191)) * 16;
#pragma unroll
                for (int e = 0; e < 4; ++e) { const float x = acc[0][e], other = __shfl_xor(x, 32); const int fi = 4 * (q4 & 1) + e; const float c = rt[fi], sn = rt[8 + fi];
                    acc[0][e] = (q4 < 2) ? (x * c - other * sn) : (x * c + other * sn); }
#pragma unroll
                for (int it = 0; it < 4; ++it) { u32x2 o; o.x = pk2(acc[it][0], acc[it][1]); o.y = pk2(acc[it][2], acc[it][3]); if (n == 511) { o.x = 0u; o.y = 0u; }
                    *(u32x2*)((bf16_t*)(ws + WS_KC) + (size_t)r * 64 + 16 * it + 4 * q4) = o; }
            } else {
#pragma unroll
                for (int it = 0; it < 4; ++it) { u32x2 o; o.x = pk2(acc[it][0], acc[it][1]); o.y = pk2(acc[it][2], acc[it][3]); if (n == 511) { o.x = 0u; o.y = 0u; }
                    *(u32x2*)((bf16_t*)(ws + WS_VCT) + (size_t)r * 64 + 16 * it + 4 * q4) = o; }
            }
        }
    }
    SYNC(4);

    if (IN(5)) RPT(5) {
        const bf16_t* KC = (const bf16_t*)(ws + WS_KC); const bf16_t* VC = (const bf16_t*)(ws + WS_VCT);
        bf16_t* MIX = (bf16_t*)(dout + DO_MIX);
        LAS float* wl = (LAS float*)(lds + 65536 + wid * 4352);
        LAS unsigned* wgum = (LAS unsigned*)(lds + 65536 + 8 * 4352);
        LAS unsigned char* blist = (LAS unsigned char*)(wgum + 8);
        const int j = lane & 15, q4 = lane >> 4, tk = j >> 2, hd = j & 3;
        const int drow = 8 * wid + (lane >> 3), dch = (lane & 7) ^ (lane >> 3);
        const unsigned ldsb = (unsigned)(uintptr_t)lds;
        const unsigned kadr0 = (unsigned)(j * 128 + ((q4 ^ (j & 7)) << 4)), kadr1 = (unsigned)(j * 128 + (((4 + q4) ^ (j & 7)) << 4));
        const int vrow = 4 * q4 + (j >> 2);
        unsigned vadr[4];
#pragma unroll
        for (int dt = 0; dt < 4; ++dt) vadr[dt] = ldsb + 8192u + (unsigned)(vrow * 128 + (((2 * dt + ((lane & 3) >> 1)) ^ (vrow & 7)) << 4) + 8 * (lane & 1));
#define DMA16(g, l) __builtin_amdgcn_global_load_lds((const unsigned*)(g), (LAS unsigned*)(l), 16, 0, 0)
#define ISSUE(nn, KROW0, VROW0, PITCH) do { const int sl_ = (nn) & 3; DMA16((KROW0) + (size_t)drow * (PITCH) + dch * 8, lds + sl_ * 16384 + wid * 1024); \
            DMA16((VROW0) + (size_t)drow * (PITCH) + dch * 8, lds + sl_ * 16384 + 8192 + wid * 1024); } while (0)
#define WAITV(n) asm volatile("s_waitcnt vmcnt(" #n ")" ::: "memory")
#define PIPE_WAIT(n, nb) do { const int rem_ = (nb) - 1 - (n); if (rem_ >= 2) WAITV(4); else if (rem_ == 1) WAITV(2); else WAITV(0); __builtin_amdgcn_s_barrier(); asm volatile("" ::: "memory"); } while (0)
#define QK_LDS(slot, hf, s0, s1) do { const LAS unsigned char* p_ = lds + (slot) * 16384 + (hf) * 4096; const f32x4 z_ = {0.f, 0.f, 0.f, 0.f}; \
            const bf16x8 k00_ = *(const LAS bf16x8*)(p_ + kadr0), k01_ = *(const LAS bf16x8*)(p_ + kadr1), k10_ = *(const LAS bf16x8*)(p_ + 2048 + kadr0), k11_ = *(const LAS bf16x8*)(p_ + 2048 + kadr1); \
            s0 = MFMA16(k00_, qf0, z_); s0 = MFMA16(k01_, qf1, s0); s1 = MFMA16(k10_, qf0, z_); s1 = MFMA16(k11_, qf1, s1); } while (0)
#define PV_LDS(slot, hf, pb, o) do { const unsigned b_ = (unsigned)((slot) * 16384 + (hf) * 4096); const unsigned a0_ = vadr[0] + b_, a1_ = vadr[1] + b_, a2_ = vadr[2] + b_, a3_ = vadr[3] + b_; \
            u32x2 l0_, h0_, l1_, h1_, l2_, h2_, l3_, h3_; \
            asm volatile("ds_read_b64_tr_b16 %0, %8\n\tds_read_b64_tr_b16 %1, %8 offset:2048\n\tds_read_b64_tr_b16 %2, %9\n\tds_read_b64_tr_b16 %3, %9 offset:2048\n\t" \
                         "ds_read_b64_tr_b16 %4, %10\n\tds_read_b64_tr_b16 %5, %10 offset:2048\n\tds_read_b64_tr_b16 %6, %11\n\tds_read_b64_tr_b16 %7, %11 offset:2048\n\ts_waitcnt lgkmcnt(0)" \
                         : "=&v"(l0_), "=&v"(h0_), "=&v"(l1_), "=&v"(h1_), "=&v"(l2_), "=&v"(h2_), "=&v"(l3_), "=&v"(h3_) : "v"(a0_), "v"(a1_), "v"(a2_), "v"(a3_) : "memory"); \
            { u32x4 w_; w_.x = l0_.x; w_.y = l0_.y; w_.z = h0_.x; w_.w = h0_.y; o[0] = MFMA16(__builtin_bit_cast(bf16x8, w_), pb, o[0]); } \
            { u32x4 w_; w_.x = l1_.x; w_.y = l1_.y; w_.z = h1_.x; w_.w = h1_.y; o[1] = MFMA16(__builtin_bit_cast(bf16x8, w_), pb, o[1]); } \
            { u32x4 w_; w_.x = l2_.x; w_.y = l2_.y; w_.z = h2_.x; w_.w = h2_.y; o[2] = MFMA16(__builtin_bit_cast(bf16x8, w_), pb, o[2]); } \
            { u32x4 w_; w_.x = l3_.x; w_.y = l3_.y; w_.z = h3_.x; w_.w = h3_.y; o[3] = MFMA16(__builtin_bit_cast(bf16x8, w_), pb, o[3]); } } while (0)
#define MK8(lo, hi) __builtin_bit_cast(bf16x8, (u32x4){(lo).x, (lo).y, (hi).x, (hi).y})
#define BLOCK64(slot, vm, m, l, o) do { const LAS unsigned char* p_ = lds + (slot) * 16384; const f32x4 z_ = {0.f, 0.f, 0.f, 0.f}; f32x4 s_[4]; \
            { const bf16x8 ka_ = *(const LAS bf16x8*)(p_ + kadr0), kb_ = *(const LAS bf16x8*)(p_ + kadr1), kc_ = *(const LAS bf16x8*)(p_ + 2048 + kadr0), kd_ = *(const LAS bf16x8*)(p_ + 2048 + kadr1); \
              const bf16x8 ke_ = *(const LAS bf16x8*)(p_ + 4096 + kadr0), kf_ = *(const LAS bf16x8*)(p_ + 4096 + kadr1), kg_ = *(const LAS bf16x8*)(p_ + 6144 + kadr0), kh_ = *(const LAS bf16x8*)(p_ + 6144 + kadr1); \
              s_[0] = MFMA16(ka_, qf0, z_); s_[1] = MFMA16(kc_, qf0, z_); s_[2] = MFMA16(ke_, qf0, z_); s_[3] = MFMA16(kg_, qf0, z_); \
              s_[0] = MFMA16(kb_, qf1, s_[0]); s_[1] = MFMA16(kd_, qf1, s_[1]); s_[2] = MFMA16(kf_, qf1, s_[2]); s_[3] = MFMA16(kh_, qf1, s_[3]); } \
            const unsigned b_ = (unsigned)((slot) * 16384); const unsigned a0_ = vadr[0] + b_, a1_ = vadr[1] + b_, a2_ = vadr[2] + b_, a3_ = vadr[3] + b_; \
            u32x2 v0_, v1_, v2_, v3_, v4_, v5_, v6_, v7_, v8_, v9_, v10_, v11_, v12_, v13_, v14_, v15_; \
            asm volatile("ds_read_b64_tr_b16 %0, %16\n\tds_read_b64_tr_b16 %1, %16 offset:2048\n\tds_read_b64_tr_b16 %2, %17\n\tds_read_b64_tr_b16 %3, %17 offset:2048\n\t" \
                         "ds_read_b64_tr_b16 %4, %18\n\tds_read_b64_tr_b16 %5, %18 offset:2048\n\tds_read_b64_tr_b16 %6, %19\n\tds_read_b64_tr_b16 %7, %19 offset:2048\n\t" \
                         "ds_read_b64_tr_b16 %8, %16 offset:4096\n\tds_read_b64_tr_b16 %9, %16 offset:6144\n\tds_read_b64_tr_b16 %10, %17 offset:4096\n\tds_read_b64_tr_b16 %11, %17 offset:6144\n\t" \
                         "ds_read_b64_tr_b16 %12, %18 offset:4096\n\tds_read_b64_tr_b16 %13, %18 offset:6144\n\tds_read_b64_tr_b16 %14, %19 offset:4096\n\tds_read_b64_tr_b16 %15, %19 offset:6144\n\ts_waitcnt lgkmcnt(0)" \
                         : "=&v"(v0_), "=&v"(v1_), "=&v"(v2_), "=&v"(v3_), "=&v"(v4_), "=&v"(v5_), "=&v"(v6_), "=&v"(v7_), "=&v"(v8_), "=&v"(v9_), "=&v"(v10_), "=&v"(v11_), "=&v"(v12_), "=&v"(v13_), "=&v"(v14_), "=&v"(v15_) \
                         : "v"(a0_), "v"(a1_), "v"(a2_), "v"(a3_) : "memory"); \
            bf16x8 pb0_, pb1_; osm_step64(s_, vm, m, l, o, pb0_, pb1_); \
            o[0] = MFMA16(MK8(v0_, v1_), pb0_, o[0]); o[1] = MFMA16(MK8(v2_, v3_), pb0_, o[1]); o[2] = MFMA16(MK8(v4_, v5_), pb0_, o[2]); o[3] = MFMA16(MK8(v6_, v7_), pb0_, o[3]); \
            o[0] = MFMA16(MK8(v8_, v9_), pb1_, o[0]); o[1] = MFMA16(MK8(v10_, v11_), pb1_, o[1]); o[2] = MFMA16(MK8(v12_, v13_), pb1_, o[2]); o[3] = MFMA16(MK8(v14_, v15_), pb1_, o[3]); } while (0)
        for (int uu = blockIdx.x; uu < 2048; uu += G) {
            const int bhu = uu >> 8; int tb = uu & 255; if (bhu & 1) tb = 255 - tb;
            const int b = bhu >> 2, kvh = bhu & 3, t0w = 32 * tb, t0 = t0w + 4 * wid, t = t0 + tk; const size_t tok = (size_t)b * S + t, bh = (size_t)bhu;
            const bf16_t* zr = Z + tok * ZC; const int head = kvh * 4 + hd;
            const bf16x8 qf0 = *(const bf16x8*)(zr + C_Q + head * 64 + 8 * q4), qf1 = *(const bf16x8*)(zr + C_Q + head * 64 + 32 + 8 * q4);
            for (int i = lane; i < 1040; i += 64) wl[i] = 0.f;
            if (tid < 8) wgum[tid] = 0u;
            const float gcm = sigm(bf1(zr[C_GN + head * 3 + 0])), gsl = sigm(bf1(zr[C_GN + head * 3 + 1])), gwn = sigm(bf1(zr[C_GN + head * 3 + 2]));
            f32x4 yb[4];
#pragma unroll
            for (int dt = 0; dt < 4; ++dt) yb[dt] = (f32x4){0.f, 0.f, 0.f, 0.f};
            __syncthreads();
            const int ncw = (t0w + 31 >= 31) ? (((t0w + 31 - 31) >> 4) + 1) : 0;
            const int ncmax = (t0 + 3 >= 31) ? (((t0 + 3 - 31) >> 4) + 1) : 0;
            const int nvalid = (t >= 31) ? (((t - 31) >> 4) + 1) : 0;
            const int nb_c = (ncw + 63) >> 6;
            {
                float m = -1e30f, l = 0.f;
                const bf16_t* kcb = KC + bh * 512 * 64; const bf16_t* vcb = VC + bh * 512 * 64;
                WAITV(0);
                for (int pre = 0; pre < 3 && pre < nb_c; ++pre) ISSUE(pre, kcb + (size_t)pre * 4096, vcb + (size_t)pre * 4096, 64);
                for (int n = 0; n < nb_c; ++n) { const int slot = n & 3; PIPE_WAIT(n, nb_c); if (n + 3 < nb_c) ISSUE(n + 3, kcb + (size_t)(n + 3) * 4096, vcb + (size_t)(n + 3) * 4096, 64);
#pragma unroll
                    for (int hf = 0; hf < 2; ++hf) { const int kb = 64 * n + 32 * hf; if (kb < ncmax) { f32x4 s0, s1; QK_LDS(slot, hf, s0, s1);
                        float mx = -1e30f;
#pragma unroll
                        for (int e = 0; e < 4; ++e) { if (kb + 4 * q4 + e < nvalid) mx = fmaxf(mx, s0[e]); if (kb + 16 + 4 * q4 + e < nvalid) mx = fmaxf(mx, s1[e]); }
                        mx = fmaxf(mx, __shfl_xor(mx, 16)); mx = fmaxf(mx, __shfl_xor(mx, 32));
                        const float mn = fmaxf(m, mx); float ps = 0.f;
#pragma unroll
                        for (int e = 0; e < 4; ++e) { if (kb + 4 * q4 + e < nvalid) ps += __builtin_amdgcn_exp2f(s0[e] - mn); if (kb + 16 + 4 * q4 + e < nvalid) ps += __builtin_amdgcn_exp2f(s1[e] - mn); }
                        l = l * __builtin_amdgcn_exp2f(m - mn) + ps; m = mn; } } }
                l += __shfl_xor(l, 16); l += __shfl_xor(l, 32);
                const float invl = l > 0.f ? 1.f / l : 0.f;
                f32x4 o[4];
#pragma unroll
                for (int dt = 0; dt < 4; ++dt) o[dt] = (f32x4){0.f, 0.f, 0.f, 0.f};
                WAITV(0); __builtin_amdgcn_s_barrier();
                for (int pre = 0; pre < 3 && pre < nb_c; ++pre) ISSUE(pre, kcb + (size_t)pre * 4096, vcb + (size_t)pre * 4096, 64);
                for (int n = 0; n < nb_c; ++n) { const int slot = n & 3; PIPE_WAIT(n, nb_c); if (n + 3 < nb_c) ISSUE(n + 3, kcb + (size_t)(n + 3) * 4096, vcb + (size_t)(n + 3) * 4096, 64);
#pragma unroll
                    for (int hf = 0; hf < 2; ++hf) { const int kb = 64 * n + 32 * hf; if (kb < ncmax) { f32x4 s0, s1; QK_LDS(slot, hf, s0, s1);
                        float p[8];
#pragma unroll
                        for (int e = 0; e < 4; ++e) { p[e] = (kb + 4 * q4 + e < nvalid) ? __builtin_amdgcn_exp2f(s0[e] - m) * invl : 0.f; p[4 + e] = (kb + 16 + 4 * q4 + e < nvalid) ? __builtin_amdgcn_exp2f(s1[e] - m) * invl : 0.f; }
                        float a0 = (p[0] + p[1]) + (p[2] + p[3]), a1 = (p[4] + p[5]) + (p[6] + p[7]), x0 = p[3], x1 = p[7];
                        a0 += dpp_xor1(a0); a0 += dpp_xor2(a0); a1 += dpp_xor1(a1); a1 += dpp_xor2(a1);
                        x0 += dpp_xor1(x0); x0 += dpp_xor2(x0); x1 += dpp_xor1(x1); x1 += dpp_xor2(x1);
                        if (hd == 0) { const int jj0 = (kb >> 2) + q4, jj1 = jj0 + 4; wl[tk * 128 + jj0] = a0; wl[tk * 128 + jj1] = a1; wl[512 + tk * 132 + jj0 + 1] = x0; wl[512 + tk * 132 + jj1 + 1] = x1; }
                        const bf16x8 pb = pack_p(p); PV_LDS(slot, hf, pb, o); } } }
#pragma unroll
                for (int dt = 0; dt < 4; ++dt) yb[dt] = yb[dt] + o[dt] * gcm;
            }
            LDS_WAIT();
            unsigned mysel[4], um[4];
            {
                const int tk2 = lane >> 4, r = lane & 15, cur = t0 >> 6;
                float val[8];
#pragma unroll
                for (int mm = 0; mm < 8; ++mm) { const int jj = r + 16 * mm; const float pvv = wl[tk2 * 128 + jj] + wl[512 + tk2 * 132 + jj];
                    const bool forced = (jj == 0) | (jj == cur) | (jj == cur - 1);
                    val[mm] = forced ? __builtin_inff() : (jj <= cur ? pvv : -__builtin_inff()); }
                LDS_WAIT();
#pragma unroll
                for (int mm = 0; mm < 8; ++mm) wl[tk2 * 128 + r + 16 * mm] = val[mm];
                LDS_WAIT();
                int rank[8];
#pragma unroll
                for (int mm = 0; mm < 8; ++mm) rank[mm] = 0;
                for (int jp = 0; jp <= cur; ++jp) { const float vp = wl[tk2 * 128 + jp];
#pragma unroll
                    for (int mm = 0; mm < 8; ++mm) rank[mm] += ((vp > val[mm]) || (vp == val[mm] && jp < r + 16 * mm)) ? 1 : 0; }
                unsigned long long bm[8];
#pragma unroll
                for (int mm = 0; mm < 8; ++mm) bm[mm] = __ballot((r + 16 * mm <= cur) && rank[mm] < 16);
#pragma unroll
                for (int w = 0; w < 4; ++w) { const unsigned long long b0 = bm[2 * w], b1 = bm[2 * w + 1];
                    mysel[w] = (unsigned)((b0 >> (16 * tk)) & 0xFFFFull) | ((unsigned)((b1 >> (16 * tk)) & 0xFFFFull) << 16);
                    const unsigned u0 = (unsigned)((b0 | (b0 >> 16) | (b0 >> 32) | (b0 >> 48)) & 0xFFFFull), u1 = (unsigned)((b1 | (b1 >> 16) | (b1 >> 32) | (b1 >> 48)) & 0xFFFFull);
                    um[w] = (unsigned)__builtin_amdgcn_readfirstlane((int)(u0 | (u1 << 16))); }
                if (lane < 4) { const unsigned v = lane == 0 ? um[0] : (lane == 1 ? um[1] : (lane == 2 ? um[2] : um[3])); atomicOr((unsigned*)(wgum + lane), v); }
            }
            __syncthreads();
            if (tid < 128) { const int w = tid >> 5, bi = tid & 31; const unsigned w0 = wgum[0], w1 = wgum[1], w2 = wgum[2], w3 = wgum[3]; const unsigned word = w == 0 ? w0 : (w == 1 ? w1 : (w == 2 ? w2 : w3));
                if ((word >> bi) & 1u) { const int pos = (w > 0 ? __builtin_popcount(w0) : 0) + (w > 1 ? __builtin_popcount(w1) : 0) + (w > 2 ? __builtin_popcount(w2) : 0) + __builtin_popcount(word & ((1u << bi) - 1u)); blist[pos] = (unsigned char)tid; }
                if (tid == 0) wgum[4] = (unsigned)(__builtin_popcount(w0) + __builtin_popcount(w1) + __builtin_popcount(w2) + __builtin_popcount(w3)); }
            __syncthreads();
            {
                float m = -1e30f, l = 0.f; f32x4 o[4];
#pragma unroll
                for (int dt = 0; dt < 4; ++dt) o[dt] = (f32x4){0.f, 0.f, 0.f, 0.f};
                const int nb_s = (int)wgum[4];
                const bf16_t* ksb = Z + (size_t)b * S * ZC + C_KSLC + kvh * 64; const bf16_t* vsb = Z + (size_t)b * S * ZC + C_VSLC + kvh * 64;
                WAITV(0);
                for (int pre = 0; pre < 3 && pre < nb_s; ++pre) { const size_t ro = (size_t)(64 * (int)blist[pre]) * ZC; ISSUE(pre, ksb + ro, vsb + ro, ZC); }
                for (int n = 0; n < nb_s; ++n) { const int slot = n & 3; const int jj = blist[n]; PIPE_WAIT(n, nb_s);
                    if (n + 3 < nb_s) { const size_t ro = (size_t)(64 * (int)blist[n + 3]) * ZC; ISSUE(n + 3, ksb + ro, vsb + ro, ZC); }
                    const unsigned uw = jj < 32 ? um[0] : (jj < 64 ? um[1] : (jj < 96 ? um[2] : um[3]));
                    if ((uw >> (jj & 31)) & 1u) { const unsigned mw = jj < 32 ? mysel[0] : (jj < 64 ? mysel[1] : (jj < 96 ? mysel[2] : mysel[3])); const bool mine = (mw >> (jj & 31)) & 1u;
                        unsigned vm = mine ? 0xFFFFu : 0u;
                        if (jj >= (t0 >> 6)) { vm = 0u;
#pragma unroll
                            for (int qd = 0; qd < 4; ++qd)
#pragma unroll
                                for (int e = 0; e < 4; ++e) vm |= (mine && (64 * jj + 16 * qd + 4 * q4 + e <= t)) ? (1u << (4 * qd + e)) : 0u; }
                        BLOCK64(slot, vm, m, l, o); } }
                l += __shfl_xor(l, 16); l += __shfl_xor(l, 32); const float sc2 = (l > 0.f ? 1.f / l : 0.f) * gsl;
#pragma unroll
                for (int dt = 0; dt < 4; ++dt) yb[dt] = yb[dt] + o[dt] * sc2;
            }
            {
                float m = -1e30f, l = 0.f; f32x4 o[4];
#pragma unroll
                for (int dt = 0; dt < 4; ++dt) o[dt] = (f32x4){0.f, 0.f, 0.f, 0.f};
                const int kws = ((t0w - 511 > 0) ? (t0w - 511) : 0) & ~63; const int nb_w = ((t0w + 31 - kws) >> 6) + 1;
                const bf16_t* kwb = Z + ((size_t)b * S + kws) * ZC + C_KWIN + kvh * 64; const bf16_t* vwb = Z + ((size_t)b * S + kws) * ZC + C_VWIN + kvh * 64;
                WAITV(0); __builtin_amdgcn_s_barrier();
                for (int pre = 0; pre < 3 && pre < nb_w; ++pre) ISSUE(pre, kwb + (size_t)(64 * pre) * ZC, vwb + (size_t)(64 * pre) * ZC, ZC);
                for (int n = 0; n < nb_w; ++n) { const int slot = n & 3; PIPE_WAIT(n, nb_w);
                    if (n + 3 < nb_w) ISSUE(n + 3, kwb + (size_t)(64 * (n + 3)) * ZC, vwb + (size_t)(64 * (n + 3)) * ZC, ZC);
                    const int key0 = kws + 64 * n;
                    if (key0 + 63 >= t0 - 511 && key0 <= t0 + 3) {
                        unsigned vm = 0xFFFFu;
                        if (!(key0 + 63 <= t0 && key0 > t0 + 3 - 512)) { vm = 0u;
#pragma unroll
                            for (int qd = 0; qd < 4; ++qd)
#pragma unroll
                                for (int e = 0; e < 4; ++e) { const int kk = key0 + 16 * qd + 4 * q4 + e; vm |= (kk <= t && kk > t - 512) ? (1u << (4 * qd + e)) : 0u; } }
                        BLOCK64(slot, vm, m, l, o); } }
                l += __shfl_xor(l, 16); l += __shfl_xor(l, 32); const float sc2 = (l > 0.f ? 1.f / l : 0.f) * gwn;
#pragma unroll
                for (int dt = 0; dt < 4; ++dt) yb[dt] = yb[dt] + o[dt] * sc2;
            }
#pragma unroll
            for (int dt = 0; dt < 4; ++dt) { const int c = head * 64 + 16 * dt + 4 * q4; const u32x2 mw = *(const u32x2*)(zr + C_U + c), gw2 = *(const u32x2*)(zr + C_GB + c);
                u32x2 o2; o2.x = pk2(bflo(mw.x) + sigm(bflo(gw2.x)) * yb[dt][0], bfhi(mw.x) + sigm(bfhi(gw2.x)) * yb[dt][1]); o2.y = pk2(bflo(mw.y) + sigm(bflo(gw2.y)) * yb[dt][2], bfhi(mw.y) + sigm(bfhi(gw2.y)) * yb[dt][3]);
                *(u32x2*)(MIX + tok * 1024 + c) = o2; }
            __syncthreads();
        }
#undef DMA16
#undef ISSUE
#undef WAITV
#undef PIPE_WAIT
#undef QK_LDS
#undef PV_LDS
#undef BLOCK64
#undef MK8
    }
    SYNC(5);

    if (IN(6)) RPT(6) { pg8::Gemm g{(const bf16_t*)(dout + DO_MIX), (const bf16_t*)(ws + WS_WOUT_T), T, D, D, D}; pg8::StaticOrder So; So.init(T, D, G, (int)blockIdx.x);
        pg8::EpiF32 E{(float*)(ws + WS_ACCF), D}; pg8::gemm_phase<pg8::EpiF32, pg8::StaticOrder, true>(lds, g, So, E); }
    SYNC(6);

    if (IN(7)) RPT(7) {
        for (int m = gw; m < T; m += NGW) { f32x4 v[4], ac[4]; row_load(v, a.in[0] + (size_t)m * D, lane); row_load(ac, (const float*)(ws + WS_ACCF) + (size_t)m * D, lane); ln_apply(v, a.in[3], a.in[4], lane);
#pragma unroll
            for (int jx = 0; jx < 4; ++jx) v[jx] = v[jx] * ALPHA + ac[jx];
            ln_apply(v, a.in[21], a.in[22], lane); row_store_f32(v, (float*)(ws + WS_HF) + (size_t)m * D, lane); row_store_bf16(v, (bf16_t*)(ws + WS_HB) + (size_t)m * D, lane); }
        LAS float* scr = (LAS float*)(lds + wid * 8448);
        constexpr int I_SQ = 16 * 32, I_F1 = 16 * 128, I_F2 = 64 * 32;
        for (int it = gw; it < 2 * I_SQ + I_F1 + I_F2; it += NGW) { int r = it;
            if (r < I_SQ) { tr_item(a.in[23], 1024, 1024, 1024, (bf16_t*)(ws + WS_WXQ_T), scr, r, lane); continue; } r -= I_SQ;
            if (r < I_SQ) { tr_item(a.in[25], 1024, 1024, 1024, (bf16_t*)(ws + WS_WXO_T), scr, r, lane); continue; } r -= I_SQ;
            if (r < I_F1) { tr_item(a.in[28], 1024, 4096, 4096, (bf16_t*)(ws + WS_WFF1_T), scr, r, lane); continue; } r -= I_F1;
            tr_item(a.in[29], 4096, 1024, 1024, (bf16_t*)(ws + WS_WFF2_T), scr, r, lane); }
    }
    SYNC(7);

    if (IN(8)) RPT(8) { pg8::Gemm g{(const bf16_t*)(ws + WS_HB), (const bf16_t*)(ws + WS_WXQ_T), T, D, D, D}; pg8::StaticOrder So; So.init(T, D, G, (int)blockIdx.x);
        pg8::EpiBf16<0> E{(bf16_t*)(ws + WS_XQ), D, nullptr, XSCALE}; pg8::gemm_phase<pg8::EpiBf16<0>, pg8::StaticOrder, true>(lds, g, So, E); }
    SYNC(8);

    if (IN(9)) RPT(9) {
        const bf16_t* XQ = (const bf16_t*)(ws + WS_XQ); const bf16_t* XKV = (const bf16_t*)(dout + DO_XKV); const bf16_t* XVT = (const bf16_t*)(dout + DO_XVT); bf16_t* XO = (bf16_t*)(ws + WS_XO);
        const int j = lane & 15, q4 = lane >> 4;
        for (int u = gw; u < 4096; u += NGW) { const int hx = u & 3, tok0 = (u >> 2) * 16, b = tok0 >> 13;
            bf16x8 qf[8];
#pragma unroll
            for (int ks = 0; ks < 8; ++ks) qf[ks] = *(const bf16x8*)(XQ + (size_t)(tok0 + j) * 1024 + hx * 256 + 32 * ks + 8 * q4);
            f32x4 s[16];
#pragma unroll
            for (int kt = 0; kt < 16; ++kt) { const bf16_t* kp = XKV + (size_t)(b * 256 + 16 * kt + j) * 2048 + hx * 256 + 8 * q4; s[kt] = (f32x4){0.f, 0.f, 0.f, 0.f};
#pragma unroll
                for (int ks = 0; ks < 8; ++ks) s[kt] = MFMA16(*(const bf16x8*)(kp + 32 * ks), qf[ks], s[kt]); }
            float mx = -1e30f;
#pragma unroll
            for (int kt = 0; kt < 16; ++kt) mx = fmaxf(fmaxf(mx, fmaxf(s[kt][0], s[kt][1])), fmaxf(s[kt][2], s[kt][3]));
            mx = fmaxf(mx, __shfl_xor(mx, 16)); mx = fmaxf(mx, __shfl_xor(mx, 32));
            float l = 0.f; bf16x8 pf[8];
#pragma unroll
            for (int kk = 0; kk < 8; ++kk) { float p[8];
#pragma unroll
                for (int e = 0; e < 4; ++e) { p[e] = __builtin_amdgcn_exp2f(s[2 * kk][e] - mx); p[4 + e] = __builtin_amdgcn_exp2f(s[2 * kk + 1][e] - mx); l += p[e] + p[4 + e]; }
                pf[kk] = pack_p(p); }
            l += __shfl_xor(l, 16); l += __shfl_xor(l, 32); const float invl = 1.f / l;
#pragma unroll 2
            for (int dt = 0; dt < 16; ++dt) { f32x4 o = {0.f, 0.f, 0.f, 0.f}; const bf16_t* vp = XVT + (size_t)(b * 1024 + hx * 256 + 16 * dt + j) * 256 + 4 * q4;
#pragma unroll
                for (int kk = 0; kk < 8; ++kk) { const u32x2 vlo = *(const u32x2*)(vp + 32 * kk), vhi = *(const u32x2*)(vp + 32 * kk + 16); u32x4 w; w.x = vlo.x; w.y = vlo.y; w.z = vhi.x; w.w = vhi.y;
                    o = MFMA16(__builtin_bit_cast(bf16x8, w), pf[kk], o); }
                u32x2 ow; ow.x = pk2(o[0] * invl, o[1] * invl); ow.y = pk2(o[2] * invl, o[3] * invl);
                *(u32x2*)(XO + (size_t)(tok0 + j) * 1024 + hx * 256 + 16 * dt + 4 * q4) = ow; }
        }
    }
    SYNC(9);

    if (IN(10)) RPT(10) { pg8::Gemm g{(const bf16_t*)(ws + WS_XO), (const bf16_t*)(ws + WS_WXO_T), T, D, D, D}; pg8::StaticOrder So; So.init(T, D, G, (int)blockIdx.x);
        pg8::EpiF32 E{(float*)(ws + WS_ACCF), D}; pg8::gemm_phase<pg8::EpiF32, pg8::StaticOrder, true>(lds, g, So, E); }
    SYNC(10);

    if (IN(11)) RPT(11) {
        for (int m = gw; m < T; m += NGW) { f32x4 v[4], ac[4]; row_load(v, (const float*)(ws + WS_HF) + (size_t)m * D, lane); row_load(ac, (const float*)(ws + WS_ACCF) + (size_t)m * D, lane);
#pragma unroll
            for (int jx = 0; jx < 4; ++jx) v[jx] = v[jx] * ALPHA + ac[jx];
            ln_apply(v, a.in[26], a.in[27], lane); row_store_f32(v, (float*)(ws + WS_HF) + (size_t)m * D, lane); row_store_bf16(v, (bf16_t*)(ws + WS_HB) + (size_t)m * D, lane); }
    }
    SYNC(11);

    if (IN(12)) RPT(12) { pg8::Gemm g{(const bf16_t*)(ws + WS_HB), (const bf16_t*)(ws + WS_WFF1_T), T, FF, D, D}; pg8::StaticOrder So; So.init(T, FF, G, (int)blockIdx.x);
        pg8::EpiBf16<3> E{(bf16_t*)(ws + WS_FFB), FF, nullptr, 1.f}; pg8::gemm_phase<pg8::EpiBf16<3>, pg8::StaticOrder, true>(lds, g, So, E); }
    SYNC(12);

    if (IN(13)) RPT(13) { pg8::Gemm g{(const bf16_t*)(ws + WS_FFB), (const bf16_t*)(ws + WS_WFF2_T), T, D, FF, FF}; pg8::StaticOrder So; So.init(T, D, G, (int)blockIdx.x);
        pg8::EpiF32 E{a.out, D}; pg8::gemm_phase<pg8::EpiF32, pg8::StaticOrder, true>(lds, g, So, E); }
    SYNC(13);

    if (IN(14)) RPT(14) {
        for (int m = gw; m < T; m += NGW) { f32x4 v[4], ac[4]; row_load(v, (const float*)(ws + WS_HF) + (size_t)m * D, lane); row_load(ac, a.out + (size_t)m * D, lane);
#pragma unroll
            for (int jx = 0; jx < 4; ++jx) v[jx] = v[jx] * ALPHA + ac[jx];
            ln_apply(v, a.in[30], a.in[31], lane); row_store_f32(v, a.out + (size_t)m * D, lane); }
    }
#undef IN
#undef SYNC
}

constexpr int NPHASE = 15;
extern "C" void kernel_launch(void* const* d_in, const int* in_sizes, int n_in, void* d_out, int out_size, void* d_ws, size_t ws_size, hipStream_t stream) {
    static int grid = 0;
    if (grid == 0) {
        if (n_in != 32 || out_size != T * D || ws_size < 256 * MiB) { fprintf(stderr, "kernel_launch: unexpected shapes (n_in %d out %d ws %zu)\n", n_in, out_size, ws_size); grid = -1; return; }
        int dev = 0, cus = 0, per_cu = 0;
        hipGetDevice(&dev); hipDeviceGetAttribute(&cus, hipDeviceAttributeMultiprocessorCount, dev);
        hipFuncSetAttribute((const void*)mk_fwd, hipFuncAttributeMaxDynamicSharedMemorySize, LDS_BYTES);
        hipOccupancyMaxActiveBlocksPerMultiprocessor(&per_cu, (const void*)mk_fwd, 512, LDS_BYTES);
        (void)hipGetLastError();
        if (per_cu < 1) fprintf(stderr, "kernel_launch: occupancy query says %d blocks per CU\n", per_cu);
        grid = cus > 0 ? cus : 256;
    }
    if (grid < 0) return;
    Args a{};
    for (int i = 0; i < 32; ++i) a.in[i] = (const float*)d_in[i];
    a.out = (float*)d_out; a.ws = (unsigned char*)d_ws; a.ph_lo = 0; a.ph_hi = NPHASE;
    void* args[] = {&a};
    hipError_t e = hipLaunchCooperativeKernel((const void*)mk_fwd, dim3(grid), dim3(512), args, LDS_BYTES, stream);
    if (e != hipSuccess) fprintf(stderr, "cooperative launch failed: %s (grid %d)\n", hipGetErrorString(e), grid);
}
```

```cpp
#include <hip/hip_runtime.h>
#include <hip/hip_cooperative_groups.h>
#include <cstdio>
#include <cstdint>
namespace cg = cooperative_groups;

#define LAS __attribute__((address_space(3)))
typedef unsigned short bf16_t;
typedef short bf16x8 __attribute__((ext_vector_type(8)));
typedef float f32x4 __attribute__((ext_vector_type(4)));
typedef float f32x2 __attribute__((ext_vector_type(2)));
typedef unsigned u32x4 __attribute__((ext_vector_type(4)));
typedef unsigned u32x2 __attribute__((ext_vector_type(2)));

__device__ __forceinline__ unsigned f2bf(float f) { unsigned u = __builtin_bit_cast(unsigned, f); return (u + 0x7fffu + ((u >> 16) & 1u)) >> 16; }
__device__ __forceinline__ unsigned pk2(float lo, float hi) { return f2bf(lo) | (f2bf(hi) << 16); }
__device__ __forceinline__ float bflo(unsigned w) { return __builtin_bit_cast(float, w << 16); }
__device__ __forceinline__ float bfhi(unsigned w) { return __builtin_bit_cast(float, w & 0xffff0000u); }
__device__ __forceinline__ float bf1(bf16_t h) { return __builtin_bit_cast(float, ((unsigned)h) << 16); }
__device__ __forceinline__ float gelu_t(float x) { const float u = x * (1.f + 0.044715f * x * x); const float e = __builtin_amdgcn_exp2f(-2.3022081986f * u); return x * __builtin_amdgcn_rcpf(1.f + e); }
__device__ __forceinline__ float sigm(float x) { return __builtin_amdgcn_rcpf(1.f + __builtin_amdgcn_exp2f(-1.4426950409f * x)); }
__device__ __forceinline__ float wave_sum(float v) {
#pragma unroll
    for (int o = 1; o < 64; o <<= 1) v += __shfl_xor(v, o);
    return v;
}
#define LDS_WAIT() asm volatile("s_waitcnt lgkmcnt(0)" ::: "memory")

namespace pg8 {
constexpr int BM = 256, BK = 64, HALF = 128, HTB = HALF * BK * 2, STAGE_BYTES = 8 * HTB, NXCD = 8, WGM = 8;
__host__ __device__ __forceinline__ int lds_byte(int r, int c) { const int st = (r >> 4) * 2 + (c >> 5), rr = r & 15, cc = c & 31, ob = rr * 64 + cc * 2; return st * 1024 + (ob ^ (((ob >> 9) & 1) << 5)); }
__host__ __device__ __forceinline__ void stage_rc(int b, int& R, int& C) { const int st = b / 1024, sb = b % 1024, swz = sb ^ (((sb >> 9) & 1) << 5); R = (st >> 1) * 16 + swz / 64; C = (st & 1) * 32 + (swz % 64) / 2; }
__host__ __device__ __forceinline__ int perm32(int rho) { const int n = rho >> 4, i = rho & 15; return 8 * (i >> 2) + 4 * n + (i & 3); }
struct Unit { int pm, pn; };
struct Gemm { const bf16_t* A; const bf16_t* Bt; int M, N, K, lda; };
struct StaticOrder {
    int nM, nN, nwg, G, c;
    __device__ void init(int M, int N, int G_, int c_) { nM = M / BM; nN = N / BM; nwg = nM * nN; G = G_; c = c_; }
    __device__ bool next(int i, Unit& u) const {
        const long L = (long)i * G + c; if (L >= nwg) return false;
        int wgid = (int)L; { const int q = nwg / NXCD, r = nwg % NXCD, xcd = wgid % NXCD, off = wgid / NXCD; wgid = (xcd < r ? xcd * (q + 1) : r * (q + 1) + (xcd - r) * q) + off; }
        const int nig = WGM * nN, gid = wgid / nig, fm = gid * WGM, gsz = (nM - fm) < WGM ? (nM - fm) : WGM;
        u.pm = fm + ((wgid % nig) % gsz); u.pn = (wgid % nig) / gsz; return true;
    }
};
__device__ __forceinline__ unsigned cvt_pk_bf16(float lo, float hi) { unsigned r; asm volatile("v_cvt_pk_bf16_f32 %0, %1, %2" : "=v"(r) : "v"(lo), "v"(hi)); return r; }

template <int ACT> struct EpiBf16 {
    static constexpr bool PERM = true;
    bf16_t* O; int ldc; const float* bias; float scale;
    __device__ __forceinline__ void operator()(const f32x4 (&acc)[2][2][4][2], const Unit& u, int wr, int wc, int fr, int fq) const {
        const int row0 = u.pm * BM + wr * 64 + fr; const int col0 = u.pn * BM + wc * 32 + 8 * fq;
        f32x4 bv[2][2];
#pragma unroll
        for (int bj = 0; bj < 2; ++bj)
#pragma unroll
            for (int n = 0; n < 2; ++n) bv[bj][n] = bias ? *(const f32x4*)(bias + col0 + bj * HALF + 4 * n) : (f32x4){0.f, 0.f, 0.f, 0.f};
#pragma unroll
        for (int ai = 0; ai < 2; ++ai)
#pragma unroll
            for (int m = 0; m < 4; ++m) { bf16_t* rowp = O + (size_t)(row0 + ai * HALF + m * 16) * ldc + col0;
#pragma unroll
                for (int bj = 0; bj < 2; ++bj) { f32x4 v0 = acc[ai][bj][m][0] + bv[bj][0], v1 = acc[ai][bj][m][1] + bv[bj][1];
                    if (ACT == 2) {
#pragma unroll
                        for (int e = 0; e < 4; ++e) { v0[e] = gelu_t(v0[e]); v1[e] = gelu_t(v1[e]); } }
                    if (ACT == 3) {
#pragma unroll
                        for (int e = 0; e < 4; ++e) { float a0 = v0[e] > 0.f ? v0[e] : 0.f, a1 = v1[e] > 0.f ? v1[e] : 0.f; v0[e] = a0 * a0; v1[e] = a1 * a1; } }
                    v0 = v0 * scale; v1 = v1 * scale; u32x4 w; w.x = cvt_pk_bf16(v0[0], v0[1]); w.y = cvt_pk_bf16(v0[2], v0[3]); w.z = cvt_pk_bf16(v1[0], v1[1]); w.w = cvt_pk_bf16(v1[2], v1[3]);
                    *(u32x4*)(rowp + bj * HALF) = w; } }
    }
};
struct EpiF32 {
    static constexpr bool PERM = false;
    float* O; int ldc;
    __device__ __forceinline__ void operator()(const f32x4 (&acc)[2][2][4][2], const Unit& u, int wr, int wc, int fr, int fq) const {
        const int row0 = u.pm * BM + wr * 64 + fr; const int col0 = u.pn * BM + wc * 32 + 4 * fq;
#pragma unroll
        for (int ai = 0; ai < 2; ++ai)
#pragma unroll
            for (int m = 0; m < 4; ++m) { float* rowp = O + (size_t)(row0 + ai * HALF + m * 16) * ldc + col0;
#pragma unroll
                for (int bj = 0; bj < 2; ++bj)
#pragma unroll
                    for (int n = 0; n < 2; ++n) *(f32x4*)(rowp + bj * HALF + n * 16) = acc[ai][bj][m][n]; }
    }
};

template <class Epi, class Sched, bool ALIGN_EPI>
__device__ __forceinline__ void gemm_phase(LAS unsigned char* lds, const Gemm g, const Sched& S, const Epi& E) {
    const int tid = threadIdx.x, wid = __builtin_amdgcn_readfirstlane(tid >> 6), lane = tid & 63, wr = wid >> 2, wc = wid & 3, fr = lane & 15, fq = lane >> 4;
    const int K = g.K, nt = K / BK, lda = g.lda;
    unsigned voffA[2], voffB[2];
#pragma unroll
    for (int i = 0; i < 2; ++i) { int R, C; stage_rc(tid * 16 + i * 8192, R, C); const int Rb = Epi::PERM ? ((R & ~31) + perm32(R & 31)) : R;
        voffA[i] = (unsigned)(R * lda + C) * 2u; voffB[i] = (unsigned)(Rb * K + C) * 2u; }
    const size_t kstep = (size_t)(BK * 2);
    const size_t hstepA = (size_t)HALF * lda * 2, hstepB = (size_t)HALF * K * 2;
    const size_t tstepA = 2 * hstepA, tstepB = 2 * hstepB;
    const unsigned ldsw = (unsigned)wid * 1024u;
    const int aoff = lds_byte(wr * 64 + fr, fq * 8), boff = lds_byte(wc * 32 + fr, fq * 8);
#define PG8_SA(b, h) (((b) * 2 + (h)) * HTB)
#define PG8_SB(b, h) ((4 + (b) * 2 + (h)) * HTB)
#define PG8_STAGE(bufoff, gbase, voff) do { _Pragma("unroll") for (int _i = 0; _i < 2; ++_i) \
        __builtin_amdgcn_global_load_lds((const unsigned*)((const char*)(gbase) + (voff)[_i]), (LAS unsigned*)(lds + (bufoff) + ldsw + _i * 8192), 16, 0, 0); } while (0)
#define PG8_LDA(dst, b, h) do { _Pragma("unroll") for (int m = 0; m < 4; ++m) _Pragma("unroll") for (int k = 0; k < 2; ++k) dst[m][k] = *(const LAS bf16x8*)(lds + PG8_SA(b, h) + aoff + m * 2048 + k * 1024); } while (0)
#define PG8_LDB(dst, b, h) do { _Pragma("unroll") for (int n = 0; n < 2; ++n) _Pragma("unroll") for (int k = 0; k < 2; ++k) dst[n][k] = *(const LAS bf16x8*)(lds + PG8_SB(b, h) + boff + n * 2048 + k * 1024); } while (0)
#define PG8_MMA(ai, bj, At, Bt) do { __builtin_amdgcn_s_setprio(1); _Pragma("unroll") for (int m = 0; m < 4; ++m) _Pragma("unroll") for (int n = 0; n < 2; ++n) _Pragma("unroll") for (int k = 0; k < 2; ++k) \
        acc[ai][bj][m][n] = __builtin_amdgcn_mfma_f32_16x16x32_bf16(Bt[n][k], At[m][k], acc[ai][bj][m][n], 0, 0, 0); __builtin_amdgcn_s_setprio(0); } while (0)
#define PG8_WAIT_V(n) asm volatile("s_waitcnt vmcnt(" #n ")" ::: "memory")
#define PG8_WAIT_L(n) asm volatile("s_waitcnt lgkmcnt(" #n ")" ::: "memory")
#define PG8_BAR __builtin_amdgcn_s_barrier()
#define PG8_SCHED __builtin_amdgcn_sched_barrier(0)
    Unit cur, nxt; int ui = 0;
    if (!S.next(0, cur)) return;
    f32x4 acc[2][2][4][2];
#pragma unroll
    for (int a = 0; a < 2; ++a)
#pragma unroll
        for (int b = 0; b < 2; ++b)
#pragma unroll
            for (int m = 0; m < 4; ++m)
#pragma unroll
                for (int n = 0; n < 2; ++n) acc[a][b][m][n] = (f32x4){0.f, 0.f, 0.f, 0.f};
    bf16x8 At[4][2], B0[2][2], B1[2][2];
    const char* cA = (const char*)g.A + (size_t)cur.pm * tstepA; const char* cB = (const char*)g.Bt + (size_t)cur.pn * tstepB;
    PG8_STAGE(PG8_SB(0, 0), cB, voffB); PG8_STAGE(PG8_SB(0, 1), cB + hstepB, voffB); PG8_STAGE(PG8_SA(0, 0), cA, voffA); PG8_STAGE(PG8_SA(0, 1), cA + hstepA, voffA);
    if (wr == 1) PG8_BAR;
    PG8_WAIT_V(2); PG8_BAR;
    PG8_STAGE(PG8_SB(1, 0), cB + kstep, voffB); PG8_STAGE(PG8_SA(1, 0), cA + kstep, voffA); PG8_STAGE(PG8_SB(1, 1), cB + hstepB + kstep, voffB);
    PG8_WAIT_V(6); PG8_BAR;
    for (;;) {
        const bool has_next = S.next(ui + 1, nxt);
        const char* nA = has_next ? (const char*)g.A + (size_t)nxt.pm * tstepA : cA; const char* nB = has_next ? (const char*)g.Bt + (size_t)nxt.pn * tstepB : cB;
        for (int t = 0; t < nt; t += 2) {
            const bool last = (t == nt - 2);
            const char* a1 = cA + (size_t)(t + 1) * kstep;
            const char* a2 = last ? nA : cA + (size_t)(t + 2) * kstep; const char* b2 = last ? nB : cB + (size_t)(t + 2) * kstep;
            const char* a3 = a2 + kstep; const char* b3 = b2 + kstep;
            PG8_LDB(B0, 0, 0); PG8_LDB(B1, 0, 1); PG8_SCHED; PG8_LDA(At, 0, 0); PG8_STAGE(PG8_SA(1, 1), a1 + hstepA, voffA);
            PG8_WAIT_V(8); PG8_WAIT_L(0); PG8_BAR; PG8_MMA(0, 0, At, B0); PG8_MMA(0, 1, At, B1); PG8_BAR; PG8_SCHED;
            PG8_LDA(At, 0, 1); PG8_STAGE(PG8_SB(0, 0), b2, voffB); PG8_STAGE(PG8_SB(0, 1), b2 + hstepB, voffB); PG8_STAGE(PG8_SA(0, 0), a2, voffA);
            PG8_WAIT_V(8); PG8_WAIT_L(0); PG8_BAR; PG8_MMA(1, 0, At, B0); PG8_MMA(1, 1, At, B1); PG8_BAR; PG8_SCHED;
            PG8_LDB(B0, 1, 0); PG8_LDB(B1, 1, 1); PG8_SCHED; PG8_LDA(At, 1, 0); PG8_STAGE(PG8_SA(0, 1), a2 + hstepA, voffA);
            PG8_WAIT_V(8); PG8_WAIT_L(0); PG8_BAR; PG8_MMA(0, 0, At, B0); PG8_MMA(0, 1, At, B1); PG8_BAR; PG8_SCHED;
            PG8_LDA(At, 1, 1); PG8_STAGE(PG8_SB(1, 0), b3, voffB); PG8_STAGE(PG8_SB(1, 1), b3 + hstepB, voffB); PG8_STAGE(PG8_SA(1, 0), a3, voffA);
            PG8_WAIT_V(8); PG8_WAIT_L(0); PG8_BAR; PG8_MMA(1, 0, At, B0); PG8_MMA(1, 1, At, B1); PG8_BAR; PG8_SCHED;
        }
        if constexpr (ALIGN_EPI) { if (wr == 0) PG8_BAR; }
        E(acc, cur, wr, wc, fr, fq);
        if (!has_next) break;
#pragma unroll
        for (int a = 0; a < 2; ++a)
#pragma unroll
            for (int b = 0; b < 2; ++b)
#pragma unroll
                for (int m = 0; m < 4; ++m)
#pragma unroll
                    for (int n = 0; n < 2; ++n) acc[a][b][m][n] = (f32x4){0.f, 0.f, 0.f, 0.f};
        cur = nxt; cA = nA; cB = nB; ++ui;
        if constexpr (ALIGN_EPI) { if (wr == 1) PG8_BAR; }
    }
    PG8_WAIT_V(0);
    if constexpr (!ALIGN_EPI) { if (wr == 0) PG8_BAR; }
    PG8_BAR;
#undef PG8_SA
#undef PG8_SB
#undef PG8_STAGE
#undef PG8_LDA
#undef PG8_LDB
#undef PG8_MMA
#undef PG8_WAIT_V
#undef PG8_WAIT_L
#undef PG8_BAR
#undef PG8_SCHED
}
}

constexpr int NB = 2, S = 8192, D = 1024, T = NB * S, FF = 4096;
constexpr int ZC = 6912;
constexpr int C_U = 0, C_V = 1024, C_Q = 2048, C_KCMP = 3072, C_VCMP = 3328, C_KSLC = 3584, C_VSLC = 3840, C_KWIN = 4096, C_VWIN = 4352, C_GN = 4608, C_GA = 4656, C_GB = 5680;
constexpr float ALPHA = 1.189207115002721f;
constexpr float QSCALE = 0.125f * 1.4426950408889634f;
constexpr float XSCALE = 0.0625f * 1.4426950408889634f;
constexpr float LN_EPS = 1e-5f;
constexpr size_t MiB = 1u << 20;
constexpr size_t WS_Z = 0, WS_KCMPT = 216 * MiB, WS_VCMPT = 224 * MiB, WS_VSLCT = 232 * MiB, WS_VWINT = 240 * MiB, WS_HDNK = 248 * MiB, WS_HDNV = 250 * MiB,
                 WS_KC = 252 * MiB, WS_VCT = 252 * MiB + 512 * 1024, WS_WOUT_T = 253 * MiB, WS_C1 = 255 * MiB, WS_W2KT = 255 * MiB + 4096, WS_W2VT = 255 * MiB + 65536, WS_WSTRIL = 255 * MiB + 131072, WS_C1P = 255 * MiB + 524288;
constexpr size_t WS_HF = 0, WS_HB = 64 * MiB, WS_XQ = 96 * MiB, WS_XO = 128 * MiB, WS_ACCF = 160 * MiB, WS_FFB = 96 * MiB,
                 WS_WXQ_T = 224 * MiB, WS_WXO_T = 226 * MiB, WS_WFF1_T = 228 * MiB, WS_WFF2_T = 236 * MiB;
constexpr size_t DO_H0B = 0, DO_MIX = 0, DO_WIN_T = 32 * MiB, DO_WXKV_T = 46 * MiB, DO_MEMB = 50 * MiB, DO_XKV = 51 * MiB, DO_XVT = 53 * MiB, DO_ROPE = 54 * MiB, DO_W1KT = 55 * MiB, DO_W1VT = 56 * MiB;
constexpr int LDS_BYTES = 147456;

struct Args { const float* in[32]; float* out; unsigned char* ws; int ph_lo, ph_hi; };

__device__ __forceinline__ void tr_item(const float* W, int K, int N, int Npad, bf16_t* WT, LAS float* scr, int item, int lane) {
    const int nblk = Npad / 32, kb = item / nblk, nb = item % nblk, k0 = 64 * kb, n0 = 32 * nb;
    const int cc = n0 + (lane & 31);
#pragma unroll 8
    for (int i = 0; i < 32; ++i) { const int kk = 2 * i + (lane >> 5); scr[kk * 33 + (lane & 31)] = (cc < N) ? W[(size_t)(k0 + kk) * N + cc] : 0.f; }
    LDS_WAIT();
    const int c = lane & 7;
#pragma unroll
    for (int j = 0; j < 4; ++j) { const int n = (lane >> 3) + 8 * j; const LAS float* s = scr + (8 * c) * 33 + n;
        u32x4 o; o.x = pk2(s[0 * 33], s[1 * 33]); o.y = pk2(s[2 * 33], s[3 * 33]); o.z = pk2(s[4 * 33], s[5 * 33]); o.w = pk2(s[6 * 33], s[7 * 33]);
        *(u32x4*)(WT + (size_t)(n0 + n) * K + k0 + 8 * c) = o; }
    LDS_WAIT();
}

__device__ __forceinline__ void ln_apply(f32x4 (&v)[4], const float* g, const float* b, int lane) {
    float s = 0.f;
#pragma unroll
    for (int j = 0; j < 4; ++j) s += (v[j].x + v[j].y) + (v[j].z + v[j].w);
    const float mean = wave_sum(s) * (1.f / 1024.f); float s2 = 0.f;
#pragma unroll
    for (int j = 0; j < 4; ++j) { v[j] = v[j] - mean; s2 += (v[j].x * v[j].x + v[j].y * v[j].y) + (v[j].z * v[j].z + v[j].w * v[j].w); }
    const float rstd = 1.f / sqrtf(wave_sum(s2) * (1.f / 1024.f) + LN_EPS);
#pragma unroll
    for (int j = 0; j < 4; ++j) { const f32x4 gg = *(const f32x4*)(g + 4 * lane + 256 * j), bb = *(const f32x4*)(b + 4 * lane + 256 * j); v[j] = v[j] * rstd * gg + bb; }
}
__device__ __forceinline__ void row_load(f32x4 (&v)[4], const float* p, int lane) {
#pragma unroll
    for (int j = 0; j < 4; ++j) v[j] = *(const f32x4*)(p + 4 * lane + 256 * j);
}
__device__ __forceinline__ void row_store_f32(const f32x4 (&v)[4], float* p, int lane) {
#pragma unroll
    for (int j = 0; j < 4; ++j) *(f32x4*)(p + 4 * lane + 256 * j) = v[j];
}
__device__ __forceinline__ void row_store_bf16(const f32x4 (&v)[4], bf16_t* p, int lane) {
#pragma unroll
    for (int j = 0; j < 4; ++j) { u32x2 w; w.x = pk2(v[j].x, v[j].y); w.y = pk2(v[j].z, v[j].w); *(u32x2*)(p + 4 * lane + 256 * j) = w; }
}

#define MFMA16(a, b, c) __builtin_amdgcn_mfma_f32_16x16x32_bf16((a), (b), (c), 0, 0, 0)

__device__ __forceinline__ void qk32(const bf16_t* kp, size_t t1off, bf16x8 qf0, bf16x8 qf1, f32x4& s0, f32x4& s1) {
    const bf16x8 k00 = *(const bf16x8*)(kp), k01 = *(const bf16x8*)(kp + 32), k10 = *(const bf16x8*)(kp + t1off), k11 = *(const bf16x8*)(kp + t1off + 32);
    const f32x4 z = {0.f, 0.f, 0.f, 0.f};
    s0 = MFMA16(k00, qf0, z); s0 = MFMA16(k01, qf1, s0); s1 = MFMA16(k10, qf0, z); s1 = MFMA16(k11, qf1, s1);
}
__device__ __forceinline__ void pv32(const bf16_t* vp, size_t dtoff, bf16x8 pb, f32x4 (&o)[4]) {
#pragma unroll
    for (int dt = 0; dt < 4; ++dt) { const u32x2 lo = *(const u32x2*)(vp + dt * dtoff), hi = *(const u32x2*)(vp + dt * dtoff + 16);
        u32x4 w; w.x = lo.x; w.y = lo.y; w.z = hi.x; w.w = hi.y; o[dt] = MFMA16(__builtin_bit_cast(bf16x8, w), pb, o[dt]); }
}
__device__ __forceinline__ unsigned cvtpk(float lo, float hi) { unsigned r; asm volatile("v_cvt_pk_bf16_f32 %0, %1, %2" : "=v"(r) : "v"(lo), "v"(hi)); return r; }
__device__ __forceinline__ bf16x8 pack_p(const float (&p)[8]) { u32x4 w; w.x = cvtpk(p[0], p[1]); w.y = cvtpk(p[2], p[3]); w.z = cvtpk(p[4], p[5]); w.w = cvtpk(p[6], p[7]); return __builtin_bit_cast(bf16x8, w); }
__device__ __forceinline__ float dpp_xor1(float v) { return __builtin_bit_cast(float, __builtin_amdgcn_mov_dpp(__builtin_bit_cast(int, v), 0xB1, 0xF, 0xF, true)); }
__device__ __forceinline__ float dpp_xor2(float v) { return __builtin_bit_cast(float, __builtin_amdgcn_mov_dpp(__builtin_bit_cast(int, v), 0x4E, 0xF, 0xF, true)); }
__device__ __forceinline__ bf16x8 osm_step(f32x4 s0, f32x4 s1, unsigned vm, float& m, float& l, f32x4 (&o)[4]) {
    const float NINF = -__builtin_inff();
#pragma unroll
    for (int e = 0; e < 4; ++e) { s0[e] = ((vm >> e) & 1u) ? s0[e] : NINF; s1[e] = ((vm >> (4 + e)) & 1u) ? s1[e] : NINF; }
    float mx = fmaxf(fmaxf(fmaxf(s0[0], s0[1]), fmaxf(s0[2], s0[3])), fmaxf(fmaxf(s1[0], s1[1]), fmaxf(s1[2], s1[3])));
    if (__ballot(mx > m + 8.f) != 0ull) {
        float r = fmaxf(mx, __shfl_xor(mx, 16)); r = fmaxf(r, __shfl_xor(r, 32));
        const float mn = fmaxf(m, r), alpha = __builtin_amdgcn_exp2f(m - mn); m = mn; l *= alpha;
#pragma unroll
        for (int dt = 0; dt < 4; ++dt) o[dt] = o[dt] * alpha;
    }
    float p[8];
#pragma unroll
    for (int e = 0; e < 4; ++e) { p[e] = __builtin_amdgcn_exp2f(s0[e] - m); p[4 + e] = __builtin_amdgcn_exp2f(s1[e] - m); }
    l += ((p[0] + p[1]) + (p[2] + p[3])) + ((p[4] + p[5]) + (p[6] + p[7]));
    return pack_p(p);
}

__device__ __forceinline__ void osm_step64(f32x4 (&s)[4], unsigned vm, float& m, float& l, f32x4 (&o)[4], bf16x8& pb0, bf16x8& pb1) {
    const float NINF = -__builtin_inff();
#pragma unroll
    for (int qd = 0; qd < 4; ++qd)
#pragma unroll
        for (int e = 0; e < 4; ++e) s[qd][e] = ((vm >> (4 * qd + e)) & 1u) ? s[qd][e] : NINF;
    const float mx = fmaxf(fmaxf(fmaxf(fmaxf(s[0][0], s[0][1]), fmaxf(s[0][2], s[0][3])), fmaxf(fmaxf(s[1][0], s[1][1]), fmaxf(s[1][2], s[1][3]))),
                           fmaxf(fmaxf(fmaxf(s[2][0], s[2][1]), fmaxf(s[2][2], s[2][3])), fmaxf(fmaxf(s[3][0], s[3][1]), fmaxf(s[3][2], s[3][3]))));
    if (__ballot(mx > m + 8.f) != 0ull) {
        float r = fmaxf(mx, __shfl_xor(mx, 16)); r = fmaxf(r, __shfl_xor(r, 32));
        const float mn = fmaxf(m, r), alpha = __builtin_amdgcn_exp2f(m - mn); m = mn; l *= alpha;
#pragma unroll
        for (int dt = 0; dt < 4; ++dt) o[dt] = o[dt] * alpha;
    }
    float p[8], q[8];
#pragma unroll
    for (int e = 0; e < 4; ++e) { p[e] = __builtin_amdgcn_exp2f(s[0][e] - m); p[4 + e] = __builtin_amdgcn_exp2f(s[1][e] - m); q[e] = __builtin_amdgcn_exp2f(s[2][e] - m); q[4 + e] = __builtin_amdgcn_exp2f(s[3][e] - m); }
    l += (((p[0] + p[1]) + (p[2] + p[3])) + ((p[4] + p[5]) + (p[6] + p[7]))) + (((q[0] + q[1]) + (q[2] + q[3])) + ((q[4] + q[5]) + (q[6] + q[7])));
    pb0 = pack_p(p); pb1 = pack_p(q);
}

__global__ void __launch_bounds__(512, 2) mk_fwd(Args a) {
    extern __shared__ __attribute__((aligned(16))) unsigned char lds_raw[];
    LAS unsigned char* lds = (LAS unsigned char*)lds_raw;
    cg::grid_group grid = cg::this_grid();
    const int tid = threadIdx.x, lane = tid & 63, wid = __builtin_amdgcn_readfirstlane(tid >> 6);
    const int G = gridDim.x, gw = blockIdx.x * 8 + wid, NGW = G * 8, gtid = blockIdx.x * 512 + tid, NGT = G * 512;
    unsigned char* ws = a.ws; unsigned char* dout = (unsigned char*)a.out;
    const int lo = a.ph_lo, hi = a.ph_hi;
#define IN(k) (lo <= (k) && (k) < hi)
#define SYNC(k) do { if (IN(k) && IN((k) + 1)) grid.sync(); } while (0)
#ifndef PROBE_PH
#define PROBE_PH -1
#endif
#ifndef PROBE_N
#define PROBE_N 2
#endif
#ifndef PROBE_MASK
#define PROBE_MASK 0
#endif
#define PRB(k) ((k) == PROBE_PH || ((PROBE_MASK >> (k)) & 1))
#define RPT(k) for (int rp_ = 0; rp_ < (PRB(k) ? PROBE_N : 1); ++rp_, (PRB(k) && rp_ < PROBE_N) ? grid.sync() : (void)0)
    bf16_t* const Z = (bf16_t*)(ws + WS_Z);
    float* const ROPE = (float*)(dout + DO_ROPE);

    if (IN(0)) RPT(0) {
        LAS float* scr = (LAS float*)(lds + wid * 8448);
        constexpr int I_WIN = 16 * 216, I_XKV = 16 * 64, I_W1 = 32 * 8, I_W2 = 4 * 2, I_WOUT = 16 * 32;
        constexpr int NIT = I_WIN + I_XKV + 2 * I_W1 + 2 * I_W2 + I_WOUT;
        for (int it = gw; it < NIT; it += NGW) { int r = it;
            if (r < I_WIN) { tr_item(a.in[5], 1024, 6704, 6912, (bf16_t*)(dout + DO_WIN_T), scr, r, lane); continue; } r -= I_WIN;
            if (r < I_XKV) { tr_item(a.in[24], 1024, 2048, 2048, (bf16_t*)(dout + DO_WXKV_T), scr, r, lane); continue; } r -= I_XKV;
            if (r < I_W1) { tr_item(a.in[11], 2048, 256, 256, (bf16_t*)(dout + DO_W1KT), scr, r, lane); continue; } r -= I_W1;
            if (r < I_W1) { tr_item(a.in[16], 2048, 256, 256, (bf16_t*)(dout + DO_W1VT), scr, r, lane); continue; } r -= I_W1;
            if (r < I_W2) { tr_item(a.in[13], 256, 64, 64, (bf16_t*)(ws + WS_W2KT), scr, r, lane); continue; } r -= I_W2;
            if (r < I_W2) { tr_item(a.in[18], 256, 64, 64, (bf16_t*)(ws + WS_W2VT), scr, r, lane); continue; } r -= I_W2;
            tr_item(a.in[20], 1024, 1024, 1024, (bf16_t*)(ws + WS_WOUT_T), scr, r, lane);
        }
        for (int m = gw; m < T; m += NGW) { f32x4 v[4]; row_load(v, a.in[0] + (size_t)m * D, lane); ln_apply(v, a.in[3], a.in[4], lane); row_store_bf16(v, (bf16_t*)(dout + DO_H0B) + (size_t)m * D, lane); }
        for (int i = gtid; i < 512 * 1024 / 4; i += NGT) { const f32x4 v = *(const f32x4*)(a.in[1] + 4 * (size_t)i); u32x2 w; w.x = pk2(v.x, v.y); w.y = pk2(v.z, v.w); *(u32x2*)((bf16_t*)(dout + DO_MEMB) + 4 * (size_t)i) = w; }
        for (int i = gtid; i < T * 8; i += NGT) { const int tok = i >> 3, fi = i & 7; const int pos = ((const int*)a.in[2])[tok];
            float inv = 1.0f;
            inv = fi == 1 ? 0.19392274474868576f : inv; inv = fi == 2 ? 0.03760603093086393f : inv; inv = fi == 3 ? 0.007292664737217109f : inv; inv = fi == 4 ? 0.001414213562373095f : inv;
            inv = fi == 5 ? 0.0002742481756762073f : inv; inv = fi == 6 ? 5.318295896944988e-05f : inv; inv = fi == 7 ? 1.031338537721246e-05f : inv;
            const float ang = (float)pos * inv; ROPE[tok * 16 + fi] = cosf(ang); ROPE[tok * 16 + 8 + fi] = sinf(ang); }
        for (int i = gtid; i < 8 * 128 * 128; i += NGT) { const int t = (i >> 7) & 127, s = i & 127; const float w = a.in[8][i]; ((bf16_t*)(ws + WS_WSTRIL))[i] = (bf16_t)(s <= t ? f2bf(w) : 0u); }
        for (int job = blockIdx.x; job < 64; job += G) if (tid < 256) { const int mat = job >> 5, ks = job & 31; const float* pe = a.in[mat ? 15 : 10] + ks * 64; const float* w1 = a.in[mat ? 16 : 11] + (size_t)ks * 64 * 256 + tid; float sum = 0.f;
#pragma unroll 16
            for (int k = 0; k < 64; ++k) sum += pe[k] * w1[(size_t)k * 256];
            ((float*)(ws + WS_C1P))[job * 256 + tid] = sum; }
    }
    SYNC(0);

    if (IN(1)) RPT(1) {
        { pg8::Gemm g{(const bf16_t*)(dout + DO_H0B), (const bf16_t*)(dout + DO_WIN_T), T, ZC, D, D}; pg8::StaticOrder So; So.init(T, ZC, G, (int)blockIdx.x);
          pg8::EpiBf16<0> E{Z, ZC, nullptr, 1.f}; pg8::gemm_phase<pg8::EpiBf16<0>, pg8::StaticOrder, true>(lds, g, So, E); }
        { pg8::Gemm g{(const bf16_t*)(dout + DO_MEMB), (const bf16_t*)(dout + DO_WXKV_T), 512, 2048, D, D}; pg8::StaticOrder So; So.init(512, 2048, G, (G - 1) - (int)blockIdx.x);
          pg8::EpiBf16<0> E{(bf16_t*)(dout + DO_XKV), 2048, nullptr, 1.f}; pg8::gemm_phase<pg8::EpiBf16<0>, pg8::StaticOrder, true>(lds, g, So, E); }
    }
    SYNC(1);

    if (IN(2)) RPT(2) {
        bf16_t* const KCMPT = (bf16_t*)(ws + WS_KCMPT); bf16_t* const VCMPT = (bf16_t*)(ws + WS_VCMPT);
        for (int tok = gw; tok < T; tok += NGW) {
            bf16_t* zr = Z + (size_t)tok * ZC; const int b = tok >> 13, t = tok & 8191;
            float rc[8], rs[8];
            { const f32x4 c0 = *(const f32x4*)(ROPE + tok * 16), c1 = *(const f32x4*)(ROPE + tok * 16 + 4), s0 = *(const f32x4*)(ROPE + tok * 16 + 8), s1 = *(const f32x4*)(ROPE + tok * 16 + 12);
#pragma unroll
              for (int e = 0; e < 4; ++e) { rc[e] = c0[e]; rc[4 + e] = c1[e]; rs[e] = s0[e]; rs[4 + e] = s1[e]; } }
            { const u32x4 w0 = *(const u32x4*)(zr + C_V + 16 * lane), w1 = *(const u32x4*)(zr + C_V + 16 * lane + 8); float f[16];
#pragma unroll
              for (int e = 0; e < 4; ++e) { f[2 * e] = bflo(w0[e]); f[2 * e + 1] = bfhi(w0[e]); f[8 + 2 * e] = bflo(w1[e]); f[8 + 2 * e + 1] = bfhi(w1[e]); }
              float s = 0.f;
#pragma unroll
              for (int e = 0; e < 16; ++e) { f[e] = gelu_t(f[e]); s += f[e]; }
              const float mean = wave_sum(s) * (1.f / 1024.f); float s2 = 0.f;
#pragma unroll
              for (int e = 0; e < 16; ++e) { f[e] -= mean; s2 += f[e] * f[e]; }
              const float rstd = 1.f / sqrtf(wave_sum(s2) * (1.f / 1024.f) + LN_EPS);
              const float* gg = a.in[6] + 16 * lane; const float* bb = a.in[7] + 16 * lane; u32x4 o0, o1;
#pragma unroll
              for (int e = 0; e < 4; ++e) { o0[e] = pk2(f[2 * e] * rstd * gg[2 * e] + bb[2 * e], f[2 * e + 1] * rstd * gg[2 * e + 1] + bb[2 * e + 1]);
                                            o1[e] = pk2(f[8 + 2 * e] * rstd * gg[8 + 2 * e] + bb[8 + 2 * e], f[9 + 2 * e] * rstd * gg[9 + 2 * e] + bb[9 + 2 * e]); }
              *(u32x4*)(zr + C_V + 16 * lane) = o0; *(u32x4*)(zr + C_V + 16 * lane + 8) = o1; }
            { const u32x4 w0 = *(const u32x4*)(zr + C_Q + 16 * lane), w1 = *(const u32x4*)(zr + C_Q + 16 * lane + 8); float f[16];
#pragma unroll
              for (int e = 0; e < 4; ++e) { f[2 * e] = bflo(w0[e]); f[2 * e + 1] = bfhi(w0[e]); f[8 + 2 * e] = bflo(w1[e]); f[8 + 2 * e + 1] = bfhi(w1[e]); }
              if ((lane & 3) == 0) {
#pragma unroll
                  for (int i = 0; i < 8; ++i) { const float x1 = f[i], x2 = f[8 + i]; f[i] = x1 * rc[i] - x2 * rs[i]; f[8 + i] = x2 * rc[i] + x1 * rs[i]; } }
              u32x4 o0, o1;
#pragma unroll
              for (int e = 0; e < 4; ++e) { o0[e] = pk2(f[2 * e] * QSCALE, f[2 * e + 1] * QSCALE); o1[e] = pk2(f[8 + 2 * e] * QSCALE, f[9 + 2 * e] * QSCALE); }
              *(u32x4*)(zr + C_Q + 16 * lane) = o0; *(u32x4*)(zr + C_Q + 16 * lane + 8) = o1; }
            { const int h = lane >> 4, r = lane & 15; const size_t bh = (size_t)(b * 4 + h);
              const f32x4 rcl = *(const f32x4*)(ROPE + tok * 16 + 4 * (r & 1)), rsl = *(const f32x4*)(ROPE + tok * 16 + 8 + 4 * (r & 1));
#pragma unroll
              for (int sg = 0; sg < 6; ++sg) {
                  const u32x2 w = *(const u32x2*)(zr + C_KCMP + sg * 256 + 4 * lane);
                  if (sg == 0) *(u32x2*)(KCMPT + (bh * 8192 + t) * 64 + 4 * r) = w;
                  else if (sg == 1) *(u32x2*)(VCMPT + (bh * 8192 + t) * 64 + 4 * r) = w;
                  else if (sg == 2 || sg == 4) {
                      float x[4] = {bflo(w.x), bfhi(w.x), bflo(w.y), bfhi(w.y)}; float y[4];
#pragma unroll
                      for (int e = 0; e < 4; ++e) { const float other = __shfl_xor(x[e], 2); const float c = rcl[e], sn = rsl[e];
                          y[e] = (r < 2) ? (x[e] * c - other * sn) : ((r < 4) ? (x[e] * c + other * sn) : x[e]); }
                      u32x2 o; o.x = pk2(y[0], y[1]); o.y = pk2(y[2], y[3]); *(u32x2*)(zr + C_KCMP + sg * 256 + 4 * lane) = o;
                  }
              } }
        }
        if (gtid < 512) { const int mat = gtid >> 8, col = gtid & 255; float sum = a.in[mat ? 17 : 12][col];
            for (int ks = 0; ks < 32; ++ks) sum += ((const float*)(ws + WS_C1P))[(mat * 32 + ks) * 256 + col];
            ((float*)(ws + WS_C1))[gtid] = sum; }
        for (int i = gtid; i < 512 * 128; i += NGT) { const int mrow = i >> 7, cgp = i & 127; const u32x4 w = *(const u32x4*)((const bf16_t*)(dout + DO_XKV) + (size_t)mrow * 2048 + 1024 + 8 * cgp);
            bf16_t* p = (bf16_t*)(dout + DO_XVT) + ((size_t)((mrow >> 8) * 1024 + 8 * cgp)) * 256 + (mrow & 255);
#pragma unroll
            for (int e = 0; e < 4; ++e) { p[(2 * e) * 256] = (bf16_t)(w[e] & 0xffffu); p[(2 * e + 1) * 256] = (bf16_t)(w[e] >> 16); } }
    }
    SYNC(2);

    if (IN(3)) RPT(3) {
        const bf16_t* WSTRIL = (const bf16_t*)(ws + WS_WSTRIL);
        for (int un = blockIdx.x; un < 1024; un += G) {
            const int chunk = un >> 3, g = un & 7; const size_t tokbase = (size_t)chunk * 128;
            LAS bf16_t* vT = (LAS bf16_t*)lds;
#pragma unroll
            for (int i = 0; i < 4; ++i) { const int p = tid + 512 * i, s = p >> 4, c0 = (p & 15) * 8; const u32x4 w = *(const u32x4*)(Z + (tokbase + s) * ZC + C_V + g * 128 + c0);
#pragma unroll
                for (int e = 0; e < 4; ++e) { vT[(c0 + 2 * e) * 136 + s] = (bf16_t)(w[e] & 0xffffu); vT[(c0 + 2 * e + 1) * 136 + s] = (bf16_t)(w[e] >> 16); } }
            __syncthreads();
            const int j = lane & 15, q4 = lane >> 4, t = 16 * wid + j;
            f32x4 acc[8];
#pragma unroll
            for (int it = 0; it < 8; ++it) acc[it] = (f32x4){0.f, 0.f, 0.f, 0.f};
            const int nks = (16 * wid + 15) / 32 + 1;
            for (int ks = 0; ks < nks; ++ks) { const bf16x8 wf = *(const bf16x8*)(WSTRIL + (size_t)g * 16384 + t * 128 + 32 * ks + 8 * q4);
#pragma unroll
                for (int it = 0; it < 8; ++it) { const bf16x8 vf = *(const LAS bf16x8*)(vT + (16 * it + j) * 136 + 32 * ks + 8 * q4); acc[it] = MFMA16(vf, wf, acc[it]); } }
            const float bsv = a.in[9][g * 128 + t]; bf16_t* zr = Z + (tokbase + t) * ZC;
#pragma unroll
            for (int it = 0; it < 8; ++it) { const int c = g * 128 + 16 * it + 4 * q4; const u32x2 uw = *(const u32x2*)(zr + C_U + c), gaw = *(const u32x2*)(zr + C_GA + c);
                const float u0 = bflo(uw.x), u1 = bfhi(uw.x), u2 = bflo(uw.y), u3 = bfhi(uw.y), g0 = bflo(gaw.x), g1 = bfhi(gaw.x), g2 = bflo(gaw.y), g3 = bfhi(gaw.y);
                u32x2 o; o.x = pk2(gelu_t(u0) * (acc[it][0] + bsv) * sigm(g0), gelu_t(u1) * (acc[it][1] + bsv) * sigm(g1)); o.y = pk2(gelu_t(u2) * (acc[it][2] + bsv) * sigm(g2), gelu_t(u3) * (acc[it][3] + bsv) * sigm(g3));
                *(u32x2*)(zr + C_U + c) = o; }
            __syncthreads();
        }
        { pg8::Gemm g{(const bf16_t*)(ws + WS_KCMPT), (const bf16_t*)(dout + DO_W1KT), 4096, 256, 2048, 1024}; pg8::StaticOrder So; So.init(4096, 256, G, (int)blockIdx.x);
          pg8::EpiBf16<2> E{(bf16_t*)(ws + WS_HDNK), 256, (const float*)(ws + WS_C1), 1.f}; pg8::gemm_phase<pg8::EpiBf16<2>, pg8::StaticOrder, true>(lds, g, So, E); }
        { pg8::Gemm g{(const bf16_t*)(ws + WS_VCMPT), (const bf16_t*)(dout + DO_W1VT), 4096, 256, 2048, 1024}; pg8::StaticOrder So; So.init(4096, 256, G, (G - 1) - (int)blockIdx.x);
          pg8::EpiBf16<2> E{(bf16_t*)(ws + WS_HDNV), 256, (const float*)(ws + WS_C1) + 256, 1.f}; pg8::gemm_phase<pg8::EpiBf16<2>, pg8::StaticOrder, true>(lds, g, So, E); }
    }
    SYNC(3);

    if (IN(4)) RPT(4) {
        for (int u = gw; u < 512; u += NGW) {
            const int mat = u >> 8, r0 = (u & 255) * 16, j = lane & 15, q4 = lane >> 4;
            const bf16_t* HDN = (const bf16_t*)(ws + (mat ? WS_HDNV : WS_HDNK)); const bf16_t* W2T = (const bf16_t*)(ws + (mat ? WS_W2VT : WS_W2KT)); const float* b2 = a.in[mat ? 19 : 14];
            f32x4 acc[4];
#pragma unroll
            for (int it = 0; it < 4; ++it) acc[it] = (f32x4){0.f, 0.f, 0.f, 0.f};
#pragma unroll
            for (int ks = 0; ks < 8; ++ks) { const bf16x8 hb = *(const bf16x8*)(HDN + (size_t)(r0 + j) * 256 + 32 * ks + 8 * q4);
#pragma unroll
                for (int it = 0; it < 4; ++it) { const bf16x8 wf = *(const bf16x8*)(W2T + (16 * it + j) * 256 + 32 * ks + 8 * q4); acc[it] = MFMA16(wf, hb, acc[it]); } }
            const int r = r0 + j, bh = r >> 9, n = r & 511, b = bh >> 2;
#pragma unroll
            for (int it = 0; it < 4; ++it) { const f32x4 bv = *(const f32x4*)(b2 + 16 * it + 4 * q4); acc[it] = acc[it] + bv; }
            if (mat == 0) {
                const int pt = 16 * n + 31; const float* rt = ROPE + (size_t)(b * 8192 + (pt < 8192 ? pt : 8191)) * 16;
#pragma unroll
                for (int e = 0; e < 4; ++e) { const float x = acc[0][e], other = __shfl_xor(x, 32); const int fi = 4 * (q4 & 1) + e; const float c = rt[fi], sn = rt[8 + fi];
                    acc[0][e] = (q4 < 2) ? (x * c - other * sn) : (x * c + other * sn); }
#pragma unroll
                for (int it = 0; it < 4; ++it) { u32x2 o; o.x = pk2(acc[it][0], acc[it][1]); o.y = pk2(acc[it][2], acc[it][3]); if (n == 511) { o.x = 0u; o.y = 0u; }
                    *(u32x2*)((bf16_t*)(ws + WS_KC) + (size_t)r * 64 + 16 * it + 4 * q4) = o; }
            } else {
#pragma unroll
                for (int it = 0; it < 4; ++it) { u32x2 o; o.x = pk2(acc[it][0], acc[it][1]); o.y = pk2(acc[it][2], acc[it][3]); if (n == 511) { o.x = 0u; o.y = 0u; }
                    *(u32x2*)((bf16_t*)(ws + WS_VCT) + (size_t)r * 64 + 16 * it + 4 * q4) = o; }
            }
        }
    }
    SYNC(4);

    if (IN(5)) RPT(5) {
        const bf16_t* KC = (const bf16_t*)(ws + WS_KC); const bf16_t* VC = (const bf16_t*)(ws + WS_VCT);
        bf16_t* MIX = (bf16_t*)(dout + DO_MIX);
        LAS float* wl = (LAS float*)(lds + 65536 + wid * 4352);
        LAS unsigned* wgum = (LAS unsigned*)(lds + 65536 + 8 * 4352);
        LAS unsigned char* blist = (LAS unsigned char*)(wgum + 8);
        const int j = lane & 15, q4 = lane >> 4, tk = j >> 2, hd = j & 3;
        const int drow = 8 * wid + (lane >> 3), dch = (lane & 7) ^ (lane >> 3);
        const unsigned ldsb = (unsigned)(uintptr_t)lds;
        const unsigned kadr0 = (unsigned)(j * 128 + ((q4 ^ (j & 7)) << 4)), kadr1 = (unsigned)(j * 128 + (((4 + q4) ^ (j & 7)) << 4));
        const int vrow = 4 * q4 + (j >> 2);
        unsigned vadr[4];
#pragma unroll
        for (int dt = 0; dt < 4; ++dt) vadr[dt] = ldsb + 8192u + (unsigned)(vrow * 128 + (((2 * dt + ((lane & 3) >> 1)) ^ (vrow & 7)) << 4) + 8 * (lane & 1));
#define DMA16(g, l) __builtin_amdgcn_global_load_lds((const unsigned*)(g), (LAS unsigned*)(l), 16, 0, 0)
#define ISSUE(nn, KROW0, VROW0, PITCH) do { const int sl_ = (nn) & 3; DMA16((KROW0) + (size_t)drow * (PITCH) + dch * 8, lds + sl_ * 16384 + wid * 1024); \
            DMA16((VROW0) + (size_t)drow * (PITCH) + dch * 8, lds + sl_ * 16384 + 8192 + wid * 1024); } while (0)
#define WAITV(n) asm volatile("s_waitcnt vmcnt(" #n ")" ::: "memory")
#define PIPE_WAIT(n, nb) do { const int rem_ = (nb) - 1 - (n); if (rem_ >= 2) WAITV(4); else if (rem_ == 1) WAITV(2); else WAITV(0); __builtin_amdgcn_s_barrier(); asm volatile("" ::: "memory"); } while (0)
#define QK_LDS(slot, hf, s0, s1) do { const LAS unsigned char* p_ = lds + (slot) * 16384 + (hf) * 4096; const f32x4 z_ = {0.f, 0.f, 0.f, 0.f}; \
            const bf16x8 k00_ = *(const LAS bf16x8*)(p_ + kadr0), k01_ = *(const LAS bf16x8*)(p_ + kadr1), k10_ = *(const LAS bf16x8*)(p_ + 2048 + kadr0), k11_ = *(const LAS bf16x8*)(p_ + 2048 + kadr1); \
            s0 = MFMA16(k00_, qf0, z_); s0 = MFMA16(k01_, qf1, s0); s1 = MFMA16(k10_, qf0, z_); s1 = MFMA16(k11_, qf1, s1); } while (0)
#define PV_LDS(slot, hf, pb, o) do { const unsigned b_ = (unsigned)((slot) * 16384 + (hf) * 4096); const unsigned a0_ = vadr[0] + b_, a1_ = vadr[1] + b_, a2_ = vadr[2] + b_, a3_ = vadr[3] + b_; \
            u32x2 l0_, h0_, l1_, h1_, l2_, h2_, l3_, h3_; \
            asm volatile("ds_read_b64_tr_b16 %0, %8\n\tds_read_b64_tr_b16 %1, %8 offset:2048\n\tds_read_b64_tr_b16 %2, %9\n\tds_read_b64_tr_b16 %3, %9 offset:2048\n\t" \
                         "ds_read_b64_tr_b16 %4, %10\n\tds_read_b64_tr_b16 %5, %10 offset:2048\n\tds_read_b64_tr_b16 %6, %11\n\tds_read_b64_tr_b16 %7, %11 offset:2048\n\ts_waitcnt lgkmcnt(0)" \
                         : "=&v"(l0_), "=&v"(h0_), "=&v"(l1_), "=&v"(h1_), "=&v"(l2_), "=&v"(h2_), "=&v"(l3_), "=&v"(h3_) : "v"(a0_), "v"(a1_), "v"(a2_), "v"(a3_) : "memory"); \
            { u32x4 w_; w_.x = l0_.x; w_.y = l0_.y; w_.z = h0_.x; w_.w = h0_.y; o[0] = MFMA16(__builtin_bit_cast(bf16x8, w_), pb, o[0]); } \
            { u32x4 w_; w_.x = l1_.x; w_.y = l1_.y; w_.z = h1_.x; w_.w = h1_.y; o[1] = MFMA16(__builtin_bit_cast(bf16x8, w_), pb, o[1]); } \
            { u32x4 w_; w_.x = l2_.x; w_.y = l2_.y; w_.z = h2_.x; w_.w = h2_.y; o[2] = MFMA16(__builtin_bit_cast(bf16x8, w_), pb, o[2]); } \
            { u32x4 w_; w_.x = l3_.x; w_.y = l3_.y; w_.z = h3_.x; w_.w = h3_.y; o[3] = MFMA16(__builtin_bit_cast(bf16x8, w_), pb, o[3]); } } while (0)
#define MK8(lo, hi) __builtin_bit_cast(bf16x8, (u32x4){(lo).x, (lo).y, (hi).x, (hi).y})
#define BLOCK64(slot, vm, m, l, o) do { const LAS unsigned char* p_ = lds + (slot) * 16384; const f32x4 z_ = {0.f, 0.f, 0.f, 0.f}; f32x4 s_[4]; \
            { const bf16x8 ka_ = *(const LAS bf16x8*)(p_ + kadr0), kb_ = *(const LAS bf16x8*)(p_ + kadr1), kc_ = *(const LAS bf16x8*)(p_ + 2048 + kadr0), kd_ = *(const LAS bf16x8*)(p_ + 2048 + kadr1); \
              const bf16x8 ke_ = *(const LAS bf16x8*)(p_ + 4096 + kadr0), kf_ = *(const LAS bf16x8*)(p_ + 4096 + kadr1), kg_ = *(const LAS bf16x8*)(p_ + 6144 + kadr0), kh_ = *(const LAS bf16x8*)(p_ + 6144 + kadr1); \
              s_[0] = MFMA16(ka_, qf0, z_); s_[1] = MFMA16(kc_, qf0, z_); s_[2] = MFMA16(ke_, qf0, z_); s_[3] = MFMA16(kg_, qf0, z_); \
              s_[0] = MFMA16(kb_, qf1, s_[0]); s_[1] = MFMA16(kd_, qf1, s_[1]); s_[2] = MFMA16(kf_, qf1, s_[2]); s_[3] = MFMA16(kh_, qf1, s_[3]); } \
            const unsigned b_ = (unsigned)((slot) * 16384); const unsigned a0_ = vadr[0] + b_, a1_ = vadr[1] + b_, a2_ = vadr[2] + b_, a3_ = vadr[3] + b_; \
            u32x2 v0_, v1_, v2_, v3_, v4_, v5_, v6_, v7_, v8_, v9_, v10_, v11_, v12_, v13_, v14_, v15_; \
            asm volatile("ds_read_b64_tr_b16 %0, %16\n\tds_read_b64_tr_b16 %1, %16 offset:2048\n\tds_read_b64_tr_b16 %2, %17\n\tds_read_b64_tr_b16 %3, %17 offset:2048\n\t" \
                         "ds_read_b64_tr_b16 %4, %18\n\tds_read_b64_tr_b16 %5, %18 offset:2048\n\tds_read_b64_tr_b16 %6, %19\n\tds_read_b64_tr_b16 %7, %19 offset:2048\n\t" \
                         "ds_read_b64_tr_b16 %8, %16 offset:4096\n\tds_read_b64_tr_b16 %9, %16 offset:6144\n\tds_read_b64_tr_b16 %10, %17 offset:4096\n\tds_read_b64_tr_b16 %11, %17 offset:6144\n\t" \
                         "ds_read_b64_tr_b16 %12, %18 offset:4096\n\tds_read_b64_tr_b16 %13, %18 offset:6144\n\tds_read_b64_tr_b16 %14, %19 offset:4096\n\tds_read_b64_tr_b16 %15, %19 offset:6144\n\ts_waitcnt lgkmcnt(0)" \
                         : "=&v"(v0_), "=&v"(v1_), "=&v"(v2_), "=&v"(v3_), "=&v"(v4_), "=&v"(v5_), "=&v"(v6_), "=&v"(v7_), "=&v"(v8_), "=&v"(v9_), "=&v"(v10_), "=&v"(v11_), "=&v"(v12_), "=&v"(v13_), "=&v"(v14_), "=&v"(v15_) \
                         : "v"(a0_), "v"(a1_), "v"(a2_), "v"(a3_) : "memory"); \
            bf16x8 pb0_, pb1_; osm_step64(s_, vm, m, l, o, pb0_, pb1_); \
            o[0] = MFMA16(MK8(v0_, v1_), pb0_, o[0]); o[1] = MFMA16(MK8(v2_, v3_), pb0_, o[1]); o[2] = MFMA16(MK8(v4_, v5_), pb0_, o[2]); o[3] = MFMA16(MK8(v6_, v7_), pb0_, o[3]); \
            o[0] = MFMA16(MK8(v8_, v9_), pb1_, o[0]); o[1] = MFMA16(MK8(v10_, v11_), pb1_, o[1]); o[2] = MFMA16(MK8(v12_, v13_), pb1_, o[2]); o[3] = MFMA16(MK8(v14_, v15_), pb1_, o[3]); } while (0)
        for (int uu = blockIdx.x; uu < 2048; uu += G) {
            const int bhu = uu >> 8; int tb = uu & 255; if (bhu & 1) tb = 255 - tb;
            const int b = bhu >> 2, kvh = bhu & 3, t0w = 32 * tb, t0 = t0w + 4 * wid, t = t0 + tk; const size_t tok = (size_t)b * S + t, bh = (size_t)bhu;
            const bf16_t* zr = Z + tok * ZC; const int head = kvh * 4 + hd;
            const bf16x8 qf0 = *(const bf16x8*)(zr + C_Q + head * 64 + 8 * q4), qf1 = *(const bf16x8*)(zr + C_Q + head * 64 + 32 + 8 * q4);
            for (int i = lane; i < 1040; i += 64) wl[i] = 0.f;
            if (tid < 8) wgum[tid] = 0u;
            const float gcm = sigm(bf1(zr[C_GN + head * 3 + 0])), gsl = sigm(bf1(zr[C_GN + head * 3 + 1])), gwn = sigm(bf1(zr[C_GN + head * 3 + 2]));
            f32x4 yb[4];
#pragma unroll
            for (int dt = 0; dt < 4; ++dt) yb[dt] = (f32x4){0.f, 0.f, 0.f, 0.f};
            __syncthreads();
            const int ncw = (t0w + 31 >= 31) ? (((t0w + 31 - 31) >> 4) + 1) : 0;
            const int ncmax = (t0 + 3 >= 31) ? (((t0 + 3 - 31) >> 4) + 1) : 0;
            const int nvalid = (t >= 31) ? (((t - 31) >> 4) + 1) : 0;
            const int nb_c = (ncw + 63) >> 6;
            {
                float m = -1e30f, l = 0.f;
                const bf16_t* kcb = KC + bh * 512 * 64; const bf16_t* vcb = VC + bh * 512 * 64;
                WAITV(0);
                for (int pre = 0; pre < 3 && pre < nb_c; ++pre) ISSUE(pre, kcb + (size_t)pre * 4096, vcb + (size_t)pre * 4096, 64);
                for (int n = 0; n < nb_c; ++n) { const int slot = n & 3; PIPE_WAIT(n, nb_c); if (n + 3 < nb_c) ISSUE(n + 3, kcb + (size_t)(n + 3) * 4096, vcb + (size_t)(n + 3) * 4096, 64);
#pragma unroll
                    for (int hf = 0; hf < 2; ++hf) { const int kb = 64 * n + 32 * hf; if (kb < ncmax) { f32x4 s0, s1; QK_LDS(slot, hf, s0, s1);
                        float mx = -1e30f;
#pragma unroll
                        for (int e = 0; e < 4; ++e) { if (kb + 4 * q4 + e < nvalid) mx = fmaxf(mx, s0[e]); if (kb + 16 + 4 * q4 + e < nvalid) mx = fmaxf(mx, s1[e]); }
                        mx = fmaxf(mx, __shfl_xor(mx, 16)); mx = fmaxf(mx, __shfl_xor(mx, 32));
                        const float mn = fmaxf(m, mx); float ps = 0.f;
#pragma unroll
                        for (int e = 0; e < 4; ++e) { if (kb + 4 * q4 + e < nvalid) ps += __builtin_amdgcn_exp2f(s0[e] - mn); if (kb + 16 + 4 * q4 + e < nvalid) ps += __builtin_amdgcn_exp2f(s1[e] - mn); }
                        l = l * __builtin_amdgcn_exp2f(m - mn) + ps; m = mn; } } }
                l += __shfl_xor(l, 16); l += __shfl_xor(l, 32);
                const float invl = l > 0.f ? 1.f / l : 0.f;
                f32x4 o[4];
#pragma unroll
                for (int dt = 0; dt < 4; ++dt) o[dt] = (f32x4){0.f, 0.f, 0.f, 0.f};
                WAITV(0); __builtin_amdgcn_s_barrier();
                for (int pre = 0; pre < 3 && pre < nb_c; ++pre) ISSUE(pre, kcb + (size_t)pre * 4096, vcb + (size_t)pre * 4096, 64);
                for (int n = 0; n < nb_c; ++n) { const int slot = n & 3; PIPE_WAIT(n, nb_c); if (n + 3 < nb_c) ISSUE(n + 3, kcb + (size_t)(n + 3) * 4096, vcb + (size_t)(n + 3) * 4096, 64);
#pragma unroll
                    for (int hf = 0; hf < 2; ++hf) { const int kb = 64 * n + 32 * hf; if (kb < ncmax) { f32x4 s0, s1; QK_LDS(slot, hf, s0, s1);
                        float p[8];
#pragma unroll
                        for (int e = 0; e < 4; ++e) { p[e] = (kb + 4 * q4 + e < nvalid) ? __builtin_amdgcn_exp2f(s0[e] - m) * invl : 0.f; p[4 + e] = (kb + 16 + 4 * q4 + e < nvalid) ? __builtin_amdgcn_exp2f(s1[e] - m) * invl : 0.f; }
                        float a0 = (p[0] + p[1]) + (p[2] + p[3]), a1 = (p[4] + p[5]) + (p[6] + p[7]), x0 = p[3], x1 = p[7];
                        a0 += dpp_xor1(a0); a0 += dpp_xor2(a0); a1 += dpp_xor1(a1); a1 += dpp_xor2(a1);
                        x0 += dpp_xor1(x0); x0 += dpp_xor2(x0); x1 += dpp_xor1(x1); x1 += dpp_xor2(x1);
                        if (hd == 0) { const int jj0 = (kb >> 2) + q4, jj1 = jj0 + 4; wl[tk * 128 + jj0] = a0; wl[tk * 128 + jj1] = a1; wl[512 + tk * 132 + jj0 + 1] = x0; wl[512 + tk * 132 + jj1 + 1] = x1; }
                        const bf16x8 pb = pack_p(p); PV_LDS(slot, hf, pb, o); } } }
#pragma unroll
                for (int dt = 0; dt < 4; ++dt) yb[dt] = yb[dt] + o[dt] * gcm;
            }
            LDS_WAIT();
            unsigned mysel[4], um[4];
            {
                const int tk2 = lane >> 4, r = lane & 15, cur = t0 >> 6;
                float val[8];
#pragma unroll
                for (int mm = 0; mm < 8; ++mm) { const int jj = r + 16 * mm; const float pvv = wl[tk2 * 128 + jj] + wl[512 + tk2 * 132 + jj];
                    const bool forced = (jj == 0) | (jj == cur) | (jj == cur - 1);
                    val[mm] = forced ? __builtin_inff() : (jj <= cur ? pvv : -__builtin_inff()); }
                LDS_WAIT();
#pragma unroll
                for (int mm = 0; mm < 8; ++mm) wl[tk2 * 128 + r + 16 * mm] = val[mm];
                LDS_WAIT();
                int rank[8];
#pragma unroll
                for (int mm = 0; mm < 8; ++mm) rank[mm] = 0;
                for (int jp = 0; jp <= cur; ++jp) { const float vp = wl[tk2 * 128 + jp];
#pragma unroll
                    for (int mm = 0; mm < 8; ++mm) rank[mm] += ((vp > val[mm]) || (vp == val[mm] && jp < r + 16 * mm)) ? 1 : 0; }
                unsigned long long bm[8];
#pragma unroll
                for (int mm = 0; mm < 8; ++mm) bm[mm] = __ballot((r + 16 * mm <= cur) && rank[mm] < 16);
#pragma unroll
                for (int w = 0; w < 4; ++w) { const unsigned long long b0 = bm[2 * w], b1 = bm[2 * w + 1];
                    mysel[w] = (unsigned)((b0 >> (16 * tk)) & 0xFFFFull) | ((unsigned)((b1 >> (16 * tk)) & 0xFFFFull) << 16);
                    const unsigned u0 = (unsigned)((b0 | (b0 >> 16) | (b0 >> 32) | (b0 >> 48)) & 0xFFFFull), u1 = (unsigned)((b1 | (b1 >> 16) | (b1 >> 32) | (b1 >> 48)) & 0xFFFFull);
                    um[w] = (unsigned)__builtin_amdgcn_readfirstlane((int)(u0 | (u1 << 16))); }
                if (lane < 4) { const unsigned v = lane == 0 ? um[0] : (lane == 1 ? um[1] : (lane == 2 ? um[2] : um[3])); atomicOr((unsigned*)(wgum + lane), v); }
            }
            __syncthreads();
            if (tid < 128) { const int w = tid >> 5, bi = tid & 31; const unsigned w0 = wgum[0], w1 = wgum[1], w2 = wgum[2], w3 = wgum[3]; const unsigned word = w == 0 ? w0 : (w == 1 ? w1 : (w == 2 ? w2 : w3));
                if ((word >> bi) & 1u) { const int pos = (w > 0 ? __builtin_popcount(w0) : 0) + (w > 1 ? __builtin_popcount(w1) : 0) + (w > 2 ? __builtin_popcount(w2) : 0) + __builtin_popcount(word & ((1u << bi) - 1u)); blist[pos] = (unsigned char)tid; }
                if (tid == 0) wgum[4] = (unsigned)(__builtin_popcount(w0) + __builtin_popcount(w1) + __builtin_popcount(w2) + __builtin_popcount(w3)); }
            __syncthreads();
            {
                float m = -1e30f, l = 0.f; f32x4 o[4];
#pragma unroll
                for (int dt = 0; dt < 4; ++dt) o[dt] = (f32x4){0.f, 0.f, 0.f, 0.f};
                const int nb_s = (int)wgum[4];
                const bf16_t* ksb = Z + (size_t)b * S * ZC + C_KSLC + kvh * 64; const bf16_t* vsb = Z + (size_t)b * S * ZC + C_VSLC + kvh * 64;
                WAITV(0);
                for (int pre = 0; pre < 3 && pre < nb_s; ++pre) { const size_t ro = (size_t)(64 * (int)blist[pre]) * ZC; ISSUE(pre, ksb + ro, vsb + ro, ZC); }
                for (int n = 0; n < nb_s; ++n) { const int slot = n & 3; const int jj = blist[n]; PIPE_WAIT(n, nb_s);
                    if (n + 3 < nb_s) { const size_t ro = (size_t)(64 * (int)blist[n + 3]) * ZC; ISSUE(n + 3, ksb + ro, vsb + ro, ZC); }
                    const unsigned uw = jj < 32 ? um[0] : (jj < 64 ? um[1] : (jj < 96 ? um[2] : um[3]));
                    if ((uw >> (jj & 31)) & 1u) { const unsigned mw = jj < 32 ? mysel[0] : (jj < 64 ? mysel[1] : (jj < 96 ? mysel[2] : mysel[3])); const bool mine = (mw >> (jj & 31)) & 1u;
                        unsigned vm = mine ? 0xFFFFu : 0u;
                        if (jj >= (t0 >> 6)) { vm = 0u;
#pragma unroll
                            for (int qd = 0; qd < 4; ++qd)
#pragma unroll
                                for (int e = 0; e < 4; ++e) vm |= (mine && (64 * jj + 16 * qd + 4 * q4 + e <= t)) ? (1u << (4 * qd + e)) : 0u; }
                        BLOCK64(slot, vm, m, l, o); } }
                l += __shfl_xor(l, 16); l += __shfl_xor(l, 32); const float sc2 = (l > 0.f ? 1.f / l : 0.f) * gsl;
#pragma unroll
                for (int dt = 0; dt < 4; ++dt) yb[dt] = yb[dt] + o[dt] * sc2;
            }
            {
                float m = -1e30f, l = 0.f; f32x4 o[4];
#pragma unroll
                for (int dt = 0; dt < 4; ++dt) o[dt] = (f32x4){0.f, 0.f, 0.f, 0.f};
                const int kws = ((t0w - 511 > 0) ? (t0w - 511) : 0) & ~63; const int nb_w = ((t0w + 31 - kws) >> 6) + 1;
                const bf16_t* kwb = Z + ((size_t)b * S + kws) * ZC + C_KWIN + kvh * 64; const bf16_t* vwb = Z + ((size_t)b * S + kws) * ZC + C_VWIN + kvh * 64;
                WAITV(0); __builtin_amdgcn_s_barrier();
                for (int pre = 0; pre < 3 && pre < nb_w; ++pre) ISSUE(pre, kwb + (size_t)(64 * pre) * ZC, vwb + (size_t)(64 * pre) * ZC, ZC);
                for (int n = 0; n < nb_w; ++n) { const int slot = n & 3; PIPE_WAIT(n, nb_w);
                    if (n + 3 < nb_w) ISSUE(n + 3, kwb + (size_t)(64 * (n + 3)) * ZC, vwb + (size_t)(64 * (n + 3)) * ZC, ZC);
                    const int key0 = kws + 64 * n;
                    if (key0 + 63 >= t0 - 511 && key0 <= t0 + 3) {
                        unsigned vm = 0xFFFFu;
                        if (!(key0 + 63 <= t0 && key0 > t0 + 3 - 512)) { vm = 0u;
#pragma unroll
                            for (int qd = 0; qd < 4; ++qd)
#pragma unroll
                                for (int e = 0; e < 4; ++e) { const int kk = key0 + 16 * qd + 4 * q4 + e; vm |= (kk <= t && kk > t - 512) ? (1u << (4 * qd + e)) : 0u; } }
                        BLOCK64(slot, vm, m, l, o); } }
                l += __shfl_xor(l, 16); l += __shfl_xor(l, 32); const float sc2 = (l > 0.f ? 1.f / l : 0.f) * gwn;
#pragma unroll
                for (int dt = 0; dt < 4; ++dt) yb[dt] = yb[dt] + o[dt] * sc2;
            }
#pragma unroll
            for (int dt = 0; dt < 4; ++dt) { const int c = head * 64 + 16 * dt + 4 * q4; const u32x2 mw = *(const u32x2*)(zr + C_U + c), gw2 = *(const u32x2*)(zr + C_GB + c);
                u32x2 o2; o2.x = pk2(bflo(mw.x) + sigm(bflo(gw2.x)) * yb[dt][0], bfhi(mw.x) + sigm(bfhi(gw2.x)) * yb[dt][1]); o2.y = pk2(bflo(mw.y) + sigm(bflo(gw2.y)) * yb[dt][2], bfhi(mw.y) + sigm(bfhi(gw2.y)) * yb[dt][3]);
                *(u32x2*)(MIX + tok * 1024 + c) = o2; }
            __syncthreads();
        }
#undef DMA16
#undef ISSUE
#undef WAITV
#undef PIPE_WAIT
#undef QK_LDS
#undef PV_LDS
#undef BLOCK64
#undef MK8
    }
    SYNC(5);

    if (IN(6)) RPT(6) { pg8::Gemm g{(const bf16_t*)(dout + DO_MIX), (const bf16_t*)(ws + WS_WOUT_T), T, D, D, D}; pg8::StaticOrder So; So.init(T, D, G, (int)blockIdx.x);
        pg8::EpiF32 E{(float*)(ws + WS_ACCF), D}; pg8::gemm_phase<pg8::EpiF32, pg8::StaticOrder, true>(lds, g, So, E); }
    SYNC(6);

    if (IN(7)) RPT(7) {
        for (int m = gw; m < T; m += NGW) { f32x4 v[4], ac[4]; row_load(v, a.in[0] + (size_t)m * D, lane); row_load(ac, (const float*)(ws + WS_ACCF) + (size_t)m * D, lane); ln_apply(v, a.in[3], a.in[4], lane);
#pragma unroll
            for (int jx = 0; jx < 4; ++jx) v[jx] = v[jx] * ALPHA + ac[jx];
            ln_apply(v, a.in[21], a.in[22], lane); row_store_f32(v, (float*)(ws + WS_HF) + (size_t)m * D, lane); row_store_bf16(v, (bf16_t*)(ws + WS_HB) + (size_t)m * D, lane); }
        LAS float* scr = (LAS float*)(lds + wid * 8448);
        constexpr int I_SQ = 16 * 32, I_F1 = 16 * 128, I_F2 = 64 * 32;
        for (int it = gw; it < 2 * I_SQ + I_F1 + I_F2; it += NGW) { int r = it;
            if (r < I_SQ) { tr_item(a.in[23], 1024, 1024, 1024, (bf16_t*)(ws + WS_WXQ_T), scr, r, lane); continue; } r -= I_SQ;
            if (r < I_SQ) { tr_item(a.in[25], 1024, 1024, 1024, (bf16_t*)(ws + WS_WXO_T), scr, r, lane); continue; } r -= I_SQ;
            if (r < I_F1) { tr_item(a.in[28], 1024, 4096, 4096, (bf16_t*)(ws + WS_WFF1_T), scr, r, lane); continue; } r -= I_F1;
            tr_item(a.in[29], 4096, 1024, 1024, (bf16_t*)(ws + WS_WFF2_T), scr, r, lane); }
    }
    SYNC(7);

    if (IN(8)) RPT(8) { pg8::Gemm g{(const bf16_t*)(ws + WS_HB), (const bf16_t*)(ws + WS_WXQ_T), T, D, D, D}; pg8::StaticOrder So; So.init(T, D, G, (int)blockIdx.x);
        pg8::EpiBf16<0> E{(bf16_t*)(ws + WS_XQ), D, nullptr, XSCALE}; pg8::gemm_phase<pg8::EpiBf16<0>, pg8::StaticOrder, true>(lds, g, So, E); }
    SYNC(8);

    if (IN(9)) RPT(9) {
        const bf16_t* XQ = (const bf16_t*)(ws + WS_XQ); const bf16_t* XKV = (const bf16_t*)(dout + DO_XKV); bf16_t* XO = (bf16_t*)(ws + WS_XO);
        const int j = lane & 15, q4 = lane >> 4;
        const unsigned ldsb = (unsigned)(uintptr_t)lds;
        const unsigned kadr0 = (unsigned)(j * 128 + ((q4 ^ (j & 7)) << 4)), kadr1 = (unsigned)(j * 128 + (((4 + q4) ^ (j & 7)) << 4));
        const int vrow = 4 * q4 + (j >> 2);
        unsigned vadr4[4];
#pragma unroll
        for (int dtl = 0; dtl < 4; ++dtl) vadr4[dtl] = (unsigned)(vrow * 128 + (((2 * dtl + ((lane & 3) >> 1)) ^ (vrow & 7)) << 4) + 8 * (lane & 1));
#define WAITV(n) asm volatile("s_waitcnt vmcnt(" #n ")" ::: "memory")
#define X_ISSUE(st) do { const int st_ = (st); const int sl_ = st_ & 1; \
            if (st_ < 4) { const bf16_t* gb_ = kvb + (size_t)(64 * st_) * 2048; \
                _Pragma("unroll") for (int q_ = 0; q_ < 4; ++q_) { const int row_ = 8 * wid + (lane >> 3); const int ch_ = (lane & 7) ^ (lane >> 3); \
                    __builtin_amdgcn_global_load_lds((const unsigned*)(gb_ + (size_t)row_ * 2048 + 64 * q_ + ch_ * 8), (LAS unsigned*)(lds + sl_ * 32768 + q_ * 8192 + wid * 1024), 16, 0, 0); } } \
            else { const bf16_t* gb_ = kvb + (size_t)(64 * (st_ & 3)) * 2048 + 1024; \
                _Pragma("unroll") for (int q_ = 0; q_ < 4; ++q_) { const int row_ = 8 * wid + (lane >> 3); const int ch_ = (lane & 7) ^ (lane >> 3); \
                    __builtin_amdgcn_global_load_lds((const unsigned*)(gb_ + (size_t)row_ * 2048 + 64 * q_ + ch_ * 8), (LAS unsigned*)(lds + sl_ * 32768 + q_ * 8192 + wid * 1024), 16, 0, 0); } } } while (0)
#define X_WAIT(n) do { WAITV(0); __builtin_amdgcn_s_barrier(); asm volatile("" ::: "memory"); } while (0)
#define MK8(lo, hi) __builtin_bit_cast(bf16x8, (u32x4){(lo).x, (lo).y, (hi).x, (hi).y})
#define X_VGRP(slot, d0, pfa, pfb) do { const unsigned sb_ = (unsigned)((slot) * 32768 + ((d0) >> 2) * 8192) + ldsb; \
            const unsigned a0_ = vadr4[0] + sb_, a1_ = vadr4[1] + sb_, a2_ = vadr4[2] + sb_, a3_ = vadr4[3] + sb_; \
            u32x2 v0_, v1_, v2_, v3_, v4_, v5_, v6_, v7_, v8_, v9_, v10_, v11_, v12_, v13_, v14_, v15_; \
            asm volatile("ds_read_b64_tr_b16 %0, %16\n\tds_read_b64_tr_b16 %1, %16 offset:2048\n\tds_read_b64_tr_b16 %2, %16 offset:4096\n\tds_read_b64_tr_b16 %3, %16 offset:6144\n\t" \
                         "ds_read_b64_tr_b16 %4, %17\n\tds_read_b64_tr_b16 %5, %17 offset:2048\n\tds_read_b64_tr_b16 %6, %17 offset:4096\n\tds_read_b64_tr_b16 %7, %17 offset:6144\n\t" \
                         "ds_read_b64_tr_b16 %8, %18\n\tds_read_b64_tr_b16 %9, %18 offset:2048\n\tds_read_b64_tr_b16 %10, %18 offset:4096\n\tds_read_b64_tr_b16 %11, %18 offset:6144\n\t" \
                         "ds_read_b64_tr_b16 %12, %19\n\tds_read_b64_tr_b16 %13, %19 offset:2048\n\tds_read_b64_tr_b16 %14, %19 offset:4096\n\tds_read_b64_tr_b16 %15, %19 offset:6144\n\ts_waitcnt lgkmcnt(0)" \
                         : "=&v"(v0_), "=&v"(v1_), "=&v"(v2_), "=&v"(v3_), "=&v"(v4_), "=&v"(v5_), "=&v"(v6_), "=&v"(v7_), "=&v"(v8_), "=&v"(v9_), "=&v"(v10_), "=&v"(v11_), "=&v"(v12_), "=&v"(v13_), "=&v"(v14_), "=&v"(v15_) \
                         : "v"(a0_), "v"(a1_), "v"(a2_), "v"(a3_) : "memory"); \
            o[(d0)] = MFMA16(MK8(v0_, v1_), pfa, o[(d0)]); o[(d0)] = MFMA16(MK8(v2_, v3_), pfb, o[(d0)]); o[(d0) + 1] = MFMA16(MK8(v4_, v5_), pfa, o[(d0) + 1]); o[(d0) + 1] = MFMA16(MK8(v6_, v7_), pfb, o[(d0) + 1]); \
            o[(d0) + 2] = MFMA16(MK8(v8_, v9_), pfa, o[(d0) + 2]); o[(d0) + 2] = MFMA16(MK8(v10_, v11_), pfb, o[(d0) + 2]); o[(d0) + 3] = MFMA16(MK8(v12_, v13_), pfa, o[(d0) + 3]); o[(d0) + 3] = MFMA16(MK8(v14_, v15_), pfb, o[(d0) + 3]); } while (0)
        for (int u = blockIdx.x; u < 512; u += G) {
            const int hx = u & 3, tile = u >> 2, tok0 = 128 * tile + 16 * wid, b = tile >> 6;
            const bf16_t* kvb = XKV + (size_t)(b * 256) * 2048 + hx * 256;
            bf16x8 qf[8];
#pragma unroll
            for (int ks = 0; ks < 8; ++ks) qf[ks] = *(const bf16x8*)(XQ + (size_t)(tok0 + j) * 1024 + hx * 256 + 32 * ks + 8 * q4);
            WAITV(0); __builtin_amdgcn_s_barrier(); asm volatile("" ::: "memory");
            X_ISSUE(4); X_ISSUE(5);
            f32x4 s[16];
#pragma unroll
            for (int kt = 0; kt < 16; ++kt) { const bf16_t* kp = kvb + (size_t)(16 * kt + j) * 2048 + 8 * q4; f32x4 acc = {0.f, 0.f, 0.f, 0.f};
#pragma unroll
                for (int ks = 0; ks < 8; ++ks) acc = MFMA16(*(const bf16x8*)(kp + 32 * ks), qf[ks], acc);
                s[kt] = acc; }
            float mx = -1e30f;
#pragma unroll
            for (int kt = 0; kt < 16; ++kt) mx = fmaxf(fmaxf(mx, fmaxf(s[kt][0], s[kt][1])), fmaxf(s[kt][2], s[kt][3]));
            mx = fmaxf(mx, __shfl_xor(mx, 16)); mx = fmaxf(mx, __shfl_xor(mx, 32));
            float l = 0.f; bf16x8 pf[8];
#pragma unroll
            for (int kk = 0; kk < 8; ++kk) { float p[8];
#pragma unroll
                for (int e = 0; e < 4; ++e) { p[e] = __builtin_amdgcn_exp2f(s[2 * kk][e] - mx); p[4 + e] = __builtin_amdgcn_exp2f(s[2 * kk + 1][e] - mx); l += p[e] + p[4 + e]; }
                pf[kk] = pack_p(p); }
            l += __shfl_xor(l, 16); l += __shfl_xor(l, 32); const float invl = 1.f / l;
            f32x4 o[16];
#pragma unroll
            for (int dt = 0; dt < 16; ++dt) o[dt] = (f32x4){0.f, 0.f, 0.f, 0.f};
#pragma unroll
            for (int vb = 0; vb < 4; ++vb) {
                if (vb != 1) WAITV(0);
                __builtin_amdgcn_s_barrier(); asm volatile("" ::: "memory");
                if (vb == 1) X_ISSUE(6);
                if (vb == 2) X_ISSUE(7);
                X_VGRP(vb & 1, 0, pf[2 * vb], pf[2 * vb + 1]); X_VGRP(vb & 1, 4, pf[2 * vb], pf[2 * vb + 1]); X_VGRP(vb & 1, 8, pf[2 * vb], pf[2 * vb + 1]); X_VGRP(vb & 1, 12, pf[2 * vb], pf[2 * vb + 1]); }
#pragma unroll
            for (int dt = 0; dt < 16; ++dt) { u32x2 ow; ow.x = cvtpk(o[dt][0] * invl, o[dt][1] * invl); ow.y = cvtpk(o[dt][2] * invl, o[dt][3] * invl);
                *(u32x2*)(XO + (size_t)(tok0 + j) * 1024 + hx * 256 + 16 * dt + 4 * q4) = ow; }
        }
        WAITV(0); __syncthreads();
#undef WAITV
#undef X_ISSUE
#undef X_WAIT
#undef MK8
#undef X_VGRP
    }
    SYNC(9);

    if (IN(10)) RPT(10) { pg8::Gemm g{(const bf16_t*)(ws + WS_XO), (const bf16_t*)(ws + WS_WXO_T), T, D, D, D}; pg8::StaticOrder So; So.init(T, D, G, (int)blockIdx.x);
        pg8::EpiF32 E{(float*)(ws + WS_ACCF), D}; pg8::gemm_phase<pg8::EpiF32, pg8::StaticOrder, true>(lds, g, So, E); }
    SYNC(10);

    if (IN(11)) RPT(11) {
        for (int m = gw; m < T; m += NGW) { f32x4 v[4], ac[4]; row_load(v, (const float*)(ws + WS_HF) + (size_t)m * D, lane); row_load(ac, (const float*)(ws + WS_ACCF) + (size_t)m * D, lane);
#pragma unroll
            for (int jx = 0; jx < 4; ++jx) v[jx] = v[jx] * ALPHA + ac[jx];
            ln_apply(v, a.in[26], a.in[27], lane); row_store_f32(v, (float*)(ws + WS_HF) + (size_t)m * D, lane); row_store_bf16(v, (bf16_t*)(ws + WS_HB) + (size_t)m * D, lane); }
    }
    SYNC(11);

    if (IN(12)) RPT(12) { pg8::Gemm g{(const bf16_t*)(ws + WS_HB), (const bf16_t*)(ws + WS_WFF1_T), T, FF, D, D}; pg8::StaticOrder So; So.init(T, FF, G, (int)blockIdx.x);
        pg8::EpiBf16<3> E{(bf16_t*)(ws + WS_FFB), FF, nullptr, 1.f}; pg8::gemm_phase<pg8::EpiBf16<3>, pg8::StaticOrder, true>(lds, g, So, E); }
    SYNC(12);

    if (IN(13)) RPT(13) { pg8::Gemm g{(const bf16_t*)(ws + WS_FFB), (const bf16_t*)(ws + WS_WFF2_T), T, D, FF, FF}; pg8::StaticOrder So; So.init(T, D, G, (int)blockIdx.x);
        pg8::EpiF32 E{a.out, D}; pg8::gemm_phase<pg8::EpiF32, pg8::StaticOrder, true>(lds, g, So, E); }
    SYNC(13);

    if (IN(14)) RPT(14) {
        for (int m = gw; m < T; m += NGW) { f32x4 v[4], ac[4]; row_load(v, (const float*)(ws + WS_HF) + (size_t)m * D, lane); row_load(ac, a.out + (size_t)m * D, lane);
#pragma unroll
            for (int jx = 0; jx < 4; ++jx) v[jx] = v[jx] * ALPHA + ac[jx];
            ln_apply(v, a.in[30], a.in[31], lane); row_store_f32(v, a.out + (size_t)m * D, lane); }
    }
#undef IN
#undef SYNC
}

constexpr int NPHASE = 15;
extern "C" void kernel_launch(void* const* d_in, const int* in_sizes, int n_in, void* d_out, int out_size, void* d_ws, size_t ws_size, hipStream_t stream) {
    static int grid = 0;
    if (grid == 0) {
        if (n_in != 32 || out_size != T * D || ws_size < 256 * MiB) { fprintf(stderr, "kernel_launch: unexpected shapes (n_in %d out %d ws %zu)\n", n_in, out_size, ws_size); grid = -1; return; }
        int dev = 0, cus = 0, per_cu = 0;
        hipGetDevice(&dev); hipDeviceGetAttribute(&cus, hipDeviceAttributeMultiprocessorCount, dev);
        hipFuncSetAttribute((const void*)mk_fwd, hipFuncAttributeMaxDynamicSharedMemorySize, LDS_BYTES);
        hipOccupancyMaxActiveBlocksPerMultiprocessor(&per_cu, (const void*)mk_fwd, 512, LDS_BYTES);
        (void)hipGetLastError();
        if (per_cu < 1) fprintf(stderr, "kernel_launch: occupancy query says %d blocks per CU\n", per_cu);
        grid = cus > 0 ? cus : 256;
    }
    if (grid < 0) return;
    Args a{};
    for (int i = 0; i < 32; ++i) a.in[i] = (const float*)d_in[i];
    a.out = (float*)d_out; a.ws = (unsigned char*)d_ws; a.ph_lo = 0; a.ph_hi = NPHASE;
    void* args[] = {&a};
    hipError_t e = hipLaunchCooperativeKernel((const void*)mk_fwd, dim3(grid), dim3(512), args, LDS_BYTES, stream);
    if (e != hipSuccess) fprintf(stderr, "cooperative launch failed: %s (grid %d)\n", hipGetErrorString(e), grid);
}
```

```cpp
#include <hip/hip_runtime.h>
#include <hip/hip_cooperative_groups.h>
#include <cstdio>
#include <cstdint>
namespace cg = cooperative_groups;

#define LAS __attribute__((address_space(3)))
typedef unsigned short bf16_t;
typedef short bf16x8 __attribute__((ext_vector_type(8)));
typedef float f32x4 __attribute__((ext_vector_type(4)));
typedef float f32x2 __attribute__((ext_vector_type(2)));
typedef unsigned u32x4 __attribute__((ext_vector_type(4)));
typedef unsigned u32x2 __attribute__((ext_vector_type(2)));

__device__ __forceinline__ unsigned f2bf(float f) { unsigned u = __builtin_bit_cast(unsigned, f); return (u + 0x7fffu + ((u >> 16) & 1u)) >> 16; }
__device__ __forceinline__ unsigned pk2(float lo, float hi) { return f2bf(lo) | (f2bf(hi) << 16); }
__device__ __forceinline__ float bflo(unsigned w) { return __builtin_bit_cast(float, w << 16); }
__device__ __forceinline__ float bfhi(unsigned w) { return __builtin_bit_cast(float, w & 0xffff0000u); }
__device__ __forceinline__ float bf1(bf16_t h) { return __builtin_bit_cast(float, ((unsigned)h) << 16); }
__device__ __forceinline__ float gelu_t(float x) { const float u = x * (1.f + 0.044715f * x * x); const float e = __builtin_amdgcn_exp2f(-2.3022081986f * u); return x * __builtin_amdgcn_rcpf(1.f + e); }
__device__ __forceinline__ float sigm(float x) { return __builtin_amdgcn_rcpf(1.f + __builtin_amdgcn_exp2f(-1.4426950409f * x)); }
__device__ __forceinline__ float wave_sum(float v) {
#pragma unroll
    for (int o = 1; o < 64; o <<= 1) v += __shfl_xor(v, o);
    return v;
}
#define LDS_WAIT() asm volatile("s_waitcnt lgkmcnt(0)" ::: "memory")

namespace pg8 {
constexpr int BM = 256, BK = 64, HALF = 128, HTB = HALF * BK * 2, STAGE_BYTES = 8 * HTB, NXCD = 8, WGM = 8;
__host__ __device__ __forceinline__ int lds_byte(int r, int c) { const int st = (r >> 4) * 2 + (c >> 5), rr = r & 15, cc = c & 31, ob = rr * 64 + cc * 2; return st * 1024 + (ob ^ (((ob >> 9) & 1) << 5)); }
__host__ __device__ __forceinline__ void stage_rc(int b, int& R, int& C) { const int st = b / 1024, sb = b % 1024, swz = sb ^ (((sb >> 9) & 1) << 5); R = (st >> 1) * 16 + swz / 64; C = (st & 1) * 32 + (swz % 64) / 2; }
__host__ __device__ __forceinline__ int perm32(int rho) { const int n = rho >> 4, i = rho & 15; return 8 * (i >> 2) + 4 * n + (i & 3); }
struct Unit { int pm, pn; };
struct Gemm { const bf16_t* A; const bf16_t* Bt; int M, N, K, lda; };
struct StaticOrder {
    int nM, nN, nwg, G, c;
    __device__ void init(int M, int N, int G_, int c_) { nM = M / BM; nN = N / BM; nwg = nM * nN; G = G_; c = c_; }
    __device__ bool next(int i, Unit& u) const {
        const long L = (long)i * G + c; if (L >= nwg) return false;
        int wgid = (int)L; { const int q = nwg / NXCD, r = nwg % NXCD, xcd = wgid % NXCD, off = wgid / NXCD; wgid = (xcd < r ? xcd * (q + 1) : r * (q + 1) + (xcd - r) * q) + off; }
        const int nig = WGM * nN, gid = wgid / nig, fm = gid * WGM, gsz = (nM - fm) < WGM ? (nM - fm) : WGM;
        u.pm = fm + ((wgid % nig) % gsz); u.pn = (wgid % nig) / gsz; return true;
    }
};
__device__ __forceinline__ unsigned cvt_pk_bf16(float lo, float hi) { unsigned r; asm volatile("v_cvt_pk_bf16_f32 %0, %1, %2" : "=v"(r) : "v"(lo), "v"(hi)); return r; }

template <int ACT> struct EpiBf16 {
    static constexpr bool PERM = true;
    bf16_t* O; int ldc; const float* bias; float scale;
    __device__ __forceinline__ void operator()(const f32x4 (&acc)[2][2][4][2], const Unit& u, int wr, int wc, int fr, int fq) const {
        const int row0 = u.pm * BM + wr * 64 + fr; const int col0 = u.pn * BM + wc * 32 + 8 * fq;
        f32x4 bv[2][2];
#pragma unroll
        for (int bj = 0; bj < 2; ++bj)
#pragma unroll
            for (int n = 0; n < 2; ++n) bv[bj][n] = bias ? *(const f32x4*)(bias + col0 + bj * HALF + 4 * n) : (f32x4){0.f, 0.f, 0.f, 0.f};
#pragma unroll
        for (int ai = 0; ai < 2; ++ai)
#pragma unroll
            for (int m = 0; m < 4; ++m) { bf16_t* rowp = O + (size_t)(row0 + ai * HALF + m * 16) * ldc + col0;
#pragma unroll
                for (int bj = 0; bj < 2; ++bj) { f32x4 v0 = acc[ai][bj][m][0] + bv[bj][0], v1 = acc[ai][bj][m][1] + bv[bj][1];
                    if (ACT == 2) {
#pragma unroll
                        for (int e = 0; e < 4; ++e) { v0[e] = gelu_t(v0[e]); v1[e] = gelu_t(v1[e]); } }
                    if (ACT == 3) {
#pragma unroll
                        for (int e = 0; e < 4; ++e) { float a0 = v0[e] > 0.f ? v0[e] : 0.f, a1 = v1[e] > 0.f ? v1[e] : 0.f; v0[e] = a0 * a0; v1[e] = a1 * a1; } }
                    v0 = v0 * scale; v1 = v1 * scale; u32x4 w; w.x = cvt_pk_bf16(v0[0], v0[1]); w.y = cvt_pk_bf16(v0[2], v0[3]); w.z = cvt_pk_bf16(v1[0], v1[1]); w.w = cvt_pk_bf16(v1[2], v1[3]);
                    *(u32x4*)(rowp + bj * HALF) = w; } }
    }
};
struct EpiF32 {
    static constexpr bool PERM = false;
    float* O; int ldc;
    __device__ __forceinline__ void operator()(const f32x4 (&acc)[2][2][4][2], const Unit& u, int wr, int wc, int fr, int fq) const {
        const int row0 = u.pm * BM + wr * 64 + fr; const int col0 = u.pn * BM + wc * 32 + 4 * fq;
#pragma unroll
        for (int ai = 0; ai < 2; ++ai)
#pragma unroll
            for (int m = 0; m < 4; ++m) { float* rowp = O + (size_t)(row0 + ai * HALF + m * 16) * ldc + col0;
#pragma unroll
                for (int bj = 0; bj < 2; ++bj)
#pragma unroll
                    for (int n = 0; n < 2; ++n) *(f32x4*)(rowp + bj * HALF + n * 16) = acc[ai][bj][m][n]; }
    }
};

template <class Epi, class Sched, bool ALIGN_EPI>
__device__ __forceinline__ void gemm_phase(LAS unsigned char* lds, const Gemm g, const Sched& S, const Epi& E) {
    const int tid = threadIdx.x, wid = __builtin_amdgcn_readfirstlane(tid >> 6), lane = tid & 63, wr = wid >> 2, wc = wid & 3, fr = lane & 15, fq = lane >> 4;
    const int K = g.K, nt = K / BK, lda = g.lda;
    unsigned voffA[2], voffB[2];
#pragma unroll
    for (int i = 0; i < 2; ++i) { int R, C; stage_rc(tid * 16 + i * 8192, R, C); const int Rb = Epi::PERM ? ((R & ~31) + perm32(R & 31)) : R;
        voffA[i] = (unsigned)(R * lda + C) * 2u; voffB[i] = (unsigned)(Rb * K + C) * 2u; }
    const size_t kstep = (size_t)(BK * 2);
    const size_t hstepA = (size_t)HALF * lda * 2, hstepB = (size_t)HALF * K * 2;
    const size_t tstepA = 2 * hstepA, tstepB = 2 * hstepB;
    const unsigned ldsw = (unsigned)wid * 1024u;
    const int aoff = lds_byte(wr * 64 + fr, fq * 8), boff = lds_byte(wc * 32 + fr, fq * 8);
#define PG8_SA(b, h) (((b) * 2 + (h)) * HTB)
#define PG8_SB(b, h) ((4 + (b) * 2 + (h)) * HTB)
#define PG8_STAGE(bufoff, gbase, voff) do { _Pragma("unroll") for (int _i = 0; _i < 2; ++_i) \
        __builtin_amdgcn_global_load_lds((const unsigned*)((const char*)(gbase) + (voff)[_i]), (LAS unsigned*)(lds + (bufoff) + ldsw + _i * 8192), 16, 0, 0); } while (0)
#define PG8_LDA(dst, b, h) do { _Pragma("unroll") for (int m = 0; m < 4; ++m) _Pragma("unroll") for (int k = 0; k < 2; ++k) dst[m][k] = *(const LAS bf16x8*)(lds + PG8_SA(b, h) + aoff + m * 2048 + k * 1024); } while (0)
#define PG8_LDB(dst, b, h) do { _Pragma("unroll") for (int n = 0; n < 2; ++n) _Pragma("unroll") for (int k = 0; k < 2; ++k) dst[n][k] = *(const LAS bf16x8*)(lds + PG8_SB(b, h) + boff + n * 2048 + k * 1024); } while (0)
#define PG8_MMA(ai, bj, At, Bt) do { __builtin_amdgcn_s_setprio(1); _Pragma("unroll") for (int m = 0; m < 4; ++m) _Pragma("unroll") for (int n = 0; n < 2; ++n) _Pragma("unroll") for (int k = 0; k < 2; ++k) \
        acc[ai][bj][m][n] = __builtin_amdgcn_mfma_f32_16x16x32_bf16(Bt[n][k], At[m][k], acc[ai][bj][m][n], 0, 0, 0); __builtin_amdgcn_s_setprio(0); } while (0)
#define PG8_WAIT_V(n) asm volatile("s_waitcnt vmcnt(" #n ")" ::: "memory")
#define PG8_WAIT_L(n) asm volatile("s_waitcnt lgkmcnt(" #n ")" ::: "memory")
#define PG8_BAR __builtin_amdgcn_s_barrier()
#define PG8_SCHED __builtin_amdgcn_sched_barrier(0)
    Unit cur, nxt; int ui = 0;
    if (!S.next(0, cur)) return;
    f32x4 acc[2][2][4][2];
#pragma unroll
    for (int a = 0; a < 2; ++a)
#pragma unroll
        for (int b = 0; b < 2; ++b)
#pragma unroll
            for (int m = 0; m < 4; ++m)
#pragma unroll
                for (int n = 0; n < 2; ++n) acc[a][b][m][n] = (f32x4){0.f, 0.f, 0.f, 0.f};
    bf16x8 At[4][2], B0[2][2], B1[2][2];
    const char* cA = (const char*)g.A + (size_t)cur.pm * tstepA; const char* cB = (const char*)g.Bt + (size_t)cur.pn * tstepB;
    PG8_STAGE(PG8_SB(0, 0), cB, voffB); PG8_STAGE(PG8_SB(0, 1), cB + hstepB, voffB); PG8_STAGE(PG8_SA(0, 0), cA, voffA); PG8_STAGE(PG8_SA(0, 1), cA + hstepA, voffA);
    if (wr == 1) PG8_BAR;
    PG8_WAIT_V(2); PG8_BAR;
    PG8_STAGE(PG8_SB(1, 0), cB + kstep, voffB); PG8_STAGE(PG8_SA(1, 0), cA + kstep, voffA); PG8_STAGE(PG8_SB(1, 1), cB + hstepB + kstep, voffB);
    PG8_WAIT_V(6); PG8_BAR;
    for (;;) {
        const bool has_next = S.next(ui + 1, nxt);
        const char* nA = has_next ? (const char*)g.A + (size_t)nxt.pm * tstepA : cA; const char* nB = has_next ? (const char*)g.Bt + (size_t)nxt.pn * tstepB : cB;
        for (int t = 0; t < nt; t += 2) {
            const bool last = (t == nt - 2);
            const char* a1 = cA + (size_t)(t + 1) * kstep;
            const char* a2 = last ? nA : cA + (size_t)(t + 2) * kstep; const char* b2 = last ? nB : cB + (size_t)(t + 2) * kstep;
            const char* a3 = a2 + kstep; const char* b3 = b2 + kstep;
            PG8_LDB(B0, 0, 0); PG8_LDB(B1, 0, 1); PG8_SCHED; PG8_LDA(At, 0, 0); PG8_STAGE(PG8_SA(1, 1), a1 + hstepA, voffA);
            PG8_WAIT_V(8); PG8_WAIT_L(0); PG8_BAR; PG8_MMA(0, 0, At, B0); PG8_MMA(0, 1, At, B1); PG8_BAR; PG8_SCHED;
            PG8_LDA(At, 0, 1); PG8_STAGE(PG8_SB(0, 0), b2, voffB); PG8_STAGE(PG8_SB(0, 1), b2 + hstepB, voffB); PG8_STAGE(PG8_SA(0, 0), a2, voffA);
            PG8_WAIT_V(8); PG8_WAIT_L(0); PG8_BAR; PG8_MMA(1, 0, At, B0); PG8_MMA(1, 1, At, B1); PG8_BAR; PG8_SCHED;
            PG8_LDB(B0, 1, 0); PG8_LDB(B1, 1, 1); PG8_SCHED; PG8_LDA(At, 1, 0); PG8_STAGE(PG8_SA(0, 1), a2 + hstepA, voffA);
            PG8_WAIT_V(8); PG8_WAIT_L(0); PG8_BAR; PG8_MMA(0, 0, At, B0); PG8_MMA(0, 1, At, B1); PG8_BAR; PG8_SCHED;
            PG8_LDA(At, 1, 1); PG8_STAGE(PG8_SB(1, 0), b3, voffB); PG8_STAGE(PG8_SB(1, 1), b3 + hstepB, voffB); PG8_STAGE(PG8_SA(1, 0), a3, voffA);
            PG8_WAIT_V(8); PG8_WAIT_L(0); PG8_BAR; PG8_MMA(1, 0, At, B0); PG8_MMA(1, 1, At, B1); PG8_BAR; PG8_SCHED;
        }
        if constexpr (ALIGN_EPI) { if (wr == 0) PG8_BAR; }
        E(acc, cur, wr, wc, fr, fq);
        if (!has_next) break;
#pragma unroll
        for (int a = 0; a < 2; ++a)
#pragma unroll
            for (int b = 0; b < 2; ++b)
#pragma unroll
                for (int m = 0; m < 4; ++m)
#pragma unroll
                    for (int n = 0; n < 2; ++n) acc[a][b][m][n] = (f32x4){0.f, 0.f, 0.f, 0.f};
        cur = nxt; cA = nA; cB = nB; ++ui;
        if constexpr (ALIGN_EPI) { if (wr == 1) PG8_BAR; }
    }
    PG8_WAIT_V(0);
    if constexpr (!ALIGN_EPI) { if (wr == 0) PG8_BAR; }
    PG8_BAR;
#undef PG8_SA
#undef PG8_SB
#undef PG8_STAGE
#undef PG8_LDA
#undef PG8_LDB
#undef PG8_MMA
#undef PG8_WAIT_V
#undef PG8_WAIT_L
#undef PG8_BAR
#undef PG8_SCHED
}
}

#define XB_TMO      128
#define XB_XCNT(j)  (256  + 64 * (j))
#define XB_XSUB(j)  (1280 + 64 * (j))
#define XB_XGEN(j)  (2304 + 64 * (j))
#define XB_TOP      3328
#define XB_TOPGEN   3392
#define XCD_BAR_WORDS 3456
#define XB_SPIN_CAP (1u << 18)

__device__ __forceinline__ unsigned xb_ld(unsigned* p)              { return __hip_atomic_load(p, __ATOMIC_RELAXED, __HIP_MEMORY_SCOPE_AGENT); }
__device__ __forceinline__ unsigned xb_add(unsigned* p, unsigned v) { return __hip_atomic_fetch_add(p, v, __ATOMIC_RELAXED, __HIP_MEMORY_SCOPE_AGENT); }
__device__ __forceinline__ unsigned xb_xcc_id() { return (unsigned)__builtin_amdgcn_s_getreg((3 << 11) | 20) & 0xFu; }
#define XB_SPIN(cond, bar) do { unsigned _sp = 0; while (cond) { __builtin_amdgcn_s_sleep(1); \
    if ((++_sp & 255u) == 0u) { if (xb_ld(&(bar)[XB_TMO])) break; if (_sp > XB_SPIN_CAP) { atomicAdd(&(bar)[XB_TMO], 1u); break; } } } } while (0)

struct XcdBarrier {
    unsigned* bar; unsigned x;
    volatile LAS unsigned* st;
};

__device__ __forceinline__ XcdBarrier xcd_barrier_post(unsigned* bar, volatile LAS unsigned* st) {
    XcdBarrier b; b.bar = bar; b.x = xb_xcc_id(); b.st = st;
    if (threadIdx.x == 0) (void)xb_add(&bar[XB_XCNT(b.x)], 1u);
    return b;
}
__device__ __forceinline__ void xcd_barrier_complete(unsigned* bar, unsigned x, unsigned& nloc, unsigned& nx) {
    const unsigned G = gridDim.x * gridDim.y * gridDim.z;
    unsigned sum, cnt, mine, sp = 0u;
    for (;;) {
        sum = 0u; cnt = 0u; mine = 0u;
#pragma unroll
        for (unsigned j = 0; j < 16; ++j) { const unsigned c = xb_ld(&bar[XB_XCNT(j)]); sum += c; cnt += (c > 0u) ? 1u : 0u; mine = (j == x) ? c : mine; }
        if (sum == G) break;
        __builtin_amdgcn_s_sleep(1);
        if ((++sp & 255u) == 0u) { if (xb_ld(&bar[XB_TMO])) break; if (sp > XB_SPIN_CAP) { atomicAdd(&bar[XB_TMO], 1u); break; } }
    }
    nloc = mine > 0u ? mine : 1u; nx = cnt > 0u ? cnt : 1u;
}

__device__ __forceinline__ void xcd_barrier(const XcdBarrier& b) {
    asm volatile("s_waitcnt vmcnt(0)" ::: "memory");
    __syncthreads();
    if (threadIdx.x == 0) {
        unsigned* bar = b.bar;
        __builtin_amdgcn_s_waitcnt(0);
        unsigned nloc = b.st[0], nx = b.st[1];
        if (nloc == 0u) { xcd_barrier_complete(bar, b.x, nloc, nx); b.st[0] = nloc; b.st[1] = nx; }
        const unsigned old = xb_add(&bar[XB_XSUB(b.x)], 1u);
        const unsigned gen = old / nloc;
        if (old + 1u == (gen + 1u) * nloc) {
            __builtin_amdgcn_fence(__ATOMIC_RELEASE, "agent");
            asm volatile("s_waitcnt vmcnt(0)" ::: "memory");
            const unsigned og = xb_add(&bar[XB_TOP], 1u);
            const unsigned tg = og / nx;
            if (og + 1u == (tg + 1u) * nx) xb_add(&bar[XB_TOPGEN], 1u);
            else XB_SPIN(xb_ld(&bar[XB_TOPGEN]) == tg, bar);
            __builtin_amdgcn_fence(__ATOMIC_ACQUIRE, "agent");
            xb_add(&bar[XB_XGEN(b.x)], 1u);
            asm volatile("s_waitcnt vmcnt(0)" ::: "memory");
        } else {
            XB_SPIN(xb_ld(&bar[XB_XGEN(b.x)]) == gen, bar);
            __builtin_amdgcn_fence(__ATOMIC_ACQUIRE, "agent");
            asm volatile("s_waitcnt vmcnt(0)" ::: "memory");
        }
    }
    __syncthreads();
}


constexpr int NB = 2, S = 8192, D = 1024, T = NB * S, FF = 4096;
constexpr int ZC = 6912;
constexpr int C_U = 0, C_V = 1024, C_Q = 2048, C_KCMP = 3072, C_VCMP = 3328, C_KSLC = 3584, C_VSLC = 3840, C_KWIN = 4096, C_VWIN = 4352, C_GN = 4608, C_GA = 4656, C_GB = 5680;
constexpr float ALPHA = 1.189207115002721f;
constexpr float QSCALE = 0.125f * 1.4426950408889634f;
constexpr float XSCALE = 0.0625f * 1.4426950408889634f;
constexpr float LN_EPS = 1e-5f;
constexpr size_t MiB = 1u << 20;
constexpr size_t WS_Z = 0, WS_KCMPT = 216 * MiB, WS_VCMPT = 224 * MiB, WS_VSLCT = 232 * MiB, WS_VWINT = 240 * MiB, WS_HDNK = 248 * MiB, WS_HDNV = 250 * MiB,
                 WS_KC = 252 * MiB, WS_VCT = 252 * MiB + 512 * 1024, WS_WOUT_T = 253 * MiB, WS_C1 = 255 * MiB, WS_W2KT = 255 * MiB + 4096, WS_W2VT = 255 * MiB + 65536, WS_WSTRIL = 255 * MiB + 131072, WS_C1P = 255 * MiB + 524288, WS_BAR = 255 * MiB + 786432;
constexpr size_t WS_HF = 0, WS_HB = 64 * MiB, WS_XQ = 96 * MiB, WS_XO = 128 * MiB, WS_ACCF = 160 * MiB, WS_FFB = 96 * MiB,
                 WS_WXQ_T = 224 * MiB, WS_WXO_T = 226 * MiB, WS_WFF1_T = 228 * MiB, WS_WFF2_T = 236 * MiB;
constexpr size_t DO_H0B = 0, DO_MIX = 0, DO_WIN_T = 32 * MiB, DO_WXKV_T = 46 * MiB, DO_MEMB = 50 * MiB, DO_XKV = 51 * MiB, DO_XVT = 53 * MiB, DO_ROPE = 54 * MiB, DO_W1KT = 55 * MiB, DO_W1VT = 56 * MiB;
constexpr int LDS_BYTES = 147456;

struct Args { const float* in[32]; float* out; unsigned char* ws; int ph_lo, ph_hi; };

__device__ __forceinline__ void tr_item(const float* W, int K, int N, int Npad, bf16_t* WT, LAS float* scr, int item, int lane) {
    const int nblk = Npad / 32, kb = item / nblk, nb = item % nblk, k0 = 64 * kb, n0 = 32 * nb;
    const int cc = n0 + (lane & 31);
#pragma unroll 8
    for (int i = 0; i < 32; ++i) { const int kk = 2 * i + (lane >> 5); scr[kk * 33 + (lane & 31)] = (cc < N) ? W[(size_t)(k0 + kk) * N + cc] : 0.f; }
    LDS_WAIT();
    const int c = lane & 7;
#pragma unroll
    for (int j = 0; j < 4; ++j) { const int n = (lane >> 3) + 8 * j; const LAS float* s = scr + (8 * c) * 33 + n;
        u32x4 o; o.x = pk2(s[0 * 33], s[1 * 33]); o.y = pk2(s[2 * 33], s[3 * 33]); o.z = pk2(s[4 * 33], s[5 * 33]); o.w = pk2(s[6 * 33], s[7 * 33]);
        *(u32x4*)(WT + (size_t)(n0 + n) * K + k0 + 8 * c) = o; }
    LDS_WAIT();
}

__device__ __forceinline__ void ln_apply(f32x4 (&v)[4], const float* g, const float* b, int lane) {
    float s = 0.f;
#pragma unroll
    for (int j = 0; j < 4; ++j) s += (v[j].x + v[j].y) + (v[j].z + v[j].w);
    const float mean = wave_sum(s) * (1.f / 1024.f); float s2 = 0.f;
#pragma unroll
    for (int j = 0; j < 4; ++j) { v[j] = v[j] - mean; s2 += (v[j].x * v[j].x + v[j].y * v[j].y) + (v[j].z * v[j].z + v[j].w * v[j].w); }
    const float rstd = 1.f / sqrtf(wave_sum(s2) * (1.f / 1024.f) + LN_EPS);
#pragma unroll
    for (int j = 0; j < 4; ++j) { const f32x4 gg = *(const f32x4*)(g + 4 * lane + 256 * j), bb = *(const f32x4*)(b + 4 * lane + 256 * j); v[j] = v[j] * rstd * gg + bb; }
}
__device__ __forceinline__ void row_load(f32x4 (&v)[4], const float* p, int lane) {
#pragma unroll
    for (int j = 0; j < 4; ++j) v[j] = *(const f32x4*)(p + 4 * lane + 256 * j);
}
__device__ __forceinline__ void row_store_f32(const f32x4 (&v)[4], float* p, int lane) {
#pragma unroll
    for (int j = 0; j < 4; ++j) *(f32x4*)(p + 4 * lane + 256 * j) = v[j];
}
__device__ __forceinline__ void row_store_bf16(const f32x4 (&v)[4], bf16_t* p, int lane) {
#pragma unroll
    for (int j = 0; j < 4; ++j) { u32x2 w; w.x = pk2(v[j].x, v[j].y); w.y = pk2(v[j].z, v[j].w); *(u32x2*)(p + 4 * lane + 256 * j) = w; }
}

#define MFMA16(a, b, c) __builtin_amdgcn_mfma_f32_16x16x32_bf16((a), (b), (c), 0, 0, 0)

__device__ __forceinline__ void qk32(const bf16_t* kp, size_t t1off, bf16x8 qf0, bf16x8 qf1, f32x4& s0, f32x4& s1) {
    const bf16x8 k00 = *(const bf16x8*)(kp), k01 = *(const bf16x8*)(kp + 32), k10 = *(const bf16x8*)(kp + t1off), k11 = *(const bf16x8*)(kp + t1off + 32);
    const f32x4 z = {0.f, 0.f, 0.f, 0.f};
    s0 = MFMA16(k00, qf0, z); s0 = MFMA16(k01, qf1, s0); s1 = MFMA16(k10, qf0, z); s1 = MFMA16(k11, qf1, s1);
}
__device__ __forceinline__ void pv32(const bf16_t* vp, size_t dtoff, bf16x8 pb, f32x4 (&o)[4]) {
#pragma unroll
    for (int dt = 0; dt < 4; ++dt) { const u32x2 lo = *(const u32x2*)(vp + dt * dtoff), hi = *(const u32x2*)(vp + dt * dtoff + 16);
        u32x4 w; w.x = lo.x; w.y = lo.y; w.z = hi.x; w.w = hi.y; o[dt] = MFMA16(__builtin_bit_cast(bf16x8, w), pb, o[dt]); }
}
__device__ __forceinline__ unsigned cvtpk(float lo, float hi) { unsigned r; asm volatile("v_cvt_pk_bf16_f32 %0, %1, %2" : "=v"(r) : "v"(lo), "v"(hi)); return r; }
__device__ __forceinline__ bf16x8 pack_p(const float (&p)[8]) { u32x4 w; w.x = cvtpk(p[0], p[1]); w.y = cvtpk(p[2], p[3]); w.z = cvtpk(p[4], p[5]); w.w = cvtpk(p[6], p[7]); return __builtin_bit_cast(bf16x8, w); }
__device__ __forceinline__ float dpp_xor1(float v) { return __builtin_bit_cast(float, __builtin_amdgcn_mov_dpp(__builtin_bit_cast(int, v), 0xB1, 0xF, 0xF, true)); }
__device__ __forceinline__ float dpp_xor2(float v) { return __builtin_bit_cast(float, __builtin_amdgcn_mov_dpp(__builtin_bit_cast(int, v), 0x4E, 0xF, 0xF, true)); }
__device__ __forceinline__ bf16x8 osm_step(f32x4 s0, f32x4 s1, unsigned vm, float& m, float& l, f32x4 (&o)[4]) {
    const float NINF = -__builtin_inff();
#pragma unroll
    for (int e = 0; e < 4; ++e) { s0[e] = ((vm >> e) & 1u) ? s0[e] : NINF; s1[e] = ((vm >> (4 + e)) & 1u) ? s1[e] : NINF; }
    float mx = fmaxf(fmaxf(fmaxf(s0[0], s0[1]), fmaxf(s0[2], s0[3])), fmaxf(fmaxf(s1[0], s1[1]), fmaxf(s1[2], s1[3])));
    if (__ballot(mx > m + 8.f) != 0ull) {
        float r = fmaxf(mx, __shfl_xor(mx, 16)); r = fmaxf(r, __shfl_xor(r, 32));
        const float mn = fmaxf(m, r), alpha = __builtin_amdgcn_exp2f(m - mn); m = mn; l *= alpha;
#pragma unroll
        for (int dt = 0; dt < 4; ++dt) o[dt] = o[dt] * alpha;
    }
    float p[8];
#pragma unroll
    for (int e = 0; e < 4; ++e) { p[e] = __builtin_amdgcn_exp2f(s0[e] - m); p[4 + e] = __builtin_amdgcn_exp2f(s1[e] - m); }
    l += ((p[0] + p[1]) + (p[2] + p[3])) + ((p[4] + p[5]) + (p[6] + p[7]));
    return pack_p(p);
}

__device__ __forceinline__ void osm_step64(f32x4 (&s)[4], unsigned vm, float& m, float& l, f32x4 (&o)[4], bf16x8& pb0, bf16x8& pb1) {
    const float NINF = -__builtin_inff();
#pragma unroll
    for (int qd = 0; qd < 4; ++qd)
#pragma unroll
        for (int e = 0; e < 4; ++e) s[qd][e] = ((vm >> (4 * qd + e)) & 1u) ? s[qd][e] : NINF;
    const float mx = fmaxf(fmaxf(fmaxf(fmaxf(s[0][0], s[0][1]), fmaxf(s[0][2], s[0][3])), fmaxf(fmaxf(s[1][0], s[1][1]), fmaxf(s[1][2], s[1][3]))),
                           fmaxf(fmaxf(fmaxf(s[2][0], s[2][1]), fmaxf(s[2][2], s[2][3])), fmaxf(fmaxf(s[3][0], s[3][1]), fmaxf(s[3][2], s[3][3]))));
    if (__ballot(mx > m + 8.f) != 0ull) {
        float r = fmaxf(mx, __shfl_xor(mx, 16)); r = fmaxf(r, __shfl_xor(r, 32));
        const float mn = fmaxf(m, r), alpha = __builtin_amdgcn_exp2f(m - mn); m = mn; l *= alpha;
#pragma unroll
        for (int dt = 0; dt < 4; ++dt) o[dt] = o[dt] * alpha;
    }
    float p[8], q[8];
#pragma unroll
    for (int e = 0; e < 4; ++e) { p[e] = __builtin_amdgcn_exp2f(s[0][e] - m); p[4 + e] = __builtin_amdgcn_exp2f(s[1][e] - m); q[e] = __builtin_amdgcn_exp2f(s[2][e] - m); q[4 + e] = __builtin_amdgcn_exp2f(s[3][e] - m); }
    l += (((p[0] + p[1]) + (p[2] + p[3])) + ((p[4] + p[5]) + (p[6] + p[7]))) + (((q[0] + q[1]) + (q[2] + q[3])) + ((q[4] + q[5]) + (q[6] + q[7])));
    pb0 = pack_p(p); pb1 = pack_p(q);
}

__global__ void __launch_bounds__(512, 2) mk_fwd(Args a) {
    extern __shared__ __attribute__((aligned(16))) unsigned char lds_raw[];
    LAS unsigned char* lds = (LAS unsigned char*)lds_raw;
    cg::grid_group grid = cg::this_grid();
    const int tid = threadIdx.x, lane = tid & 63, wid = __builtin_amdgcn_readfirstlane(tid >> 6);
    const int G = gridDim.x, gw = blockIdx.x * 8 + wid, NGW = G * 8, gtid = blockIdx.x * 512 + tid, NGT = G * 512;
    unsigned char* ws = a.ws; unsigned char* dout = (unsigned char*)a.out;
    const int lo = a.ph_lo, hi = a.ph_hi;
#define IN(k) (lo <= (k) && (k) < hi)
#define SYNC(k) do { if (IN(k) && IN((k) + 1)) { if ((k) == 0) grid.sync(); else xcd_barrier(xbar); } } while (0)
#ifndef PROBE_PH
#define PROBE_PH -1
#endif
#ifndef PROBE_N
#define PROBE_N 2
#endif
#ifndef PROBE_MASK
#define PROBE_MASK 0
#endif
#define PRB(k) ((k) == PROBE_PH || ((PROBE_MASK >> (k)) & 1))
#define RPT(k) for (int rp_ = 0; rp_ < (PRB(k) ? PROBE_N : 1); ++rp_, (PRB(k) && rp_ < PROBE_N) ? xcd_barrier(xbar) : (void)0)
    bf16_t* const Z = (bf16_t*)(ws + WS_Z);
    volatile LAS unsigned* xst = (volatile LAS unsigned*)(lds + LDS_BYTES - 64);
    if (tid == 0) { xst[0] = 0u; xst[1] = 0u; }
    __syncthreads();
    const XcdBarrier xbar = xcd_barrier_post((unsigned*)(ws + WS_BAR), xst);
    float* const ROPE = (float*)(dout + DO_ROPE);

    if (IN(0)) RPT(0) {
        LAS float* scr = (LAS float*)(lds + wid * 8448);
        constexpr int I_WIN = 16 * 216, I_XKV = 16 * 64, I_W1 = 32 * 8, I_W2 = 4 * 2, I_WOUT = 16 * 32;
        constexpr int NIT = I_WIN + I_XKV + 2 * I_W1 + 2 * I_W2 + I_WOUT;
        for (int it = gw; it < NIT; it += NGW) { int r = it;
            if (r < I_WIN) { tr_item(a.in[5], 1024, 6704, 6912, (bf16_t*)(dout + DO_WIN_T), scr, r, lane); continue; } r -= I_WIN;
            if (r < I_XKV) { tr_item(a.in[24], 1024, 2048, 2048, (bf16_t*)(dout + DO_WXKV_T), scr, r, lane); continue; } r -= I_XKV;
            if (r < I_W1) { tr_item(a.in[11], 2048, 256, 256, (bf16_t*)(dout + DO_W1KT), scr, r, lane); continue; } r -= I_W1;
            if (r < I_W1) { tr_item(a.in[16], 2048, 256, 256, (bf16_t*)(dout + DO_W1VT), scr, r, lane); continue; } r -= I_W1;
            if (r < I_W2) { tr_item(a.in[13], 256, 64, 64, (bf16_t*)(ws + WS_W2KT), scr, r, lane); continue; } r -= I_W2;
            if (r < I_W2) { tr_item(a.in[18], 256, 64, 64, (bf16_t*)(ws + WS_W2VT), scr, r, lane); continue; } r -= I_W2;
            tr_item(a.in[20], 1024, 1024, 1024, (bf16_t*)(ws + WS_WOUT_T), scr, r, lane);
        }
        for (int m = gw; m < T; m += NGW) { f32x4 v[4]; row_load(v, a.in[0] + (size_t)m * D, lane); ln_apply(v, a.in[3], a.in[4], lane); row_store_bf16(v, (bf16_t*)(dout + DO_H0B) + (size_t)m * D, lane); }
        for (int i = gtid; i < 512 * 1024 / 4; i += NGT) { const f32x4 v = *(const f32x4*)(a.in[1] + 4 * (size_t)i); u32x2 w; w.x = pk2(v.x, v.y); w.y = pk2(v.z, v.w); *(u32x2*)((bf16_t*)(dout + DO_MEMB) + 4 * (size_t)i) = w; }
        for (int i = gtid; i < T * 8; i += NGT) { const int tok = i >> 3, fi = i & 7; const int pos = ((const int*)a.in[2])[tok];
            float inv = 1.0f;
            inv = fi == 1 ? 0.19392274474868576f : inv; inv = fi == 2 ? 0.03760603093086393f : inv; inv = fi == 3 ? 0.007292664737217109f : inv; inv = fi == 4 ? 0.001414213562373095f : inv;
            inv = fi == 5 ? 0.0002742481756762073f : inv; inv = fi == 6 ? 5.318295896944988e-05f : inv; inv = fi == 7 ? 1.031338537721246e-05f : inv;
            const float ang = (float)pos * inv; ROPE[tok * 16 + fi] = cosf(ang); ROPE[tok * 16 + 8 + fi] = sinf(ang); }
        for (int i = gtid; i < 8 * 128 * 128; i += NGT) { const int t = (i >> 7) & 127, s = i & 127; const float w = a.in[8][i]; ((bf16_t*)(ws + WS_WSTRIL))[i] = (bf16_t)(s <= t ? f2bf(w) : 0u); }
        for (int job = blockIdx.x; job < 64; job += G) if (tid < 256) { const int mat = job >> 5, ks = job & 31; const float* pe = a.in[mat ? 15 : 10] + ks * 64; const float* w1 = a.in[mat ? 16 : 11] + (size_t)ks * 64 * 256 + tid; float sum = 0.f;
#pragma unroll 16
            for (int k = 0; k < 64; ++k) sum += pe[k] * w1[(size_t)k * 256];
            ((float*)(ws + WS_C1P))[job * 256 + tid] = sum; }
    }
    SYNC(0);

    if (IN(1)) RPT(1) {
        { pg8::Gemm g{(const bf16_t*)(dout + DO_H0B), (const bf16_t*)(dout + DO_WIN_T), T, ZC, D, D}; pg8::StaticOrder So; So.init(T, ZC, G, (int)blockIdx.x);
          pg8::EpiBf16<0> E{Z, ZC, nullptr, 1.f}; pg8::gemm_phase<pg8::EpiBf16<0>, pg8::StaticOrder, true>(lds, g, So, E); }
        { pg8::Gemm g{(const bf16_t*)(dout + DO_MEMB), (const bf16_t*)(dout + DO_WXKV_T), 512, 2048, D, D}; pg8::StaticOrder So; So.init(512, 2048, G, (G - 1) - (int)blockIdx.x);
          pg8::EpiBf16<0> E{(bf16_t*)(dout + DO_XKV), 2048, nullptr, 1.f}; pg8::gemm_phase<pg8::EpiBf16<0>, pg8::StaticOrder, true>(lds, g, So, E); }
    }
    SYNC(1);

    if (IN(2)) RPT(2) {
        bf16_t* const KCMPT = (bf16_t*)(ws + WS_KCMPT); bf16_t* const VCMPT = (bf16_t*)(ws + WS_VCMPT);
        for (int tok = gw; tok < T; tok += NGW) {
            bf16_t* zr = Z + (size_t)tok * ZC; const int b = tok >> 13, t = tok & 8191;
            float rc[8], rs[8];
            { const f32x4 c0 = *(const f32x4*)(ROPE + tok * 16), c1 = *(const f32x4*)(ROPE + tok * 16 + 4), s0 = *(const f32x4*)(ROPE + tok * 16 + 8), s1 = *(const f32x4*)(ROPE + tok * 16 + 12);
#pragma unroll
              for (int e = 0; e < 4; ++e) { rc[e] = c0[e]; rc[4 + e] = c1[e]; rs[e] = s0[e]; rs[4 + e] = s1[e]; } }
            { const u32x4 w0 = *(const u32x4*)(zr + C_V + 16 * lane), w1 = *(const u32x4*)(zr + C_V + 16 * lane + 8); float f[16];
#pragma unroll
              for (int e = 0; e < 4; ++e) { f[2 * e] = bflo(w0[e]); f[2 * e + 1] = bfhi(w0[e]); f[8 + 2 * e] = bflo(w1[e]); f[8 + 2 * e + 1] = bfhi(w1[e]); }
              float s = 0.f;
#pragma unroll
              for (int e = 0; e < 16; ++e) { f[e] = gelu_t(f[e]); s += f[e]; }
              const float mean = wave_sum(s) * (1.f / 1024.f); float s2 = 0.f;
#pragma unroll
              for (int e = 0; e < 16; ++e) { f[e] -= mean; s2 += f[e] * f[e]; }
              const float rstd = 1.f / sqrtf(wave_sum(s2) * (1.f / 1024.f) + LN_EPS);
              const float* gg = a.in[6] + 16 * lane; const float* bb = a.in[7] + 16 * lane; u32x4 o0, o1;
#pragma unroll
              for (int e = 0; e < 4; ++e) { o0[e] = pk2(f[2 * e] * rstd * gg[2 * e] + bb[2 * e], f[2 * e + 1] * rstd * gg[2 * e + 1] + bb[2 * e + 1]);
                                            o1[e] = pk2(f[8 + 2 * e] * rstd * gg[8 + 2 * e] + bb[8 + 2 * e], f[9 + 2 * e] * rstd * gg[9 + 2 * e] + bb[9 + 2 * e]); }
              *(u32x4*)(zr + C_V + 16 * lane) = o0; *(u32x4*)(zr + C_V + 16 * lane + 8) = o1; }
            { const u32x4 w0 = *(const u32x4*)(zr + C_Q + 16 * lane), w1 = *(const u32x4*)(zr + C_Q + 16 * lane + 8); float f[16];
#pragma unroll
              for (int e = 0; e < 4; ++e) { f[2 * e] = bflo(w0[e]); f[2 * e + 1] = bfhi(w0[e]); f[8 + 2 * e] = bflo(w1[e]); f[8 + 2 * e + 1] = bfhi(w1[e]); }
              if ((lane & 3) == 0) {
#pragma unroll
                  for (int i = 0; i < 8; ++i) { const float x1 = f[i], x2 = f[8 + i]; f[i] = x1 * rc[i] - x2 * rs[i]; f[8 + i] = x2 * rc[i] + x1 * rs[i]; } }
              u32x4 o0, o1;
#pragma unroll
              for (int e = 0; e < 4; ++e) { o0[e] = pk2(f[2 * e] * QSCALE, f[2 * e + 1] * QSCALE); o1[e] = pk2(f[8 + 2 * e] * QSCALE, f[9 + 2 * e] * QSCALE); }
              *(u32x4*)(zr + C_Q + 16 * lane) = o0; *(u32x4*)(zr + C_Q + 16 * lane + 8) = o1; }
            { const int h = lane >> 4, r = lane & 15; const size_t bh = (size_t)(b * 4 + h);
              const f32x4 rcl = *(const f32x4*)(ROPE + tok * 16 + 4 * (r & 1)), rsl = *(const f32x4*)(ROPE + tok * 16 + 8 + 4 * (r & 1));
#pragma unroll
              for (int sg = 0; sg < 6; ++sg) {
                  const u32x2 w = *(const u32x2*)(zr + C_KCMP + sg * 256 + 4 * lane);
                  if (sg == 0) *(u32x2*)(KCMPT + (bh * 8192 + t) * 64 + 4 * r) = w;
                  else if (sg == 1) *(u32x2*)(VCMPT + (bh * 8192 + t) * 64 + 4 * r) = w;
                  else if (sg == 2 || sg == 4) {
                      float x[4] = {bflo(w.x), bfhi(w.x), bflo(w.y), bfhi(w.y)}; float y[4];
#pragma unroll
                      for (int e = 0; e < 4; ++e) { const float other = __shfl_xor(x[e], 2); const float c = rcl[e], sn = rsl[e];
                          y[e] = (r < 2) ? (x[e] * c - other * sn) : ((r < 4) ? (x[e] * c + other * sn) : x[e]); }
                      u32x2 o; o.x = pk2(y[0], y[1]); o.y = pk2(y[2], y[3]); *(u32x2*)(zr + C_KCMP + sg * 256 + 4 * lane) = o;
                  }
              } }
        }
        if (gtid < 512) { const int mat = gtid >> 8, col = gtid & 255; float sum = a.in[mat ? 17 : 12][col];
            for (int ks = 0; ks < 32; ++ks) sum += ((const float*)(ws + WS_C1P))[(mat * 32 + ks) * 256 + col];
            ((float*)(ws + WS_C1))[gtid] = sum; }
        for (int i = gtid; i < 512 * 128; i += NGT) { const int mrow = i >> 7, cgp = i & 127; const u32x4 w = *(const u32x4*)((const bf16_t*)(dout + DO_XKV) + (size_t)mrow * 2048 + 1024 + 8 * cgp);
            bf16_t* p = (bf16_t*)(dout + DO_XVT) + ((size_t)((mrow >> 8) * 1024 + 8 * cgp)) * 256 + (mrow & 255);
#pragma unroll
            for (int e = 0; e < 4; ++e) { p[(2 * e) * 256] = (bf16_t)(w[e] & 0xffffu); p[(2 * e + 1) * 256] = (bf16_t)(w[e] >> 16); } }
    }
    SYNC(2);

    if (IN(3)) RPT(3) {
        const bf16_t* WSTRIL = (const bf16_t*)(ws + WS_WSTRIL);
        for (int un = blockIdx.x; un < 1024; un += G) {
            const int chunk = un >> 3, g = un & 7; const size_t tokbase = (size_t)chunk * 128;
            LAS bf16_t* vT = (LAS bf16_t*)lds;
#pragma unroll
            for (int i = 0; i < 4; ++i) { const int p = tid + 512 * i, s = p >> 4, c0 = (p & 15) * 8; const u32x4 w = *(const u32x4*)(Z + (tokbase + s) * ZC + C_V + g * 128 + c0);
#pragma unroll
                for (int e = 0; e < 4; ++e) { vT[(c0 + 2 * e) * 136 + s] = (bf16_t)(w[e] & 0xffffu); vT[(c0 + 2 * e + 1) * 136 + s] = (bf16_t)(w[e] >> 16); } }
            __syncthreads();
            const int j = lane & 15, q4 = lane >> 4, t = 16 * wid + j;
            f32x4 acc[8];
#pragma unroll
            for (int it = 0; it < 8; ++it) acc[it] = (f32x4){0.f, 0.f, 0.f, 0.f};
            const int nks = (16 * wid + 15) / 32 + 1;
            for (int ks = 0; ks < nks; ++ks) { const bf16x8 wf = *(const bf16x8*)(WSTRIL + (size_t)g * 16384 + t * 128 + 32 * ks + 8 * q4);
#pragma unroll
                for (int it = 0; it < 8; ++it) { const bf16x8 vf = *(const LAS bf16x8*)(vT + (16 * it + j) * 136 + 32 * ks + 8 * q4); acc[it] = MFMA16(vf, wf, acc[it]); } }
            const float bsv = a.in[9][g * 128 + t]; bf16_t* zr = Z + (tokbase + t) * ZC;
#pragma unroll
            for (int it = 0; it < 8; ++it) { const int c = g * 128 + 16 * it + 4 * q4; const u32x2 uw = *(const u32x2*)(zr + C_U + c), gaw = *(const u32x2*)(zr + C_GA + c);
                const float u0 = bflo(uw.x), u1 = bfhi(uw.x), u2 = bflo(uw.y), u3 = bfhi(uw.y), g0 = bflo(gaw.x), g1 = bfhi(gaw.x), g2 = bflo(gaw.y), g3 = bfhi(gaw.y);
                u32x2 o; o.x = pk2(gelu_t(u0) * (acc[it][0] + bsv) * sigm(g0), gelu_t(u1) * (acc[it][1] + bsv) * sigm(g1)); o.y = pk2(gelu_t(u2) * (acc[it][2] + bsv) * sigm(g2), gelu_t(u3) * (acc[it][3] + bsv) * sigm(g3));
                *(u32x2*)(zr + C_U + c) = o; }
            __syncthreads();
        }
        { pg8::Gemm g{(const bf16_t*)(ws + WS_KCMPT), (const bf16_t*)(dout + DO_W1KT), 4096, 256, 2048, 1024}; pg8::StaticOrder So; So.init(4096, 256, G, (int)blockIdx.x);
          pg8::EpiBf16<2> E{(bf16_t*)(ws + WS_HDNK), 256, (const float*)(ws + WS_C1), 1.f}; pg8::gemm_phase<pg8::EpiBf16<2>, pg8::StaticOrder, true>(lds, g, So, E); }
        { pg8::Gemm g{(const bf16_t*)(ws + WS_VCMPT), (const bf16_t*)(dout + DO_W1VT), 4096, 256, 2048, 1024}; pg8::StaticOrder So; So.init(4096, 256, G, (G - 1) - (int)blockIdx.x);
          pg8::EpiBf16<2> E{(bf16_t*)(ws + WS_HDNV), 256, (const float*)(ws + WS_C1) + 256, 1.f}; pg8::gemm_phase<pg8::EpiBf16<2>, pg8::StaticOrder, true>(lds, g, So, E); }
    }
    SYNC(3);

    if (IN(4)) RPT(4) {
        for (int u = gw; u < 512; u += NGW) {
            const int mat = u >> 8, r0 = (u & 255) * 16, j = lane & 15, q4 = lane >> 4;
            const bf16_t* HDN = (const bf16_t*)(ws + (mat ? WS_HDNV : WS_HDNK)); const bf16_t* W2T = (const bf16_t*)(ws + (mat ? WS_W2VT : WS_W2KT)); const float* b2 = a.in[mat ? 19 : 14];
            f32x4 acc[4];
#pragma unroll
            for (int it = 0; it < 4; ++it) acc[it] = (f32x4){0.f, 0.f, 0.f, 0.f};
#pragma unroll
            for (int ks = 0; ks < 8; ++ks) { const bf16x8 hb = *(const bf16x8*)(HDN + (size_t)(r0 + j) * 256 + 32 * ks + 8 * q4);
#pragma unroll
                for (int it = 0; it < 4; ++it) { const bf16x8 wf = *(const bf16x8*)(W2T + (16 * it + j) * 256 + 32 * ks + 8 * q4); acc[it] = MFMA16(wf, hb, acc[it]); } }
            const int r = r0 + j, bh = r >> 9, n = r & 511, b = bh >> 2;
#pragma unroll
            for (int it = 0; it < 4; ++it) { const f32x4 bv = *(const f32x4*)(b2 + 16 * it + 4 * q4); acc[it] = acc[it] + bv; }
            if (mat == 0) {
                const int pt = 16 * n + 31; const float* rt = ROPE + (size_t)(b * 8192 + (pt < 8192 ? pt : 8191)) * 16;
#pragma unroll
                for (int e = 0; e < 4; ++e) { const float x = acc[0][e], other = __shfl_xor(x, 32); const int fi = 4 * (q4 & 1) + e; const float c = rt[fi], sn = rt[8 + fi];
                    acc[0][e] = (q4 < 2) ? (x * c - other * sn) : (x * c + other * sn); }
#pragma unroll
                for (int it = 0; it < 4; ++it) { u32x2 o; o.x = pk2(acc[it][0], acc[it][1]); o.y = pk2(acc[it][2], acc[it][3]); if (n == 511) { o.x = 0u; o.y = 0u; }
                    *(u32x2*)((bf16_t*)(ws + WS_KC) + (size_t)r * 64 + 16 * it + 4 * q4) = o; }
            } else {
#pragma unroll
                for (int it = 0; it < 4; ++it) { u32x2 o; o.x = pk2(acc[it][0], acc[it][1]); o.y = pk2(acc[it][2], acc[it][3]); if (n == 511) { o.x = 0u; o.y = 0u; }
                    *(u32x2*)((bf16_t*)(ws + WS_VCT) + (size_t)r * 64 + 16 * it + 4 * q4) = o; }
            }
        }
    }
    SYNC(4);

    if (IN(5)) RPT(5) {
        const bf16_t* KC = (const bf16_t*)(ws + WS_KC); const bf16_t* VC = (const bf16_t*)(ws + WS_VCT);
        bf16_t* MIX = (bf16_t*)(dout + DO_MIX);
        LAS float* wl = (LAS float*)(lds + 65536 + wid * 4352);
        LAS unsigned* wgum = (LAS unsigned*)(lds + 65536 + 8 * 4352);
        LAS unsigned char* blist = (LAS unsigned char*)(wgum + 8);
        const int j = lane & 15, q4 = lane >> 4, tk = j >> 2, hd = j & 3;
        const int drow = 8 * wid + (lane >> 3), dch = (lane & 7) ^ (lane >> 3);
        const unsigned ldsb = (unsigned)(uintptr_t)lds;
        const unsigned kadr0 = (unsigned)(j * 128 + ((q4 ^ (j & 7)) << 4)), kadr1 = (unsigned)(j * 128 + (((4 + q4) ^ (j & 7)) << 4));
        const int vrow = 4 * q4 + (j >> 2);
        unsigned vadr[4];
#pragma unroll
        for (int dt = 0; dt < 4; ++dt) vadr[dt] = ldsb + 8192u + (unsigned)(vrow * 128 + (((2 * dt + ((lane & 3) >> 1)) ^ (vrow & 7)) << 4) + 8 * (lane & 1));
#define DMA16(g, l) __builtin_amdgcn_global_load_lds((const unsigned*)(g), (LAS unsigned*)(l), 16, 0, 0)
#define ISSUE(nn, KROW0, VROW0, PITCH) do { const int sl_ = (nn) & 3; DMA16((KROW0) + (size_t)drow * (PITCH) + dch * 8, lds + sl_ * 16384 + wid * 1024); \
            DMA16((VROW0) + (size_t)drow * (PITCH) + dch * 8, lds + sl_ * 16384 + 8192 + wid * 1024); } while (0)
#define WAITV(n) asm volatile("s_waitcnt vmcnt(" #n ")" ::: "memory")
#define PIPE_WAIT(n, nb) do { const int rem_ = (nb) - 1 - (n); if (rem_ >= 2) WAITV(4); else if (rem_ == 1) WAITV(2); else WAITV(0); __builtin_amdgcn_s_barrier(); asm volatile("" ::: "memory"); } while (0)
#define QK_LDS(slot, hf, s0, s1) do { const LAS unsigned char* p_ = lds + (slot) * 16384 + (hf) * 4096; const f32x4 z_ = {0.f, 0.f, 0.f, 0.f}; \
            const bf16x8 k00_ = *(const LAS bf16x8*)(p_ + kadr0), k01_ = *(const LAS bf16x8*)(p_ + kadr1), k10_ = *(const LAS bf16x8*)(p_ + 2048 + kadr0), k11_ = *(const LAS bf16x8*)(p_ + 2048 + kadr1); \
            s0 = MFMA16(k00_, qf0, z_); s0 = MFMA16(k01_, qf1, s0); s1 = MFMA16(k10_, qf0, z_); s1 = MFMA16(k11_, qf1, s1); } while (0)
#define PV_LDS(slot, hf, pb, o) do { const unsigned b_ = (unsigned)((slot) * 16384 + (hf) * 4096); const unsigned a0_ = vadr[0] + b_, a1_ = vadr[1] + b_, a2_ = vadr[2] + b_, a3_ = vadr[3] + b_; \
            u32x2 l0_, h0_, l1_, h1_, l2_, h2_, l3_, h3_; \
            asm volatile("ds_read_b64_tr_b16 %0, %8\n\tds_read_b64_tr_b16 %1, %8 offset:2048\n\tds_read_b64_tr_b16 %2, %9\n\tds_read_b64_tr_b16 %3, %9 offset:2048\n\t" \
                         "ds_read_b64_tr_b16 %4, %10\n\tds_read_b64_tr_b16 %5, %10 offset:2048\n\tds_read_b64_tr_b16 %6, %11\n\tds_read_b64_tr_b16 %7, %11 offset:2048\n\ts_waitcnt lgkmcnt(0)" \
                         : "=&v"(l0_), "=&v"(h0_), "=&v"(l1_), "=&v"(h1_), "=&v"(l2_), "=&v"(h2_), "=&v"(l3_), "=&v"(h3_) : "v"(a0_), "v"(a1_), "v"(a2_), "v"(a3_) : "memory"); \
            { u32x4 w_; w_.x = l0_.x; w_.y = l0_.y; w_.z = h0_.x; w_.w = h0_.y; o[0] = MFMA16(__builtin_bit_cast(bf16x8, w_), pb, o[0]); } \
            { u32x4 w_; w_.x = l1_.x; w_.y = l1_.y; w_.z = h1_.x; w_.w = h1_.y; o[1] = MFMA16(__builtin_bit_cast(bf16x8, w_), pb, o[1]); } \
            { u32x4 w_; w_.x = l2_.x; w_.y = l2_.y; w_.z = h2_.x; w_.w = h2_.y; o[2] = MFMA16(__builtin_bit_cast(bf16x8, w_), pb, o[2]); } \
            { u32x4 w_; w_.x = l3_.x; w_.y = l3_.y; w_.z = h3_.x; w_.w = h3_.y; o[3] = MFMA16(__builtin_bit_cast(bf16x8, w_), pb, o[3]); } } while (0)
#define MK8(lo, hi) __builtin_bit_cast(bf16x8, (u32x4){(lo).x, (lo).y, (hi).x, (hi).y})
#define BLOCK64(slot, vm, m, l, o) do { const LAS unsigned char* p_ = lds + (slot) * 16384; const f32x4 z_ = {0.f, 0.f, 0.f, 0.f}; f32x4 s_[4]; \
            { const bf16x8 ka_ = *(const LAS bf16x8*)(p_ + kadr0), kb_ = *(const LAS bf16x8*)(p_ + kadr1), kc_ = *(const LAS bf16x8*)(p_ + 2048 + kadr0), kd_ = *(const LAS bf16x8*)(p_ + 2048 + kadr1); \
              const bf16x8 ke_ = *(const LAS bf16x8*)(p_ + 4096 + kadr0), kf_ = *(const LAS bf16x8*)(p_ + 4096 + kadr1), kg_ = *(const LAS bf16x8*)(p_ + 6144 + kadr0), kh_ = *(const LAS bf16x8*)(p_ + 6144 + kadr1); \
              s_[0] = MFMA16(ka_, qf0, z_); s_[1] = MFMA16(kc_, qf0, z_); s_[2] = MFMA16(ke_, qf0, z_); s_[3] = MFMA16(kg_, qf0, z_); \
              s_[0] = MFMA16(kb_, qf1, s_[0]); s_[1] = MFMA16(kd_, qf1, s_[1]); s_[2] = MFMA16(kf_, qf1, s_[2]); s_[3] = MFMA16(kh_, qf1, s_[3]); } \
            const unsigned b_ = (unsigned)((slot) * 16384); const unsigned a0_ = vadr[0] + b_, a1_ = vadr[1] + b_, a2_ = vadr[2] + b_, a3_ = vadr[3] + b_; \
            u32x2 v0_, v1_, v2_, v3_, v4_, v5_, v6_, v7_, v8_, v9_, v10_, v11_, v12_, v13_, v14_, v15_; \
            asm volatile("ds_read_b64_tr_b16 %0, %16\n\tds_read_b64_tr_b16 %1, %16 offset:2048\n\tds_read_b64_tr_b16 %2, %17\n\tds_read_b64_tr_b16 %3, %17 offset:2048\n\t" \
                         "ds_read_b64_tr_b16 %4, %18\n\tds_read_b64_tr_b16 %5, %18 offset:2048\n\tds_read_b64_tr_b16 %6, %19\n\tds_read_b64_tr_b16 %7, %19 offset:2048\n\t" \
                         "ds_read_b64_tr_b16 %8, %16 offset:4096\n\tds_read_b64_tr_b16 %9, %16 offset:6144\n\tds_read_b64_tr_b16 %10, %17 offset:4096\n\tds_read_b64_tr_b16 %11, %17 offset:6144\n\t" \
                         "ds_read_b64_tr_b16 %12, %18 offset:4096\n\tds_read_b64_tr_b16 %13, %18 offset:6144\n\tds_read_b64_tr_b16 %14, %19 offset:4096\n\tds_read_b64_tr_b16 %15, %19 offset:6144\n\ts_waitcnt lgkmcnt(0)" \
                         : "=&v"(v0_), "=&v"(v1_), "=&v"(v2_), "=&v"(v3_), "=&v"(v4_), "=&v"(v5_), "=&v"(v6_), "=&v"(v7_), "=&v"(v8_), "=&v"(v9_), "=&v"(v10_), "=&v"(v11_), "=&v"(v12_), "=&v"(v13_), "=&v"(v14_), "=&v"(v15_) \
                         : "v"(a0_), "v"(a1_), "v"(a2_), "v"(a3_) : "memory"); \
            bf16x8 pb0_, pb1_; osm_step64(s_, vm, m, l, o, pb0_, pb1_); \
            o[0] = MFMA16(MK8(v0_, v1_), pb0_, o[0]); o[1] = MFMA16(MK8(v2_, v3_), pb0_, o[1]); o[2] = MFMA16(MK8(v4_, v5_), pb0_, o[2]); o[3] = MFMA16(MK8(v6_, v7_), pb0_, o[3]); \
            o[0] = MFMA16(MK8(v8_, v9_), pb1_, o[0]); o[1] = MFMA16(MK8(v10_, v11_), pb1_, o[1]); o[2] = MFMA16(MK8(v12_, v13_), pb1_, o[2]); o[3] = MFMA16(MK8(v14_, v15_), pb1_, o[3]); } while (0)
        for (int uu = blockIdx.x; uu < 2048; uu += G) {
            const int bhu = uu >> 8; int tb = uu & 255; if (bhu & 1) tb = 255 - tb;
            const int b = bhu >> 2, kvh = bhu & 3, t0w = 32 * tb, t0 = t0w + 4 * wid, t = t0 + tk; const size_t tok = (size_t)b * S + t, bh = (size_t)bhu;
            const bf16_t* zr = Z + tok * ZC; const int head = kvh * 4 + hd;
            const bf16x8 qf0 = *(const bf16x8*)(zr + C_Q + head * 64 + 8 * q4), qf1 = *(const bf16x8*)(zr + C_Q + head * 64 + 32 + 8 * q4);
            for (int i = lane; i < 1040; i += 64) wl[i] = 0.f;
            if (tid < 8) wgum[tid] = 0u;
            const float gcm = sigm(bf1(zr[C_GN + head * 3 + 0])), gsl = sigm(bf1(zr[C_GN + head * 3 + 1])), gwn = sigm(bf1(zr[C_GN + head * 3 + 2]));
            f32x4 yb[4];
#pragma unroll
            for (int dt = 0; dt < 4; ++dt) yb[dt] = (f32x4){0.f, 0.f, 0.f, 0.f};
            __syncthreads();
            const int ncw = (t0w + 31 >= 31) ? (((t0w + 31 - 31) >> 4) + 1) : 0;
            const int ncmax = (t0 + 3 >= 31) ? (((t0 + 3 - 31) >> 4) + 1) : 0;
            const int nvalid = (t >= 31) ? (((t - 31) >> 4) + 1) : 0;
            const int nb_c = (ncw + 63) >> 6;
            {
                float m = -1e30f, l = 0.f;
                const bf16_t* kcb = KC + bh * 512 * 64; const bf16_t* vcb = VC + bh * 512 * 64;
                WAITV(0);
                for (int pre = 0; pre < 3 && pre < nb_c; ++pre) ISSUE(pre, kcb + (size_t)pre * 4096, vcb + (size_t)pre * 4096, 64);
                for (int n = 0; n < nb_c; ++n) { const int slot = n & 3; PIPE_WAIT(n, nb_c); if (n + 3 < nb_c) ISSUE(n + 3, kcb + (size_t)(n + 3) * 4096, vcb + (size_t)(n + 3) * 4096, 64);
#pragma unroll
                    for (int hf = 0; hf < 2; ++hf) { const int kb = 64 * n + 32 * hf; if (kb < ncmax) { f32x4 s0, s1; QK_LDS(slot, hf, s0, s1);
                        float mx = -1e30f;
#pragma unroll
                        for (int e = 0; e < 4; ++e) { if (kb + 4 * q4 + e < nvalid) mx = fmaxf(mx, s0[e]); if (kb + 16 + 4 * q4 + e < nvalid) mx = fmaxf(mx, s1[e]); }
                        mx = fmaxf(mx, __shfl_xor(mx, 16)); mx = fmaxf(mx, __shfl_xor(mx, 32));
                        const float mn = fmaxf(m, mx); float ps = 0.f;
#pragma unroll
                        for (int e = 0; e < 4; ++e) { if (kb + 4 * q4 + e < nvalid) ps += __builtin_amdgcn_exp2f(s0[e] - mn); if (kb + 16 + 4 * q4 + e < nvalid) ps += __builtin_amdgcn_exp2f(s1[e] - mn); }
                        l = l * __builtin_amdgcn_exp2f(m - mn) + ps; m = mn; } } }
                l += __shfl_xor(l, 16); l += __shfl_xor(l, 32);
                const float invl = l > 0.f ? 1.f / l : 0.f;
                f32x4 o[4];
#pragma unroll
                for (int dt = 0; dt < 4; ++dt) o[dt] = (f32x4){0.f, 0.f, 0.f, 0.f};
                WAITV(0); __builtin_amdgcn_s_barrier();
                for (int pre = 0; pre < 3 && pre < nb_c; ++pre) ISSUE(pre, kcb + (size_t)pre * 4096, vcb + (size_t)pre * 4096, 64);
                for (int n = 0; n < nb_c; ++n) { const int slot = n & 3; PIPE_WAIT(n, nb_c); if (n + 3 < nb_c) ISSUE(n + 3, kcb + (size_t)(n + 3) * 4096, vcb + (size_t)(n + 3) * 4096, 64);
#pragma unroll
                    for (int hf = 0; hf < 2; ++hf) { const int kb = 64 * n + 32 * hf; if (kb < ncmax) { f32x4 s0, s1; QK_LDS(slot, hf, s0, s1);
                        float p[8];
#pragma unroll
                        for (int e = 0; e < 4; ++e) { p[e] = (kb + 4 * q4 + e < nvalid) ? __builtin_amdgcn_exp2f(s0[e] - m) * invl : 0.f; p[4 + e] = (kb + 16 + 4 * q4 + e < nvalid) ? __builtin_amdgcn_exp2f(s1[e] - m) * invl : 0.f; }
                        float a0 = (p[0] + p[1]) + (p[2] + p[3]), a1 = (p[4] + p[5]) + (p[6] + p[7]), x0 = p[3], x1 = p[7];
                        a0 += dpp_xor1(a0); a0 += dpp_xor2(a0); a1 += dpp_xor1(a1); a1 += dpp_xor2(a1);
                        x0 += dpp_xor1(x0); x0 += dpp_xor2(x0); x1 += dpp_xor1(x1); x1 += dpp_xor2(x1);
                        if (hd == 0) { const int jj0 = (kb >> 2) + q4, jj1 = jj0 + 4; wl[tk * 128 + jj0] = a0; wl[tk * 128 + jj1] = a1; wl[512 + tk * 132 + jj0 + 1] = x0; wl[512 + tk * 132 + jj1 + 1] = x1; }
                        const bf16x8 pb = pack_p(p); PV_LDS(slot, hf, pb, o); } } }
#pragma unroll
                for (int dt = 0; dt < 4; ++dt) yb[dt] = yb[dt] + o[dt] * gcm;
            }
            LDS_WAIT();
            unsigned mysel[4], um[4];
            {
                const int tk2 = lane >> 4, r = lane & 15, cur = t0 >> 6;
                float val[8];
#pragma unroll
                for (int mm = 0; mm < 8; ++mm) { const int jj = r + 16 * mm; const float pvv = wl[tk2 * 128 + jj] + wl[512 + tk2 * 132 + jj];
                    const bool forced = (jj == 0) | (jj == cur) | (jj == cur - 1);
                    val[mm] = forced ? __builtin_inff() : (jj <= cur ? pvv : -__builtin_inff()); }
                LDS_WAIT();
#pragma unroll
                for (int mm = 0; mm < 8; ++mm) wl[tk2 * 128 + r + 16 * mm] = val[mm];
                LDS_WAIT();
                int rank[8];
#pragma unroll
                for (int mm = 0; mm < 8; ++mm) rank[mm] = 0;
                for (int jp = 0; jp <= cur; ++jp) { const float vp = wl[tk2 * 128 + jp];
#pragma unroll
                    for (int mm = 0; mm < 8; ++mm) rank[mm] += ((vp > val[mm]) || (vp == val[mm] && jp < r + 16 * mm)) ? 1 : 0; }
                unsigned long long bm[8];
#pragma unroll
                for (int mm = 0; mm < 8; ++mm) bm[mm] = __ballot((r + 16 * mm <= cur) && rank[mm] < 16);
#pragma unroll
                for (int w = 0; w < 4; ++w) { const unsigned long long b0 = bm[2 * w], b1 = bm[2 * w + 1];
                    mysel[w] = (unsigned)((b0 >> (16 * tk)) & 0xFFFFull) | ((unsigned)((b1 >> (16 * tk)) & 0xFFFFull) << 16);
                    const unsigned u0 = (unsigned)((b0 | (b0 >> 16) | (b0 >> 32) | (b0 >> 48)) & 0xFFFFull), u1 = (unsigned)((b1 | (b1 >> 16) | (b1 >> 32) | (b1 >> 48)) & 0xFFFFull);
                    um[w] = (unsigned)__builtin_amdgcn_readfirstlane((int)(u0 | (u1 << 16))); }
                if (lane < 4) { const unsigned v = lane == 0 ? um[0] : (lane == 1 ? um[1] : (lane == 2 ? um[2] : um[3])); atomicOr((unsigned*)(wgum + lane), v); }
            }
            __syncthreads();
            if (tid < 128) { const int w = tid >> 5, bi = tid & 31; const unsigned w0 = wgum[0], w1 = wgum[1], w2 = wgum[2], w3 = wgum[3]; const unsigned word = w == 0 ? w0 : (w == 1 ? w1 : (w == 2 ? w2 : w3));
                if ((word >> bi) & 1u) { const int pos = (w > 0 ? __builtin_popcount(w0) : 0) + (w > 1 ? __builtin_popcount(w1) : 0) + (w > 2 ? __builtin_popcount(w2) : 0) + __builtin_popcount(word & ((1u << bi) - 1u)); blist[pos] = (unsigned char)tid; }
                if (tid == 0) wgum[4] = (unsigned)(__builtin_popcount(w0) + __builtin_popcount(w1) + __builtin_popcount(w2) + __builtin_popcount(w3)); }
            __syncthreads();
            {
                float m = -1e30f, l = 0.f; f32x4 o[4];
#pragma unroll
                for (int dt = 0; dt < 4; ++dt) o[dt] = (f32x4){0.f, 0.f, 0.f, 0.f};
                const int nb_s = (int)wgum[4];
                const bf16_t* ksb = Z + (size_t)b * S * ZC + C_KSLC + kvh * 64; const bf16_t* vsb = Z + (size_t)b * S * ZC + C_VSLC + kvh * 64;
                WAITV(0);
                for (int pre = 0; pre < 3 && pre < nb_s; ++pre) { const size_t ro = (size_t)(64 * (int)blist[pre]) * ZC; ISSUE(pre, ksb + ro, vsb + ro, ZC); }
                for (int n = 0; n < nb_s; ++n) { const int slot = n & 3; const int jj = blist[n]; PIPE_WAIT(n, nb_s);
                    if (n + 3 < nb_s) { const size_t ro = (size_t)(64 * (int)blist[n + 3]) * ZC; ISSUE(n + 3, ksb + ro, vsb + ro, ZC); }
                    const unsigned uw = jj < 32 ? um[0] : (jj < 64 ? um[1] : (jj < 96 ? um[2] : um[3]));
                    if ((uw >> (jj & 31)) & 1u) { const unsigned mw = jj < 32 ? mysel[0] : (jj < 64 ? mysel[1] : (jj < 96 ? mysel[2] : mysel[3])); const bool mine = (mw >> (jj & 31)) & 1u;
                        unsigned vm = mine ? 0xFFFFu : 0u;
                        if (jj >= (t0 >> 6)) { vm = 0u;
#pragma unroll
                            for (int qd = 0; qd < 4; ++qd)
#pragma unroll
                                for (int e = 0; e < 4; ++e) vm |= (mine && (64 * jj + 16 * qd + 4 * q4 + e <= t)) ? (1u << (4 * qd + e)) : 0u; }
                        BLOCK64(slot, vm, m, l, o); } }
                l += __shfl_xor(l, 16); l += __shfl_xor(l, 32); const float sc2 = (l > 0.f ? 1.f / l : 0.f) * gsl;
#pragma unroll
                for (int dt = 0; dt < 4; ++dt) yb[dt] = yb[dt] + o[dt] * sc2;
            }
            {
                float m = -1e30f, l = 0.f; f32x4 o[4];
#pragma unroll
                for (int dt = 0; dt < 4; ++dt) o[dt] = (f32x4){0.f, 0.f, 0.f, 0.f};
                const int kws = ((t0w - 511 > 0) ? (t0w - 511) : 0) & ~63; const int nb_w = ((t0w + 31 - kws) >> 6) + 1;
                const bf16_t* kwb = Z + ((size_t)b * S + kws) * ZC + C_KWIN + kvh * 64; const bf16_t* vwb = Z + ((size_t)b * S + kws) * ZC + C_VWIN + kvh * 64;
                WAITV(0); __builtin_amdgcn_s_barrier();
                for (int pre = 0; pre < 3 && pre < nb_w; ++pre) ISSUE(pre, kwb + (size_t)(64 * pre) * ZC, vwb + (size_t)(64 * pre) * ZC, ZC);
                for (int n = 0; n < nb_w; ++n) { const int slot = n & 3; PIPE_WAIT(n, nb_w);
                    if (n + 3 < nb_w) ISSUE(n + 3, kwb + (size_t)(64 * (n + 3)) * ZC, vwb + (size_t)(64 * (n + 3)) * ZC, ZC);
                    const int key0 = kws + 64 * n;
                    if (key0 + 63 >= t0 - 511 && key0 <= t0 + 3) {
                        unsigned vm = 0xFFFFu;
                        if (!(key0 + 63 <= t0 && key0 > t0 + 3 - 512)) { vm = 0u;
#pragma unroll
                            for (int qd = 0; qd < 4; ++qd)
#pragma unroll
                                for (int e = 0; e < 4; ++e) { const int kk = key0 + 16 * qd + 4 * q4 + e; vm |= (kk <= t && kk > t - 512) ? (1u << (4 * qd + e)) : 0u; } }
                        BLOCK64(slot, vm, m, l, o); } }
                l += __shfl_xor(l, 16); l += __shfl_xor(l, 32); const float sc2 = (l > 0.f ? 1.f / l : 0.f) * gwn;
#pragma unroll
                for (int dt = 0; dt < 4; ++dt) yb[dt] = yb[dt] + o[dt] * sc2;
            }
#pragma unroll
            for (int dt = 0; dt < 4; ++dt) { const int c = head * 64 + 16 * dt + 4 * q4; const u32x2 mw = *(const u32x2*)(zr + C_U + c), gw2 = *(const u32x2*)(zr + C_GB + c);
                u32x2 o2; o2.x = pk2(bflo(mw.x) + sigm(bflo(gw2.x)) * yb[dt][0], bfhi(mw.x) + sigm(bfhi(gw2.x)) * yb[dt][1]); o2.y = pk2(bflo(mw.y) + sigm(bflo(gw2.y)) * yb[dt][2], bfhi(mw.y) + sigm(bfhi(gw2.y)) * yb[dt][3]);
                *(u32x2*)(MIX + tok * 1024 + c) = o2; }
            __syncthreads();
        }
#undef DMA16
#undef ISSUE
#undef WAITV
#undef PIPE_WAIT
#undef QK_LDS
#undef PV_LDS
#undef BLOCK64
#undef MK8
    }
    SYNC(5);

    if (IN(6)) RPT(6) { pg8::Gemm g{(const bf16_t*)(dout + DO_MIX), (const bf16_t*)(ws + WS_WOUT_T), T, D, D, D}; pg8::StaticOrder So; So.init(T, D, G, (int)blockIdx.x);
        pg8::EpiF32 E{(float*)(ws + WS_ACCF), D}; pg8::gemm_phase<pg8::EpiF32, pg8::StaticOrder, true>(lds, g, So, E); }
    SYNC(6);

    if (IN(7)) RPT(7) {
        for (int m = gw; m < T; m += NGW) { f32x4 v[4], ac[4]; row_load(v, a.in[0] + (size_t)m * D, lane); row_load(ac, (const float*)(ws + WS_ACCF) + (size_t)m * D, lane); ln_apply(v, a.in[3], a.in[4], lane);
#pragma unroll
            for (int jx = 0; jx < 4; ++jx) v[jx] = v[jx] * ALPHA + ac[jx];
            ln_apply(v, a.in[21], a.in[22], lane); row_store_f32(v, (float*)(ws + WS_HF) + (size_t)m * D, lane); row_store_bf16(v, (bf16_t*)(ws + WS_HB) + (size_t)m * D, lane); }
        LAS float* scr = (LAS float*)(lds + wid * 8448);
        constexpr int I_SQ = 16 * 32, I_F1 = 16 * 128, I_F2 = 64 * 32;
        for (int it = gw; it < 2 * I_SQ + I_F1 + I_F2; it += NGW) { int r = it;
            if (r < I_SQ) { tr_item(a.in[23], 1024, 1024, 1024, (bf16_t*)(ws + WS_WXQ_T), scr, r, lane); continue; } r -= I_SQ;
            if (r < I_SQ) { tr_item(a.in[25], 1024, 1024, 1024, (bf16_t*)(ws + WS_WXO_T), scr, r, lane); continue; } r -= I_SQ;
            if (r < I_F1) { tr_item(a.in[28], 1024, 4096, 4096, (bf16_t*)(ws + WS_WFF1_T), scr, r, lane); continue; } r -= I_F1;
            tr_item(a.in[29], 4096, 1024, 1024, (bf16_t*)(ws + WS_WFF2_T), scr, r, lane); }
    }
    SYNC(7);

    if (IN(8)) RPT(8) { pg8::Gemm g{(const bf16_t*)(ws + WS_HB), (const bf16_t*)(ws + WS_WXQ_T), T, D, D, D}; pg8::StaticOrder So; So.init(T, D, G, (int)blockIdx.x);
        pg8::EpiBf16<0> E{(bf16_t*)(ws + WS_XQ), D, nullptr, XSCALE}; pg8::gemm_phase<pg8::EpiBf16<0>, pg8::StaticOrder, true>(lds, g, So, E); }
    SYNC(8);

    if (IN(9)) RPT(9) {
        const bf16_t* XQ = (const bf16_t*)(ws + WS_XQ); const bf16_t* XKV = (const bf16_t*)(dout + DO_XKV); bf16_t* XO = (bf16_t*)(ws + WS_XO);
        const int j = lane & 15, q4 = lane >> 4;
        const unsigned ldsb = (unsigned)(uintptr_t)lds;
        const unsigned kadr0 = (unsigned)(j * 128 + ((q4 ^ (j & 7)) << 4)), kadr1 = (unsigned)(j * 128 + (((4 + q4) ^ (j & 7)) << 4));
        const int vrow = 4 * q4 + (j >> 2);
        unsigned vadr4[4];
#pragma unroll
        for (int dtl = 0; dtl < 4; ++dtl) vadr4[dtl] = (unsigned)(vrow * 128 + (((2 * dtl + ((lane & 3) >> 1)) ^ (vrow & 7)) << 4) + 8 * (lane & 1));
#define WAITV(n) asm volatile("s_waitcnt vmcnt(" #n ")" ::: "memory")
#define X_ISSUE(st) do { const int st_ = (st); const int sl_ = st_ & 1; \
            if (st_ < 4) { const bf16_t* gb_ = kvb + (size_t)(64 * st_) * 2048; \
                _Pragma("unroll") for (int q_ = 0; q_ < 4; ++q_) { const int row_ = 8 * wid + (lane >> 3); const int ch_ = (lane & 7) ^ (lane >> 3); \
                    __builtin_amdgcn_global_load_lds((const unsigned*)(gb_ + (size_t)row_ * 2048 + 64 * q_ + ch_ * 8), (LAS unsigned*)(lds + sl_ * 32768 + q_ * 8192 + wid * 1024), 16, 0, 0); } } \
            else { const bf16_t* gb_ = kvb + (size_t)(64 * (st_ & 3)) * 2048 + 1024; \
                _Pragma("unroll") for (int q_ = 0; q_ < 4; ++q_) { const int row_ = 8 * wid + (lane >> 3); const int ch_ = (lane & 7) ^ (lane >> 3); \
                    __builtin_amdgcn_global_load_lds((const unsigned*)(gb_ + (size_t)row_ * 2048 + 64 * q_ + ch_ * 8), (LAS unsigned*)(lds + sl_ * 32768 + q_ * 8192 + wid * 1024), 16, 0, 0); } } } while (0)
#define X_WAIT(n) do { WAITV(0); __builtin_amdgcn_s_barrier(); asm volatile("" ::: "memory"); } while (0)
#define MK8(lo, hi) __builtin_bit_cast(bf16x8, (u32x4){(lo).x, (lo).y, (hi).x, (hi).y})
#define X_VGRP(slot, d0, pfa, pfb) do { const unsigned sb_ = (unsigned)((slot) * 32768 + ((d0) >> 2) * 8192) + ldsb; \
            const unsigned a0_ = vadr4[0] + sb_, a1_ = vadr4[1] + sb_, a2_ = vadr4[2] + sb_, a3_ = vadr4[3] + sb_; \
            u32x2 v0_, v1_, v2_, v3_, v4_, v5_, v6_, v7_, v8_, v9_, v10_, v11_, v12_, v13_, v14_, v15_; \
            asm volatile("ds_read_b64_tr_b16 %0, %16\n\tds_read_b64_tr_b16 %1, %16 offset:2048\n\tds_read_b64_tr_b16 %2, %16 offset:4096\n\tds_read_b64_tr_b16 %3, %16 offset:6144\n\t" \
                         "ds_read_b64_tr_b16 %4, %17\n\tds_read_b64_tr_b16 %5, %17 offset:2048\n\tds_read_b64_tr_b16 %6, %17 offset:4096\n\tds_read_b64_tr_b16 %7, %17 offset:6144\n\t" \
                         "ds_read_b64_tr_b16 %8, %18\n\tds_read_b64_tr_b16 %9, %18 offset:2048\n\tds_read_b64_tr_b16 %10, %18 offset:4096\n\tds_read_b64_tr_b16 %11, %18 offset:6144\n\t" \
                         "ds_read_b64_tr_b16 %12, %19\n\tds_read_b64_tr_b16 %13, %19 offset:2048\n\tds_read_b64_tr_b16 %14, %19 offset:4096\n\tds_read_b64_tr_b16 %15, %19 offset:6144\n\ts_waitcnt lgkmcnt(0)" \
                         : "=&v"(v0_), "=&v"(v1_), "=&v"(v2_), "=&v"(v3_), "=&v"(v4_), "=&v"(v5_), "=&v"(v6_), "=&v"(v7_), "=&v"(v8_), "=&v"(v9_), "=&v"(v10_), "=&v"(v11_), "=&v"(v12_), "=&v"(v13_), "=&v"(v14_), "=&v"(v15_) \
                         : "v"(a0_), "v"(a1_), "v"(a2_), "v"(a3_) : "memory"); \
            o[(d0)] = MFMA16(MK8(v0_, v1_), pfa, o[(d0)]); o[(d0)] = MFMA16(MK8(v2_, v3_), pfb, o[(d0)]); o[(d0) + 1] = MFMA16(MK8(v4_, v5_), pfa, o[(d0) + 1]); o[(d0) + 1] = MFMA16(MK8(v6_, v7_), pfb, o[(d0) + 1]); \
            o[(d0) + 2] = MFMA16(MK8(v8_, v9_), pfa, o[(d0) + 2]); o[(d0) + 2] = MFMA16(MK8(v10_, v11_), pfb, o[(d0) + 2]); o[(d0) + 3] = MFMA16(MK8(v12_, v13_), pfa, o[(d0) + 3]); o[(d0) + 3] = MFMA16(MK8(v14_, v15_), pfb, o[(d0) + 3]); } while (0)
        for (int u = blockIdx.x; u < 512; u += G) {
            const int hx = u & 3, tile = u >> 2, tok0 = 128 * tile + 16 * wid, b = tile >> 6;
            const bf16_t* kvb = XKV + (size_t)(b * 256) * 2048 + hx * 256;
            bf16x8 qf[8];
#pragma unroll
            for (int ks = 0; ks < 8; ++ks) qf[ks] = *(const bf16x8*)(XQ + (size_t)(tok0 + j) * 1024 + hx * 256 + 32 * ks + 8 * q4);
            WAITV(0); __builtin_amdgcn_s_barrier(); asm volatile("" ::: "memory");
            X_ISSUE(4); X_ISSUE(5);
            f32x4 s[16];
#pragma unroll
            for (int kt = 0; kt < 16; ++kt) { const bf16_t* kp = kvb + (size_t)(16 * kt + j) * 2048 + 8 * q4; f32x4 acc = {0.f, 0.f, 0.f, 0.f};
#pragma unroll
                for (int ks = 0; ks < 8; ++ks) acc = MFMA16(*(const bf16x8*)(kp + 32 * ks), qf[ks], acc);
                s[kt] = acc; }
            float mx = -1e30f;
#pragma unroll
            for (int kt = 0; kt < 16; ++kt) mx = fmaxf(fmaxf(mx, fmaxf(s[kt][0], s[kt][1])), fmaxf(s[kt][2], s[kt][3]));
            mx = fmaxf(mx, __shfl_xor(mx, 16)); mx = fmaxf(mx, __shfl_xor(mx, 32));
            float l = 0.f; bf16x8 pf[8];
#pragma unroll
            for (int kk = 0; kk < 8; ++kk) { float p[8];
#pragma unroll
                for (int e = 0; e < 4; ++e) { p[e] = __builtin_amdgcn_exp2f(s[2 * kk][e] - mx); p[4 + e] = __builtin_amdgcn_exp2f(s[2 * kk + 1][e] - mx); l += p[e] + p[4 + e]; }
                pf[kk] = pack_p(p); }
            l += __shfl_xor(l, 16); l += __shfl_xor(l, 32); const float invl = 1.f / l;
            f32x4 o[16];
#pragma unroll
            for (int dt = 0; dt < 16; ++dt) o[dt] = (f32x4){0.f, 0.f, 0.f, 0.f};
#pragma unroll
            for (int vb = 0; vb < 4; ++vb) {
                if (vb != 1) WAITV(0);
                __builtin_amdgcn_s_barrier(); asm volatile("" ::: "memory");
                if (vb == 1) X_ISSUE(6);
                if (vb == 2) X_ISSUE(7);
                X_VGRP(vb & 1, 0, pf[2 * vb], pf[2 * vb + 1]); X_VGRP(vb & 1, 4, pf[2 * vb], pf[2 * vb + 1]); X_VGRP(vb & 1, 8, pf[2 * vb], pf[2 * vb + 1]); X_VGRP(vb & 1, 12, pf[2 * vb], pf[2 * vb + 1]); }
#pragma unroll
            for (int dt = 0; dt < 16; ++dt) { u32x2 ow; ow.x = cvtpk(o[dt][0] * invl, o[dt][1] * invl); ow.y = cvtpk(o[dt][2] * invl, o[dt][3] * invl);
                *(u32x2*)(XO + (size_t)(tok0 + j) * 1024 + hx * 256 + 16 * dt + 4 * q4) = ow; }
        }
        WAITV(0); __syncthreads();
#undef WAITV
#undef X_ISSUE
#undef X_WAIT
#undef MK8
#undef X_VGRP
    }
    SYNC(9);

    if (IN(10)) RPT(10) { pg8::Gemm g{(const bf16_t*)(ws + WS_XO), (const bf16_t*)(ws + WS_WXO_T), T, D, D, D}; pg8::StaticOrder So; So.init(T, D, G, (int)blockIdx.x);
        pg8::EpiF32 E{(float*)(ws + WS_ACCF), D}; pg8::gemm_phase<pg8::EpiF32, pg8::StaticOrder, true>(lds, g, So, E); }
    SYNC(10);

    if (IN(11)) RPT(11) {
        for (int m = gw; m < T; m += NGW) { f32x4 v[4], ac[4]; row_load(v, (const float*)(ws + WS_HF) + (size_t)m * D, lane); row_load(ac, (const float*)(ws + WS_ACCF) + (size_t)m * D, lane);
#pragma unroll
            for (int jx = 0; jx < 4; ++jx) v[jx] = v[jx] * ALPHA + ac[jx];
            ln_apply(v, a.in[26], a.in[27], lane); row_store_f32(v, (float*)(ws + WS_HF) + (size_t)m * D, lane); row_store_bf16(v, (bf16_t*)(ws + WS_HB) + (size_t)m * D, lane); }
    }
    SYNC(11);

    if (IN(12)) RPT(12) { pg8::Gemm g{(const bf16_t*)(ws + WS_HB), (const bf16_t*)(ws + WS_WFF1_T), T, FF, D, D}; pg8::StaticOrder So; So.init(T, FF, G, (int)blockIdx.x);
        pg8::EpiBf16<3> E{(bf16_t*)(ws + WS_FFB), FF, nullptr, 1.f}; pg8::gemm_phase<pg8::EpiBf16<3>, pg8::StaticOrder, true>(lds, g, So, E); }
    SYNC(12);

    if (IN(13)) RPT(13) { pg8::Gemm g{(const bf16_t*)(ws + WS_FFB), (const bf16_t*)(ws + WS_WFF2_T), T, D, FF, FF}; pg8::StaticOrder So; So.init(T, D, G, (int)blockIdx.x);
        pg8::EpiF32 E{a.out, D}; pg8::gemm_phase<pg8::EpiF32, pg8::StaticOrder, true>(lds, g, So, E); }
    SYNC(13);

    if (IN(14)) RPT(14) {
        for (int m = gw; m < T; m += NGW) { f32x4 v[4], ac[4]; row_load(v, (const float*)(ws + WS_HF) + (size_t)m * D, lane); row_load(ac, a.out + (size_t)m * D, lane);
#pragma unroll
            for (int jx = 0; jx < 4; ++jx) v[jx] = v[jx] * ALPHA + ac[jx];
            ln_apply(v, a.in[30], a.in[31], lane); row_store_f32(v, a.out + (size_t)m * D, lane); }
    }
#undef IN
#undef SYNC
}

constexpr int NPHASE = 15;
extern "C" void kernel_launch(void* const* d_in, const int* in_sizes, int n_in, void* d_out, int out_size, void* d_ws, size_t ws_size, hipStream_t stream) {
    static int grid = 0;
    if (grid == 0) {
        if (n_in != 32 || out_size != T * D || ws_size < 256 * MiB) { fprintf(stderr, "kernel_launch: unexpected shapes (n_in %d out %d ws %zu)\n", n_in, out_size, ws_size); grid = -1; return; }
        int dev = 0, cus = 0, per_cu = 0;
        hipGetDevice(&dev); hipDeviceGetAttribute(&cus, hipDeviceAttributeMultiprocessorCount, dev);
        hipFuncSetAttribute((const void*)mk_fwd, hipFuncAttributeMaxDynamicSharedMemorySize, LDS_BYTES);
        hipOccupancyMaxActiveBlocksPerMultiprocessor(&per_cu, (const void*)mk_fwd, 512, LDS_BYTES);
        (void)hipGetLastError();
        if (per_cu < 1) fprintf(stderr, "kernel_launch: occupancy query says %d blocks per CU\n", per_cu);
        grid = cus > 0 ? cus : 256;
    }
    if (grid < 0) return;
    Args a{};
    for (int i = 0; i < 32; ++i) a.in[i] = (const float*)d_in[i];
    a.out = (float*)d_out; a.ws = (unsigned char*)d_ws; a.ph_lo = 0; a.ph_hi = NPHASE;
    (void)hipMemsetAsync((char*)d_ws + WS_BAR, 0, 16384, stream);
    void* args[] = {&a};
    hipError_t e = hipLaunchCooperativeKernel((const void*)mk_fwd, dim3(grid), dim3(512), args, LDS_BYTES, stream);
    if (e != hipSuccess) fprintf(stderr, "cooperative launch failed: %s (grid %d)\n", hipGetErrorString(e), grid);
}
```

```cpp
#include <hip/hip_runtime.h>
#include <hip/hip_cooperative_groups.h>
#include <cstdio>
#include <cstdint>
namespace cg = cooperative_groups;

#define LAS __attribute__((address_space(3)))
typedef unsigned short bf16_t;
typedef short bf16x8 __attribute__((ext_vector_type(8)));
typedef float f32x4 __attribute__((ext_vector_type(4)));
typedef float f32x2 __attribute__((ext_vector_type(2)));
typedef unsigned u32x4 __attribute__((ext_vector_type(4)));
typedef unsigned u32x2 __attribute__((ext_vector_type(2)));

__device__ __forceinline__ unsigned f2bf(float f) { unsigned u = __builtin_bit_cast(unsigned, f); return (u + 0x7fffu + ((u >> 16) & 1u)) >> 16; }
__device__ __forceinline__ unsigned pk2(float lo, float hi) { return f2bf(lo) | (f2bf(hi) << 16); }
__device__ __forceinline__ float bflo(unsigned w) { return __builtin_bit_cast(float, w << 16); }
__device__ __forceinline__ float bfhi(unsigned w) { return __builtin_bit_cast(float, w & 0xffff0000u); }
__device__ __forceinline__ float bf1(bf16_t h) { return __builtin_bit_cast(float, ((unsigned)h) << 16); }
__device__ __forceinline__ float gelu_t(float x) { const float u = x * (1.f + 0.044715f * x * x); const float e = __builtin_amdgcn_exp2f(-2.3022081986f * u); return x * __builtin_amdgcn_rcpf(1.f + e); }
__device__ __forceinline__ float sigm(float x) { return __builtin_amdgcn_rcpf(1.f + __builtin_amdgcn_exp2f(-1.4426950409f * x)); }
__device__ __forceinline__ float wave_sum(float v) {
#pragma unroll
    for (int o = 1; o < 64; o <<= 1) v += __shfl_xor(v, o);
    return v;
}
#define LDS_WAIT() asm volatile("s_waitcnt lgkmcnt(0)" ::: "memory")

namespace pg8 {
constexpr int BM = 256, BK = 64, HALF = 128, HTB = HALF * BK * 2, STAGE_BYTES = 8 * HTB, NXCD = 8, WGM = 8;
__host__ __device__ __forceinline__ int lds_byte(int r, int c) { const int st = (r >> 4) * 2 + (c >> 5), rr = r & 15, cc = c & 31, ob = rr * 64 + cc * 2; return st * 1024 + (ob ^ (((ob >> 9) & 1) << 5)); }
__host__ __device__ __forceinline__ void stage_rc(int b, int& R, int& C) { const int st = b / 1024, sb = b % 1024, swz = sb ^ (((sb >> 9) & 1) << 5); R = (st >> 1) * 16 + swz / 64; C = (st & 1) * 32 + (swz % 64) / 2; }
__host__ __device__ __forceinline__ int perm32(int rho) { const int n = rho >> 4, i = rho & 15; return 8 * (i >> 2) + 4 * n + (i & 3); }
struct Unit { int pm, pn; };
struct Gemm { const bf16_t* A; const bf16_t* Bt; int M, N, K, lda; };
struct StaticOrder {
    int nM, nN, nwg, G, c;
    __device__ void init(int M, int N, int G_, int c_) { nM = M / BM; nN = N / BM; nwg = nM * nN; G = G_; c = c_; }
    __device__ bool next(int i, Unit& u) const {
        const long L = (long)i * G + c; if (L >= nwg) return false;
        int wgid = (int)L; { const int q = nwg / NXCD, r = nwg % NXCD, xcd = wgid % NXCD, off = wgid / NXCD; wgid = (xcd < r ? xcd * (q + 1) : r * (q + 1) + (xcd - r) * q) + off; }
        const int nig = WGM * nN, gid = wgid / nig, fm = gid * WGM, gsz = (nM - fm) < WGM ? (nM - fm) : WGM;
        u.pm = fm + ((wgid % nig) % gsz); u.pn = (wgid % nig) / gsz; return true;
    }
};
__device__ __forceinline__ unsigned cvt_pk_bf16(float lo, float hi) { unsigned r; asm volatile("v_cvt_pk_bf16_f32 %0, %1, %2" : "=v"(r) : "v"(lo), "v"(hi)); return r; }

template <int ACT> struct EpiBf16 {
    static constexpr bool PERM = true;
    bf16_t* O; int ldc; const float* bias; float scale;
    __device__ __forceinline__ void operator()(const f32x4 (&acc)[2][2][4][2], const Unit& u, int wr, int wc, int fr, int fq) const {
        const int row0 = u.pm * BM + wr * 64 + fr; const int col0 = u.pn * BM + wc * 32 + 8 * fq;
        f32x4 bv[2][2];
#pragma unroll
        for (int bj = 0; bj < 2; ++bj)
#pragma unroll
            for (int n = 0; n < 2; ++n) bv[bj][n] = bias ? *(const f32x4*)(bias + col0 + bj * HALF + 4 * n) : (f32x4){0.f, 0.f, 0.f, 0.f};
#pragma unroll
        for (int ai = 0; ai < 2; ++ai)
#pragma unroll
            for (int m = 0; m < 4; ++m) { bf16_t* rowp = O + (size_t)(row0 + ai * HALF + m * 16) * ldc + col0;
#pragma unroll
                for (int bj = 0; bj < 2; ++bj) { f32x4 v0 = acc[ai][bj][m][0] + bv[bj][0], v1 = acc[ai][bj][m][1] + bv[bj][1];
                    if (ACT == 2) {
#pragma unroll
                        for (int e = 0; e < 4; ++e) { v0[e] = gelu_t(v0[e]); v1[e] = gelu_t(v1[e]); } }
                    if (ACT == 3) {
#pragma unroll
                        for (int e = 0; e < 4; ++e) { float a0 = v0[e] > 0.f ? v0[e] : 0.f, a1 = v1[e] > 0.f ? v1[e] : 0.f; v0[e] = a0 * a0; v1[e] = a1 * a1; } }
                    v0 = v0 * scale; v1 = v1 * scale; u32x4 w; w.x = cvt_pk_bf16(v0[0], v0[1]); w.y = cvt_pk_bf16(v0[2], v0[3]); w.z = cvt_pk_bf16(v1[0], v1[1]); w.w = cvt_pk_bf16(v1[2], v1[3]);
                    *(u32x4*)(rowp + bj * HALF) = w; } }
    }
};
struct EpiF32 {
    static constexpr bool PERM = false;
    float* O; int ldc;
    __device__ __forceinline__ void operator()(const f32x4 (&acc)[2][2][4][2], const Unit& u, int wr, int wc, int fr, int fq) const {
        const int row0 = u.pm * BM + wr * 64 + fr; const int col0 = u.pn * BM + wc * 32 + 4 * fq;
#pragma unroll
        for (int ai = 0; ai < 2; ++ai)
#pragma unroll
            for (int m = 0; m < 4; ++m) { float* rowp = O + (size_t)(row0 + ai * HALF + m * 16) * ldc + col0;
#pragma unroll
                for (int bj = 0; bj < 2; ++bj)
#pragma unroll
                    for (int n = 0; n < 2; ++n) *(f32x4*)(rowp + bj * HALF + n * 16) = acc[ai][bj][m][n]; }
    }
};

template <class Epi, class Sched, bool ALIGN_EPI>
__device__ __forceinline__ void gemm_phase(LAS unsigned char* lds, const Gemm g, const Sched& S, const Epi& E) {
    const int tid = threadIdx.x, wid = __builtin_amdgcn_readfirstlane(tid >> 6), lane = tid & 63, wr = wid >> 2, wc = wid & 3, fr = lane & 15, fq = lane >> 4;
    const int K = g.K, nt = K / BK, lda = g.lda;
    unsigned voffA[2], voffB[2];
#pragma unroll
    for (int i = 0; i < 2; ++i) { int R, C; stage_rc(tid * 16 + i * 8192, R, C); const int Rb = Epi::PERM ? ((R & ~31) + perm32(R & 31)) : R;
        voffA[i] = (unsigned)(R * lda + C) * 2u; voffB[i] = (unsigned)(Rb * K + C) * 2u; }
    const size_t kstep = (size_t)(BK * 2);
    const size_t hstepA = (size_t)HALF * lda * 2, hstepB = (size_t)HALF * K * 2;
    const size_t tstepA = 2 * hstepA, tstepB = 2 * hstepB;
    const unsigned ldsw = (unsigned)wid * 1024u;
    const int aoff = lds_byte(wr * 64 + fr, fq * 8), boff = lds_byte(wc * 32 + fr, fq * 8);
#define PG8_SA(b, h) (((b) * 2 + (h)) * HTB)
#define PG8_SB(b, h) ((4 + (b) * 2 + (h)) * HTB)
#define PG8_STAGE(bufoff, gbase, voff) do { _Pragma("unroll") for (int _i = 0; _i < 2; ++_i) \
        __builtin_amdgcn_global_load_lds((const unsigned*)((const char*)(gbase) + (voff)[_i]), (LAS unsigned*)(lds + (bufoff) + ldsw + _i * 8192), 16, 0, 0); } while (0)
#define PG8_LDA(dst, b, h) do { _Pragma("unroll") for (int m = 0; m < 4; ++m) _Pragma("unroll") for (int k = 0; k < 2; ++k) dst[m][k] = *(const LAS bf16x8*)(lds + PG8_SA(b, h) + aoff + m * 2048 + k * 1024); } while (0)
#define PG8_LDB(dst, b, h) do { _Pragma("unroll") for (int n = 0; n < 2; ++n) _Pragma("unroll") for (int k = 0; k < 2; ++k) dst[n][k] = *(const LAS bf16x8*)(lds + PG8_SB(b, h) + boff + n * 2048 + k * 1024); } while (0)
#define PG8_MMA(ai, bj, At, Bt) do { __builtin_amdgcn_s_setprio(1); _Pragma("unroll") for (int m = 0; m < 4; ++m) _Pragma("unroll") for (int n = 0; n < 2; ++n) _Pragma("unroll") for (int k = 0; k < 2; ++k) \
        acc[ai][bj][m][n] = __builtin_amdgcn_mfma_f32_16x16x32_bf16(Bt[n][k], At[m][k], acc[ai][bj][m][n], 0, 0, 0); __builtin_amdgcn_s_setprio(0); } while (0)
#define PG8_WAIT_V(n) asm volatile("s_waitcnt vmcnt(" #n ")" ::: "memory")
#define PG8_WAIT_L(n) asm volatile("s_waitcnt lgkmcnt(" #n ")" ::: "memory")
#define PG8_BAR __builtin_amdgcn_s_barrier()
#define PG8_SCHED __builtin_amdgcn_sched_barrier(0)
    Unit cur, nxt; int ui = 0;
    if (!S.next(0, cur)) return;
    f32x4 acc[2][2][4][2];
#pragma unroll
    for (int a = 0; a < 2; ++a)
#pragma unroll
        for (int b = 0; b < 2; ++b)
#pragma unroll
            for (int m = 0; m < 4; ++m)
#pragma unroll
                for (int n = 0; n < 2; ++n) acc[a][b][m][n] = (f32x4){0.f, 0.f, 0.f, 0.f};
    bf16x8 At[4][2], B0[2][2], B1[2][2];
    const char* cA = (const char*)g.A + (size_t)cur.pm * tstepA; const char* cB = (const char*)g.Bt + (size_t)cur.pn * tstepB;
    PG8_STAGE(PG8_SB(0, 0), cB, voffB); PG8_STAGE(PG8_SB(0, 1), cB + hstepB, voffB); PG8_STAGE(PG8_SA(0, 0), cA, voffA); PG8_STAGE(PG8_SA(0, 1), cA + hstepA, voffA);
    if (wr == 1) PG8_BAR;
    PG8_WAIT_V(2); PG8_BAR;
    PG8_STAGE(PG8_SB(1, 0), cB + kstep, voffB); PG8_STAGE(PG8_SA(1, 0), cA + kstep, voffA); PG8_STAGE(PG8_SB(1, 1), cB + hstepB + kstep, voffB);
    PG8_WAIT_V(6); PG8_BAR;
    for (;;) {
        const bool has_next = S.next(ui + 1, nxt);
        const char* nA = has_next ? (const char*)g.A + (size_t)nxt.pm * tstepA : cA; const char* nB = has_next ? (const char*)g.Bt + (size_t)nxt.pn * tstepB : cB;
        for (int t = 0; t < nt; t += 2) {
            const bool last = (t == nt - 2);
            const char* a1 = cA + (size_t)(t + 1) * kstep;
            const char* a2 = last ? nA : cA + (size_t)(t + 2) * kstep; const char* b2 = last ? nB : cB + (size_t)(t + 2) * kstep;
            const char* a3 = a2 + kstep; const char* b3 = b2 + kstep;
            PG8_LDB(B0, 0, 0); PG8_LDB(B1, 0, 1); PG8_SCHED; PG8_LDA(At, 0, 0); PG8_STAGE(PG8_SA(1, 1), a1 + hstepA, voffA);
            PG8_WAIT_V(8); PG8_WAIT_L(0); PG8_BAR; PG8_MMA(0, 0, At, B0); PG8_MMA(0, 1, At, B1); PG8_BAR; PG8_SCHED;
            PG8_LDA(At, 0, 1); PG8_STAGE(PG8_SB(0, 0), b2, voffB); PG8_STAGE(PG8_SB(0, 1), b2 + hstepB, voffB); PG8_STAGE(PG8_SA(0, 0), a2, voffA);
            PG8_WAIT_V(8); PG8_WAIT_L(0); PG8_BAR; PG8_MMA(1, 0, At, B0); PG8_MMA(1, 1, At, B1); PG8_BAR; PG8_SCHED;
            PG8_LDB(B0, 1, 0); PG8_LDB(B1, 1, 1); PG8_SCHED; PG8_LDA(At, 1, 0); PG8_STAGE(PG8_SA(0, 1), a2 + hstepA, voffA);
            PG8_WAIT_V(8); PG8_WAIT_L(0); PG8_BAR; PG8_MMA(0, 0, At, B0); PG8_MMA(0, 1, At, B1); PG8_BAR; PG8_SCHED;
            PG8_LDA(At, 1, 1); PG8_STAGE(PG8_SB(1, 0), b3, voffB); PG8_STAGE(PG8_SB(1, 1), b3 + hstepB, voffB); PG8_STAGE(PG8_SA(1, 0), a3, voffA);
            PG8_WAIT_V(8); PG8_WAIT_L(0); PG8_BAR; PG8_MMA(1, 0, At, B0); PG8_MMA(1, 1, At, B1); PG8_BAR; PG8_SCHED;
        }
        if constexpr (ALIGN_EPI) { if (wr == 0) PG8_BAR; }
        E(acc, cur, wr, wc, fr, fq);
        if (!has_next) break;
#pragma unroll
        for (int a = 0; a < 2; ++a)
#pragma unroll
            for (int b = 0; b < 2; ++b)
#pragma unroll
                for (int m = 0; m < 4; ++m)
#pragma unroll
                    for (int n = 0; n < 2; ++n) acc[a][b][m][n] = (f32x4){0.f, 0.f, 0.f, 0.f};
        cur = nxt; cA = nA; cB = nB; ++ui;
        if constexpr (ALIGN_EPI) { if (wr == 1) PG8_BAR; }
    }
    PG8_WAIT_V(0);
    if constexpr (!ALIGN_EPI) { if (wr == 0) PG8_BAR; }
    PG8_BAR;
#undef PG8_SA
#undef PG8_SB
#undef PG8_STAGE
#undef PG8_LDA
#undef PG8_LDB
#undef PG8_MMA
#undef PG8_WAIT_V
#undef PG8_WAIT_L
#undef PG8_BAR
#undef PG8_SCHED
}
}

#define XB_TMO      128
#define XB_XCNT(j)  (256  + 64 * (j))
#define XB_XSUB(j)  (1280 + 64 * (j))
#define XB_XGEN(j)  (2304 + 64 * (j))
#define XB_TOP      3328
#define XB_TOPGEN   3392
#define XCD_BAR_WORDS 3456
#define XB_SPIN_CAP (1u << 18)

__device__ __forceinline__ unsigned xb_ld(unsigned* p)              { return __hip_atomic_load(p, __ATOMIC_RELAXED, __HIP_MEMORY_SCOPE_AGENT); }
__device__ __forceinline__ unsigned xb_add(unsigned* p, unsigned v) { return __hip_atomic_fetch_add(p, v, __ATOMIC_RELAXED, __HIP_MEMORY_SCOPE_AGENT); }
__device__ __forceinline__ unsigned xb_xcc_id() { return (unsigned)__builtin_amdgcn_s_getreg((3 << 11) | 20) & 0xFu; }
#define XB_SPIN(cond, bar) do { unsigned _sp = 0; while (cond) { __builtin_amdgcn_s_sleep(1); \
    if ((++_sp & 255u) == 0u) { if (xb_ld(&(bar)[XB_TMO])) break; if (_sp > XB_SPIN_CAP) { atomicAdd(&(bar)[XB_TMO], 1u); break; } } } } while (0)

struct XcdBarrier {
    unsigned* bar; unsigned x;
    volatile LAS unsigned* st;
};

__device__ __forceinline__ XcdBarrier xcd_barrier_post(unsigned* bar, volatile LAS unsigned* st) {
    XcdBarrier b; b.bar = bar; b.x = xb_xcc_id(); b.st = st;
    if (threadIdx.x == 0) (void)xb_add(&bar[XB_XCNT(b.x)], 1u);
    return b;
}
__device__ __forceinline__ void xcd_barrier_complete(unsigned* bar, unsigned x, unsigned& nloc, unsigned& nx) {
    const unsigned G = gridDim.x * gridDim.y * gridDim.z;
    unsigned sum, cnt, mine, sp = 0u;
    for (;;) {
        sum = 0u; cnt = 0u; mine = 0u;
#pragma unroll
        for (unsigned j = 0; j < 16; ++j) { const unsigned c = xb_ld(&bar[XB_XCNT(j)]); sum += c; cnt += (c > 0u) ? 1u : 0u; mine = (j == x) ? c : mine; }
        if (sum == G) break;
        __builtin_amdgcn_s_sleep(1);
        if ((++sp & 255u) == 0u) { if (xb_ld(&bar[XB_TMO])) break; if (sp > XB_SPIN_CAP) { atomicAdd(&bar[XB_TMO], 1u); break; } }
    }
    nloc = mine > 0u ? mine : 1u; nx = cnt > 0u ? cnt : 1u;
}

__device__ __forceinline__ void xcd_barrier(const XcdBarrier& b) {
    asm volatile("s_waitcnt vmcnt(0)" ::: "memory");
    __syncthreads();
    if (threadIdx.x == 0) {
        unsigned* bar = b.bar;
        __builtin_amdgcn_s_waitcnt(0);
        unsigned nloc = b.st[0], nx = b.st[1];
        if (nloc == 0u) { xcd_barrier_complete(bar, b.x, nloc, nx); b.st[0] = nloc; b.st[1] = nx; }
        const unsigned old = xb_add(&bar[XB_XSUB(b.x)], 1u);
        const unsigned gen = old / nloc;
        if (old + 1u == (gen + 1u) * nloc) {
            __builtin_amdgcn_fence(__ATOMIC_RELEASE, "agent");
            asm volatile("s_waitcnt vmcnt(0)" ::: "memory");
            const unsigned og = xb_add(&bar[XB_TOP], 1u);
            const unsigned tg = og / nx;
            if (og + 1u == (tg + 1u) * nx) xb_add(&bar[XB_TOPGEN], 1u);
            else XB_SPIN(xb_ld(&bar[XB_TOPGEN]) == tg, bar);
            __builtin_amdgcn_fence(__ATOMIC_ACQUIRE, "agent");
            xb_add(&bar[XB_XGEN(b.x)], 1u);
            asm volatile("s_waitcnt vmcnt(0)" ::: "memory");
        } else {
            XB_SPIN(xb_ld(&bar[XB_XGEN(b.x)]) == gen, bar);
            __builtin_amdgcn_fence(__ATOMIC_ACQUIRE, "agent");
            asm volatile("s_waitcnt vmcnt(0)" ::: "memory");
        }
    }
    __syncthreads();
}


constexpr int NB = 2, S = 8192, D = 1024, T = NB * S, FF = 4096;
constexpr int ZC = 6912;
constexpr int C_U = 0, C_V = 1024, C_Q = 2048, C_KCMP = 3072, C_VCMP = 3328, C_KSLC = 3584, C_VSLC = 3840, C_KWIN = 4096, C_VWIN = 4352, C_GN = 4608, C_GA = 4656, C_GB = 5680;
constexpr float ALPHA = 1.189207115002721f;
constexpr float QSCALE = 0.125f * 1.4426950408889634f;
constexpr float XSCALE = 0.0625f * 1.4426950408889634f;
constexpr float LN_EPS = 1e-5f;
constexpr size_t MiB = 1u << 20;
constexpr size_t WS_Z = 0, WS_KCMPT = 216 * MiB, WS_VCMPT = 224 * MiB, WS_VSLCT = 232 * MiB, WS_VWINT = 240 * MiB, WS_HDNK = 248 * MiB, WS_HDNV = 250 * MiB,
                 WS_KC = 252 * MiB, WS_VCT = 252 * MiB + 512 * 1024, WS_WOUT_T = 253 * MiB, WS_C1 = 255 * MiB, WS_W2KT = 255 * MiB + 4096, WS_W2VT = 255 * MiB + 65536, WS_WSTRIL = 255 * MiB + 131072, WS_C1P = 255 * MiB + 524288, WS_BAR = 255 * MiB + 786432;
constexpr size_t WS_HF = 0, WS_HB = 64 * MiB, WS_XQ = 96 * MiB, WS_XO = 128 * MiB, WS_ACCF = 160 * MiB, WS_FFB = 96 * MiB,
                 WS_WXQ_T = 224 * MiB, WS_WXO_T = 226 * MiB, WS_WFF1_T = 228 * MiB, WS_WFF2_T = 236 * MiB;
constexpr size_t DO_H0B = 0, DO_MIX = 0, DO_WIN_T = 32 * MiB, DO_WXKV_T = 46 * MiB, DO_MEMB = 50 * MiB, DO_XKV = 51 * MiB, DO_XVT = 53 * MiB, DO_ROPE = 54 * MiB, DO_W1KT = 55 * MiB, DO_W1VT = 56 * MiB;
constexpr int LDS_BYTES = 147456;

struct Args { const float* in[32]; float* out; unsigned char* ws; int ph_lo, ph_hi; };

__device__ __forceinline__ void tr_item(const float* W, int K, int N, int Npad, bf16_t* WT, LAS float* scr, int item, int lane) {
    const int nblk = Npad / 32, kb = item / nblk, nb = item % nblk, k0 = 64 * kb, n0 = 32 * nb;
    const int cc = n0 + (lane & 31);
#pragma unroll 8
    for (int i = 0; i < 32; ++i) { const int kk = 2 * i + (lane >> 5); scr[kk * 33 + (lane & 31)] = (cc < N) ? W[(size_t)(k0 + kk) * N + cc] : 0.f; }
    LDS_WAIT();
    const int c = lane & 7;
#pragma unroll
    for (int j = 0; j < 4; ++j) { const int n = (lane >> 3) + 8 * j; const LAS float* s = scr + (8 * c) * 33 + n;
        u32x4 o; o.x = pk2(s[0 * 33], s[1 * 33]); o.y = pk2(s[2 * 33], s[3 * 33]); o.z = pk2(s[4 * 33], s[5 * 33]); o.w = pk2(s[6 * 33], s[7 * 33]);
        *(u32x4*)(WT + (size_t)(n0 + n) * K + k0 + 8 * c) = o; }
    LDS_WAIT();
}

__device__ __forceinline__ void ln_apply(f32x4 (&v)[4], const float* g, const float* b, int lane) {
    float s = 0.f;
#pragma unroll
    for (int j = 0; j < 4; ++j) s += (v[j].x + v[j].y) + (v[j].z + v[j].w);
    const float mean = wave_sum(s) * (1.f / 1024.f); float s2 = 0.f;
#pragma unroll
    for (int j = 0; j < 4; ++j) { v[j] = v[j] - mean; s2 += (v[j].x * v[j].x + v[j].y * v[j].y) + (v[j].z * v[j].z + v[j].w * v[j].w); }
    const float rstd = 1.f / sqrtf(wave_sum(s2) * (1.f / 1024.f) + LN_EPS);
#pragma unroll
    for (int j = 0; j < 4; ++j) { const f32x4 gg = *(const f32x4*)(g + 4 * lane + 256 * j), bb = *(const f32x4*)(b + 4 * lane + 256 * j); v[j] = v[j] * rstd * gg + bb; }
}
__device__ __forceinline__ void row_load(f32x4 (&v)[4], const float* p, int lane) {
#pragma unroll
    for (int j = 0; j < 4; ++j) v[j] = *(const f32x4*)(p + 4 * lane + 256 * j);
}
__device__ __forceinline__ void row_store_f32(const f32x4 (&v)[4], float* p, int lane) {
#pragma unroll
    for (int j = 0; j < 4; ++j) *(f32x4*)(p + 4 * lane + 256 * j) = v[j];
}
__device__ __forceinline__ void row_store_bf16(const f32x4 (&v)[4], bf16_t* p, int lane) {
#pragma unroll
    for (int j = 0; j < 4; ++j) { u32x2 w; w.x = pk2(v[j].x, v[j].y); w.y = pk2(v[j].z, v[j].w); *(u32x2*)(p + 4 * lane + 256 * j) = w; }
}

#define MFMA16(a, b, c) __builtin_amdgcn_mfma_f32_16x16x32_bf16((a), (b), (c), 0, 0, 0)

__device__ __forceinline__ void qk32(const bf16_t* kp, size_t t1off, bf16x8 qf0, bf16x8 qf1, f32x4& s0, f32x4& s1) {
    const bf16x8 k00 = *(const bf16x8*)(kp), k01 = *(const bf16x8*)(kp + 32), k10 = *(const bf16x8*)(kp + t1off), k11 = *(const bf16x8*)(kp + t1off + 32);
    const f32x4 z = {0.f, 0.f, 0.f, 0.f};
    s0 = MFMA16(k00, qf0, z); s0 = MFMA16(k01, qf1, s0); s1 = MFMA16(k10, qf0, z); s1 = MFMA16(k11, qf1, s1);
}
__device__ __forceinline__ void pv32(const bf16_t* vp, size_t dtoff, bf16x8 pb, f32x4 (&o)[4]) {
#pragma unroll
    for (int dt = 0; dt < 4; ++dt) { const u32x2 lo = *(const u32x2*)(vp + dt * dtoff), hi = *(const u32x2*)(vp + dt * dtoff + 16);
        u32x4 w; w.x = lo.x; w.y = lo.y; w.z = hi.x; w.w = hi.y; o[dt] = MFMA16(__builtin_bit_cast(bf16x8, w), pb, o[dt]); }
}
__device__ __forceinline__ unsigned cvtpk(float lo, float hi) { unsigned r; asm volatile("v_cvt_pk_bf16_f32 %0, %1, %2" : "=v"(r) : "v"(lo), "v"(hi)); return r; }
__device__ __forceinline__ bf16x8 pack_p(const float (&p)[8]) { u32x4 w; w.x = cvtpk(p[0], p[1]); w.y = cvtpk(p[2], p[3]); w.z = cvtpk(p[4], p[5]); w.w = cvtpk(p[6], p[7]); return __builtin_bit_cast(bf16x8, w); }
__device__ __forceinline__ float dpp_xor1(float v) { return __builtin_bit_cast(float, __builtin_amdgcn_mov_dpp(__builtin_bit_cast(int, v), 0xB1, 0xF, 0xF, true)); }
__device__ __forceinline__ float dpp_xor2(float v) { return __builtin_bit_cast(float, __builtin_amdgcn_mov_dpp(__builtin_bit_cast(int, v), 0x4E, 0xF, 0xF, true)); }
__device__ __forceinline__ bf16x8 osm_step(f32x4 s0, f32x4 s1, unsigned vm, float& m, float& l, f32x4 (&o)[4]) {
    const float NINF = -__builtin_inff();
#pragma unroll
    for (int e = 0; e < 4; ++e) { s0[e] = ((vm >> e) & 1u) ? s0[e] : NINF; s1[e] = ((vm >> (4 + e)) & 1u) ? s1[e] : NINF; }
    float mx = fmaxf(fmaxf(fmaxf(s0[0], s0[1]), fmaxf(s0[2], s0[3])), fmaxf(fmaxf(s1[0], s1[1]), fmaxf(s1[2], s1[3])));
    if (__ballot(mx > m + 8.f) != 0ull) {
        float r = fmaxf(mx, __shfl_xor(mx, 16)); r = fmaxf(r, __shfl_xor(r, 32));
        const float mn = fmaxf(m, r), alpha = __builtin_amdgcn_exp2f(m - mn); m = mn; l *= alpha;
#pragma unroll
        for (int dt = 0; dt < 4; ++dt) o[dt] = o[dt] * alpha;
    }
    float p[8];
#pragma unroll
    for (int e = 0; e < 4; ++e) { p[e] = __builtin_amdgcn_exp2f(s0[e] - m); p[4 + e] = __builtin_amdgcn_exp2f(s1[e] - m); }
    l += ((p[0] + p[1]) + (p[2] + p[3])) + ((p[4] + p[5]) + (p[6] + p[7]));
    return pack_p(p);
}

__device__ __forceinline__ void osm_step64(f32x4 (&s)[4], unsigned vm, float& m, float& l, f32x4 (&o)[4], bf16x8& pb0, bf16x8& pb1) {
    const float NINF = -__builtin_inff();
#pragma unroll
    for (int qd = 0; qd < 4; ++qd)
#pragma unroll
        for (int e = 0; e < 4; ++e) s[qd][e] = ((vm >> (4 * qd + e)) & 1u) ? s[qd][e] : NINF;
    const float mx = fmaxf(fmaxf(fmaxf(fmaxf(s[0][0], s[0][1]), fmaxf(s[0][2], s[0][3])), fmaxf(fmaxf(s[1][0], s[1][1]), fmaxf(s[1][2], s[1][3]))),
                           fmaxf(fmaxf(fmaxf(s[2][0], s[2][1]), fmaxf(s[2][2], s[2][3])), fmaxf(fmaxf(s[3][0], s[3][1]), fmaxf(s[3][2], s[3][3]))));
    if (__ballot(mx > m + 8.f) != 0ull) {
        float r = fmaxf(mx, __shfl_xor(mx, 16)); r = fmaxf(r, __shfl_xor(r, 32));
        const float mn = fmaxf(m, r), alpha = __builtin_amdgcn_exp2f(m - mn); m = mn; l *= alpha;
#pragma unroll
        for (int dt = 0; dt < 4; ++dt) o[dt] = o[dt] * alpha;
    }
    float p[8], q[8];
#pragma unroll
    for (int e = 0; e < 4; ++e) { p[e] = __builtin_amdgcn_exp2f(s[0][e] - m); p[4 + e] = __builtin_amdgcn_exp2f(s[1][e] - m); q[e] = __builtin_amdgcn_exp2f(s[2][e] - m); q[4 + e] = __builtin_amdgcn_exp2f(s[3][e] - m); }
    l += (((p[0] + p[1]) + (p[2] + p[3])) + ((p[4] + p[5]) + (p[6] + p[7]))) + (((q[0] + q[1]) + (q[2] + q[3])) + ((q[4] + q[5]) + (q[6] + q[7])));
    pb0 = pack_p(p); pb1 = pack_p(q);
}

__device__ __forceinline__ void osm_fast64(const f32x4 (&s)[4], bool mine, float& m, float& l, f32x4 (&o)[4], bf16x8& pb0, bf16x8& pb1) {
    const float mxl = fmaxf(fmaxf(fmaxf(fmaxf(s[0][0], s[0][1]), fmaxf(s[0][2], s[0][3])), fmaxf(fmaxf(s[1][0], s[1][1]), fmaxf(s[1][2], s[1][3]))),
                            fmaxf(fmaxf(fmaxf(s[2][0], s[2][1]), fmaxf(s[2][2], s[2][3])), fmaxf(fmaxf(s[3][0], s[3][1]), fmaxf(s[3][2], s[3][3]))));
    const float mx = mine ? mxl : -__builtin_inff();
    if (__ballot(mx > m + 8.f) != 0ull) {
        float r = fmaxf(mx, __shfl_xor(mx, 16)); r = fmaxf(r, __shfl_xor(r, 32));
        const float mn = fmaxf(m, r), alpha = __builtin_amdgcn_exp2f(m - mn); m = mn; l *= alpha;
#pragma unroll
        for (int dt = 0; dt < 4; ++dt) o[dt] = o[dt] * alpha;
    }
    const float me = mine ? m : __builtin_inff();
    const f32x4 d0 = s[0] - me, d1 = s[1] - me, d2 = s[2] - me, d3 = s[3] - me;
    float p[8], q[8];
#pragma unroll
    for (int e = 0; e < 4; ++e) { p[e] = __builtin_amdgcn_exp2f(d0[e]); p[4 + e] = __builtin_amdgcn_exp2f(d1[e]); q[e] = __builtin_amdgcn_exp2f(d2[e]); q[4 + e] = __builtin_amdgcn_exp2f(d3[e]); }
    const f32x2 a = (f32x2){p[0], p[1]} + (f32x2){p[2], p[3]}, b = (f32x2){p[4], p[5]} + (f32x2){p[6], p[7]}, c = (f32x2){q[0], q[1]} + (f32x2){q[2], q[3]}, d = (f32x2){q[4], q[5]} + (f32x2){q[6], q[7]};
    const f32x2 t = (a + b) + (c + d);
    l += t.x + t.y;
    pb0 = pack_p(p); pb1 = pack_p(q);
}

__global__ void __launch_bounds__(512, 2) mk_fwd(Args a) {
    extern __shared__ __attribute__((aligned(16))) unsigned char lds_raw[];
    LAS unsigned char* lds = (LAS unsigned char*)lds_raw;
    cg::grid_group grid = cg::this_grid();
    const int tid = threadIdx.x, lane = tid & 63, wid = __builtin_amdgcn_readfirstlane(tid >> 6);
    const int G = gridDim.x, gw = blockIdx.x * 8 + wid, NGW = G * 8, gtid = blockIdx.x * 512 + tid, NGT = G * 512;
    unsigned char* ws = a.ws; unsigned char* dout = (unsigned char*)a.out;
    const int lo = a.ph_lo, hi = a.ph_hi;
#define IN(k) (lo <= (k) && (k) < hi)
#define SYNC(k) do { if (IN(k) && IN((k) + 1)) { if (a.ph_hi > 1000) grid.sync(); else xcd_barrier(xbar); } } while (0)
#ifndef PROBE_PH
#define PROBE_PH -1
#endif
#ifndef PROBE_N
#define PROBE_N 2
#endif
#ifndef PROBE_MASK
#define PROBE_MASK 0
#endif
#define PRB(k) ((k) == PROBE_PH || ((PROBE_MASK >> (k)) & 1))
#define RPT(k) for (int rp_ = 0; rp_ < (PRB(k) ? PROBE_N : 1); ++rp_, (PRB(k) && rp_ < PROBE_N) ? xcd_barrier(xbar) : (void)0)
    bf16_t* const Z = (bf16_t*)(ws + WS_Z);
    volatile LAS unsigned* xst = (volatile LAS unsigned*)(lds + LDS_BYTES - 64);
    if (tid == 0) { xst[0] = 0u; xst[1] = 0u; }
    __syncthreads();
    const XcdBarrier xbar = xcd_barrier_post((unsigned*)(ws + WS_BAR), xst);
    float* const ROPE = (float*)(dout + DO_ROPE);

    if (IN(0)) RPT(0) {
        LAS float* scr = (LAS float*)(lds + wid * 8448);
        constexpr int I_WIN = 16 * 216, I_XKV = 16 * 64, I_W1 = 32 * 8, I_W2 = 4 * 2, I_WOUT = 16 * 32;
        constexpr int NIT = I_WIN + I_XKV + 2 * I_W1 + 2 * I_W2 + I_WOUT;
        for (int it = gw; it < NIT; it += NGW) { int r = it;
            if (r < I_WIN) { tr_item(a.in[5], 1024, 6704, 6912, (bf16_t*)(dout + DO_WIN_T), scr, r, lane); continue; } r -= I_WIN;
            if (r < I_XKV) { tr_item(a.in[24], 1024, 2048, 2048, (bf16_t*)(dout + DO_WXKV_T), scr, r, lane); continue; } r -= I_XKV;
            if (r < I_W1) { tr_item(a.in[11], 2048, 256, 256, (bf16_t*)(dout + DO_W1KT), scr, r, lane); continue; } r -= I_W1;
            if (r < I_W1) { tr_item(a.in[16], 2048, 256, 256, (bf16_t*)(dout + DO_W1VT), scr, r, lane); continue; } r -= I_W1;
            if (r < I_W2) { tr_item(a.in[13], 256, 64, 64, (bf16_t*)(ws + WS_W2KT), scr, r, lane); continue; } r -= I_W2;
            if (r < I_W2) { tr_item(a.in[18], 256, 64, 64, (bf16_t*)(ws + WS_W2VT), scr, r, lane); continue; } r -= I_W2;
            tr_item(a.in[20], 1024, 1024, 1024, (bf16_t*)(ws + WS_WOUT_T), scr, r, lane);
        }
        for (int m = gw; m < T; m += NGW) { f32x4 v[4]; row_load(v, a.in[0] + (size_t)m * D, lane); ln_apply(v, a.in[3], a.in[4], lane); row_store_bf16(v, (bf16_t*)(dout + DO_H0B) + (size_t)m * D, lane); }
        for (int i = gtid; i < 512 * 1024 / 4; i += NGT) { const f32x4 v = *(const f32x4*)(a.in[1] + 4 * (size_t)i); u32x2 w; w.x = pk2(v.x, v.y); w.y = pk2(v.z, v.w); *(u32x2*)((bf16_t*)(dout + DO_MEMB) + 4 * (size_t)i) = w; }
        for (int i = gtid; i < T * 8; i += NGT) { const int tok = i >> 3, fi = i & 7; const int pos = ((const int*)a.in[2])[tok];
            float inv = 1.0f;
            inv = fi == 1 ? 0.19392274474868576f : inv; inv = fi == 2 ? 0.03760603093086393f : inv; inv = fi == 3 ? 0.007292664737217109f : inv; inv = fi == 4 ? 0.001414213562373095f : inv;
            inv = fi == 5 ? 0.0002742481756762073f : inv; inv = fi == 6 ? 5.318295896944988e-05f : inv; inv = fi == 7 ? 1.031338537721246e-05f : inv;
            const float ang = (float)pos * inv; ROPE[tok * 16 + fi] = cosf(ang); ROPE[tok * 16 + 8 + fi] = sinf(ang); }
        for (int i = gtid; i < 8 * 128 * 128; i += NGT) { const int t = (i >> 7) & 127, s = i & 127; const float w = a.in[8][i]; ((bf16_t*)(ws + WS_WSTRIL))[i] = (bf16_t)(s <= t ? f2bf(w) : 0u); }
        for (int job = blockIdx.x; job < 64; job += G) if (tid < 256) { const int mat = job >> 5, ks = job & 31; const float* pe = a.in[mat ? 15 : 10] + ks * 64; const float* w1 = a.in[mat ? 16 : 11] + (size_t)ks * 64 * 256 + tid; float sum = 0.f;
#pragma unroll 16
            for (int k = 0; k < 64; ++k) sum += pe[k] * w1[(size_t)k * 256];
            ((float*)(ws + WS_C1P))[job * 256 + tid] = sum; }
    }
    SYNC(0);

    if (IN(1)) RPT(1) {
        { pg8::Gemm g{(const bf16_t*)(dout + DO_H0B), (const bf16_t*)(dout + DO_WIN_T), T, ZC, D, D}; pg8::StaticOrder So; So.init(T, ZC, G, (int)blockIdx.x);
          pg8::EpiBf16<0> E{Z, ZC, nullptr, 1.f}; pg8::gemm_phase<pg8::EpiBf16<0>, pg8::StaticOrder, true>(lds, g, So, E); }
        { pg8::Gemm g{(const bf16_t*)(dout + DO_MEMB), (const bf16_t*)(dout + DO_WXKV_T), 512, 2048, D, D}; pg8::StaticOrder So; So.init(512, 2048, G, (G - 1) - (int)blockIdx.x);
          pg8::EpiBf16<0> E{(bf16_t*)(dout + DO_XKV), 2048, nullptr, 1.f}; pg8::gemm_phase<pg8::EpiBf16<0>, pg8::StaticOrder, true>(lds, g, So, E); }
    }
    SYNC(1);

    if (IN(2)) RPT(2) {
        bf16_t* const KCMPT = (bf16_t*)(ws + WS_KCMPT); bf16_t* const VCMPT = (bf16_t*)(ws + WS_VCMPT);
        for (int tok = gw; tok < T; tok += NGW) {
            bf16_t* zr = Z + (size_t)tok * ZC; const int b = tok >> 13, t = tok & 8191;
            float rc[8], rs[8];
            { const f32x4 c0 = *(const f32x4*)(ROPE + tok * 16), c1 = *(const f32x4*)(ROPE + tok * 16 + 4), s0 = *(const f32x4*)(ROPE + tok * 16 + 8), s1 = *(const f32x4*)(ROPE + tok * 16 + 12);
#pragma unroll
              for (int e = 0; e < 4; ++e) { rc[e] = c0[e]; rc[4 + e] = c1[e]; rs[e] = s0[e]; rs[4 + e] = s1[e]; } }
            { const u32x4 w0 = *(const u32x4*)(zr + C_V + 16 * lane), w1 = *(const u32x4*)(zr + C_V + 16 * lane + 8); float f[16];
#pragma unroll
              for (int e = 0; e < 4; ++e) { f[2 * e] = bflo(w0[e]); f[2 * e + 1] = bfhi(w0[e]); f[8 + 2 * e] = bflo(w1[e]); f[8 + 2 * e + 1] = bfhi(w1[e]); }
              float s = 0.f;
#pragma unroll
              for (int e = 0; e < 16; ++e) { f[e] = gelu_t(f[e]); s += f[e]; }
              const float mean = wave_sum(s) * (1.f / 1024.f); float s2 = 0.f;
#pragma unroll
              for (int e = 0; e < 16; ++e) { f[e] -= mean; s2 += f[e] * f[e]; }
              const float rstd = 1.f / sqrtf(wave_sum(s2) * (1.f / 1024.f) + LN_EPS);
              const float* gg = a.in[6] + 16 * lane; const float* bb = a.in[7] + 16 * lane; u32x4 o0, o1;
#pragma unroll
              for (int e = 0; e < 4; ++e) { o0[e] = pk2(f[2 * e] * rstd * gg[2 * e] + bb[2 * e], f[2 * e + 1] * rstd * gg[2 * e + 1] + bb[2 * e + 1]);
                                            o1[e] = pk2(f[8 + 2 * e] * rstd * gg[8 + 2 * e] + bb[8 + 2 * e], f[9 + 2 * e] * rstd * gg[9 + 2 * e] + bb[9 + 2 * e]); }
              *(u32x4*)(zr + C_V + 16 * lane) = o0; *(u32x4*)(zr + C_V + 16 * lane + 8) = o1; }
            { const u32x4 w0 = *(const u32x4*)(zr + C_Q + 16 * lane), w1 = *(const u32x4*)(zr + C_Q + 16 * lane + 8); float f[16];
#pragma unroll
              for (int e = 0; e < 4; ++e) { f[2 * e] = bflo(w0[e]); f[2 * e + 1] = bfhi(w0[e]); f[8 + 2 * e] = bflo(w1[e]); f[8 + 2 * e + 1] = bfhi(w1[e]); }
              if ((lane & 3) == 0) {
#pragma unroll
                  for (int i = 0; i < 8; ++i) { const float x1 = f[i], x2 = f[8 + i]; f[i] = x1 * rc[i] - x2 * rs[i]; f[8 + i] = x2 * rc[i] + x1 * rs[i]; } }
              u32x4 o0, o1;
#pragma unroll
              for (int e = 0; e < 4; ++e) { o0[e] = pk2(f[2 * e] * QSCALE, f[2 * e + 1] * QSCALE); o1[e] = pk2(f[8 + 2 * e] * QSCALE, f[9 + 2 * e] * QSCALE); }
              *(u32x4*)(zr + C_Q + 16 * lane) = o0; *(u32x4*)(zr + C_Q + 16 * lane + 8) = o1; }
            { const int h = lane >> 4, r = lane & 15; const size_t bh = (size_t)(b * 4 + h);
              const f32x4 rcl = *(const f32x4*)(ROPE + tok * 16 + 4 * (r & 1)), rsl = *(const f32x4*)(ROPE + tok * 16 + 8 + 4 * (r & 1));
#pragma unroll
              for (int sg = 0; sg < 6; ++sg) {
                  const u32x2 w = *(const u32x2*)(zr + C_KCMP + sg * 256 + 4 * lane);
                  if (sg == 0) *(u32x2*)(KCMPT + (bh * 8192 + t) * 64 + 4 * r) = w;
                  else if (sg == 1) *(u32x2*)(VCMPT + (bh * 8192 + t) * 64 + 4 * r) = w;
                  else if (sg == 2 || sg == 4) {
                      float x[4] = {bflo(w.x), bfhi(w.x), bflo(w.y), bfhi(w.y)}; float y[4];
#pragma unroll
                      for (int e = 0; e < 4; ++e) { const float other = __shfl_xor(x[e], 2); const float c = rcl[e], sn = rsl[e];
                          y[e] = (r < 2) ? (x[e] * c - other * sn) : ((r < 4) ? (x[e] * c + other * sn) : x[e]); }
                      u32x2 o; o.x = pk2(y[0], y[1]); o.y = pk2(y[2], y[3]); *(u32x2*)(zr + C_KCMP + sg * 256 + 4 * lane) = o;
                  }
              } }
        }
        if (gtid < 512) { const int mat = gtid >> 8, col = gtid & 255; float sum = a.in[mat ? 17 : 12][col];
            for (int ks = 0; ks < 32; ++ks) sum += ((const float*)(ws + WS_C1P))[(mat * 32 + ks) * 256 + col];
            ((float*)(ws + WS_C1))[gtid] = sum; }
        for (int i = gtid; i < 512 * 128; i += NGT) { const int mrow = i >> 7, cgp = i & 127; const u32x4 w = *(const u32x4*)((const bf16_t*)(dout + DO_XKV) + (size_t)mrow * 2048 + 1024 + 8 * cgp);
            bf16_t* p = (bf16_t*)(dout + DO_XVT) + ((size_t)((mrow >> 8) * 1024 + 8 * cgp)) * 256 + (mrow & 255);
#pragma unroll
            for (int e = 0; e < 4; ++e) { p[(2 * e) * 256] = (bf16_t)(w[e] & 0xffffu); p[(2 * e + 1) * 256] = (bf16_t)(w[e] >> 16); } }
    }
    SYNC(2);

    if (IN(3)) RPT(3) {
        const bf16_t* WSTRIL = (const bf16_t*)(ws + WS_WSTRIL);
        for (int un = blockIdx.x; un < 1024; un += G) {
            const int chunk = un >> 3, g = un & 7; const size_t tokbase = (size_t)chunk * 128;
            LAS bf16_t* vT = (LAS bf16_t*)lds;
#pragma unroll
            for (int i = 0; i < 4; ++i) { const int p = tid + 512 * i, s = p >> 4, c0 = (p & 15) * 8; const u32x4 w = *(const u32x4*)(Z + (tokbase + s) * ZC + C_V + g * 128 + c0);
#pragma unroll
                for (int e = 0; e < 4; ++e) { vT[(c0 + 2 * e) * 136 + s] = (bf16_t)(w[e] & 0xffffu); vT[(c0 + 2 * e + 1) * 136 + s] = (bf16_t)(w[e] >> 16); } }
            __syncthreads();
            const int j = lane & 15, q4 = lane >> 4, t = 16 * wid + j;
            f32x4 acc[8];
#pragma unroll
            for (int it = 0; it < 8; ++it) acc[it] = (f32x4){0.f, 0.f, 0.f, 0.f};
            const int nks = (16 * wid + 15) / 32 + 1;
            for (int ks = 0; ks < nks; ++ks) { const bf16x8 wf = *(const bf16x8*)(WSTRIL + (size_t)g * 16384 + t * 128 + 32 * ks + 8 * q4);
#pragma unroll
                for (int it = 0; it < 8; ++it) { const bf16x8 vf = *(const LAS bf16x8*)(vT + (16 * it + j) * 136 + 32 * ks + 8 * q4); acc[it] = MFMA16(vf, wf, acc[it]); } }
            const float bsv = a.in[9][g * 128 + t]; bf16_t* zr = Z + (tokbase + t) * ZC;
#pragma unroll
            for (int it = 0; it < 8; ++it) { const int c = g * 128 + 16 * it + 4 * q4; const u32x2 uw = *(const u32x2*)(zr + C_U + c), gaw = *(const u32x2*)(zr + C_GA + c);
                const float u0 = bflo(uw.x), u1 = bfhi(uw.x), u2 = bflo(uw.y), u3 = bfhi(uw.y), g0 = bflo(gaw.x), g1 = bfhi(gaw.x), g2 = bflo(gaw.y), g3 = bfhi(gaw.y);
                u32x2 o; o.x = pk2(gelu_t(u0) * (acc[it][0] + bsv) * sigm(g0), gelu_t(u1) * (acc[it][1] + bsv) * sigm(g1)); o.y = pk2(gelu_t(u2) * (acc[it][2] + bsv) * sigm(g2), gelu_t(u3) * (acc[it][3] + bsv) * sigm(g3));
                *(u32x2*)(zr + C_U + c) = o; }
            __syncthreads();
        }
        { pg8::Gemm g{(const bf16_t*)(ws + WS_KCMPT), (const bf16_t*)(dout + DO_W1KT), 4096, 256, 2048, 1024}; pg8::StaticOrder So; So.init(4096, 256, G, (int)blockIdx.x);
          pg8::EpiBf16<2> E{(bf16_t*)(ws + WS_HDNK), 256, (const float*)(ws + WS_C1), 1.f}; pg8::gemm_phase<pg8::EpiBf16<2>, pg8::StaticOrder, true>(lds, g, So, E); }
        { pg8::Gemm g{(const bf16_t*)(ws + WS_VCMPT), (const bf16_t*)(dout + DO_W1VT), 4096, 256, 2048, 1024}; pg8::StaticOrder So; So.init(4096, 256, G, (G - 1) - (int)blockIdx.x);
          pg8::EpiBf16<2> E{(bf16_t*)(ws + WS_HDNV), 256, (const float*)(ws + WS_C1) + 256, 1.f}; pg8::gemm_phase<pg8::EpiBf16<2>, pg8::StaticOrder, true>(lds, g, So, E); }
    }
    SYNC(3);

    if (IN(4)) RPT(4) {
        for (int u = gw; u < 512; u += NGW) {
            const int mat = u >> 8, r0 = (u & 255) * 16, j = lane & 15, q4 = lane >> 4;
            const bf16_t* HDN = (const bf16_t*)(ws + (mat ? WS_HDNV : WS_HDNK)); const bf16_t* W2T = (const bf16_t*)(ws + (mat ? WS_W2VT : WS_W2KT)); const float* b2 = a.in[mat ? 19 : 14];
            f32x4 acc[4];
#pragma unroll
            for (int it = 0; it < 4; ++it) acc[it] = (f32x4){0.f, 0.f, 0.f, 0.f};
#pragma unroll
            for (int ks = 0; ks < 8; ++ks) { const bf16x8 hb = *(const bf16x8*)(HDN + (size_t)(r0 + j) * 256 + 32 * ks + 8 * q4);
#pragma unroll
                for (int it = 0; it < 4; ++it) { const bf16x8 wf = *(const bf16x8*)(W2T + (16 * it + j) * 256 + 32 * ks + 8 * q4); acc[it] = MFMA16(wf, hb, acc[it]); } }
            const int r = r0 + j, bh = r >> 9, n = r & 511, b = bh >> 2;
#pragma unroll
            for (int it = 0; it < 4; ++it) { const f32x4 bv = *(const f32x4*)(b2 + 16 * it + 4 * q4); acc[it] = acc[it] + bv; }
            if (mat == 0) {
                const int pt = 16 * n + 31; const float* rt = ROPE + (size_t)(b * 8192 + (pt < 8192 ? pt : 8191)) * 16;
#pragma unroll
                for (int e = 0; e < 4; ++e) { const float x = acc[0][e], other = __shfl_xor(x, 32); const int fi = 4 * (q4 & 1) + e; const float c = rt[fi], sn = rt[8 + fi];
                    acc[0][e] = (q4 < 2) ? (x * c - other * sn) : (x * c + other * sn); }
#pragma unroll
                for (int it = 0; it < 4; ++it) { u32x2 o; o.x = pk2(acc[it][0], acc[it][1]); o.y = pk2(acc[it][2], acc[it][3]); if (n == 511) { o.x = 0u; o.y = 0u; }
                    *(u32x2*)((bf16_t*)(ws + WS_KC) + (size_t)r * 64 + 16 * it + 4 * q4) = o; }
            } else {
#pragma unroll
                for (int it = 0; it < 4; ++it) { u32x2 o; o.x = pk2(acc[it][0], acc[it][1]); o.y = pk2(acc[it][2], acc[it][3]); if (n == 511) { o.x = 0u; o.y = 0u; }
                    *(u32x2*)((bf16_t*)(ws + WS_VCT) + (size_t)r * 64 + 16 * it + 4 * q4) = o; }
            }
        }
    }
    SYNC(4);

    if (IN(5)) RPT(5) {
        const bf16_t* KC = (const bf16_t*)(ws + WS_KC); const bf16_t* VC = (const bf16_t*)(ws + WS_VCT);
        bf16_t* MIX = (bf16_t*)(dout + DO_MIX);
        LAS float* wl = (LAS float*)(lds + 65536 + wid * 4352);
        LAS unsigned* wgum = (LAS unsigned*)(lds + 65536 + 8 * 4352);
        LAS unsigned char* blist = (LAS unsigned char*)(wgum + 8);
        const int j = lane & 15, q4 = lane >> 4, tk = j >> 2, hd = j & 3;
        const int drow = 8 * wid + (lane >> 3), dch = (lane & 7) ^ (lane >> 3);
        const unsigned ldsb = (unsigned)(uintptr_t)lds;
        const unsigned kadr0 = (unsigned)(j * 128 + ((q4 ^ (j & 7)) << 4)), kadr1 = (unsigned)(j * 128 + (((4 + q4) ^ (j & 7)) << 4));
        const int vrow = 4 * q4 + (j >> 2);
        unsigned vadr[4];
#pragma unroll
        for (int dt = 0; dt < 4; ++dt) vadr[dt] = ldsb + 8192u + (unsigned)(vrow * 128 + (((2 * dt + ((lane & 3) >> 1)) ^ (vrow & 7)) << 4) + 8 * (lane & 1));
#define DMA16(g, l) __builtin_amdgcn_global_load_lds((const unsigned*)(g), (LAS unsigned*)(l), 16, 0, 0)
#define ISSUE(nn, KROW0, VROW0, PITCH) do { const int sl_ = (nn) & 3; DMA16((KROW0) + (size_t)drow * (PITCH) + dch * 8, lds + sl_ * 16384 + wid * 1024); \
            DMA16((VROW0) + (size_t)drow * (PITCH) + dch * 8, lds + sl_ * 16384 + 8192 + wid * 1024); } while (0)
#define WAITV(n) asm volatile("s_waitcnt vmcnt(" #n ")" ::: "memory")
#define PIPE_WAIT(n, nb) do { const int rem_ = (nb) - 1 - (n); if (rem_ >= 2) WAITV(4); else if (rem_ == 1) WAITV(2); else WAITV(0); __builtin_amdgcn_s_barrier(); asm volatile("" ::: "memory"); } while (0)
#define QK_LDS(slot, hf, s0, s1) do { const LAS unsigned char* p_ = lds + (slot) * 16384 + (hf) * 4096; const f32x4 z_ = {0.f, 0.f, 0.f, 0.f}; \
            const bf16x8 k00_ = *(const LAS bf16x8*)(p_ + kadr0), k01_ = *(const LAS bf16x8*)(p_ + kadr1), k10_ = *(const LAS bf16x8*)(p_ + 2048 + kadr0), k11_ = *(const LAS bf16x8*)(p_ + 2048 + kadr1); \
            s0 = MFMA16(k00_, qf0, z_); s0 = MFMA16(k01_, qf1, s0); s1 = MFMA16(k10_, qf0, z_); s1 = MFMA16(k11_, qf1, s1); } while (0)
#define PV_LDS(slot, hf, pb, o) do { const unsigned b_ = (unsigned)((slot) * 16384 + (hf) * 4096); const unsigned a0_ = vadr[0] + b_, a1_ = vadr[1] + b_, a2_ = vadr[2] + b_, a3_ = vadr[3] + b_; \
            u32x2 l0_, h0_, l1_, h1_, l2_, h2_, l3_, h3_; \
            asm volatile("ds_read_b64_tr_b16 %0, %8\n\tds_read_b64_tr_b16 %1, %8 offset:2048\n\tds_read_b64_tr_b16 %2, %9\n\tds_read_b64_tr_b16 %3, %9 offset:2048\n\t" \
                         "ds_read_b64_tr_b16 %4, %10\n\tds_read_b64_tr_b16 %5, %10 offset:2048\n\tds_read_b64_tr_b16 %6, %11\n\tds_read_b64_tr_b16 %7, %11 offset:2048\n\ts_waitcnt lgkmcnt(0)" \
                         : "=&v"(l0_), "=&v"(h0_), "=&v"(l1_), "=&v"(h1_), "=&v"(l2_), "=&v"(h2_), "=&v"(l3_), "=&v"(h3_) : "v"(a0_), "v"(a1_), "v"(a2_), "v"(a3_) : "memory"); \
            { u32x4 w_; w_.x = l0_.x; w_.y = l0_.y; w_.z = h0_.x; w_.w = h0_.y; o[0] = MFMA16(__builtin_bit_cast(bf16x8, w_), pb, o[0]); } \
            { u32x4 w_; w_.x = l1_.x; w_.y = l1_.y; w_.z = h1_.x; w_.w = h1_.y; o[1] = MFMA16(__builtin_bit_cast(bf16x8, w_), pb, o[1]); } \
            { u32x4 w_; w_.x = l2_.x; w_.y = l2_.y; w_.z = h2_.x; w_.w = h2_.y; o[2] = MFMA16(__builtin_bit_cast(bf16x8, w_), pb, o[2]); } \
            { u32x4 w_; w_.x = l3_.x; w_.y = l3_.y; w_.z = h3_.x; w_.w = h3_.y; o[3] = MFMA16(__builtin_bit_cast(bf16x8, w_), pb, o[3]); } } while (0)
#define MK8(lo, hi) __builtin_bit_cast(bf16x8, (u32x4){(lo).x, (lo).y, (hi).x, (hi).y})
#define BLOCK64(slot, vm, fast, mine, m, l, o) do { const LAS unsigned char* p_ = lds + (slot) * 16384; const f32x4 z_ = {0.f, 0.f, 0.f, 0.f}; f32x4 s_[4]; \
            { const bf16x8 ka_ = *(const LAS bf16x8*)(p_ + kadr0), kb_ = *(const LAS bf16x8*)(p_ + kadr1), kc_ = *(const LAS bf16x8*)(p_ + 2048 + kadr0), kd_ = *(const LAS bf16x8*)(p_ + 2048 + kadr1); \
              const bf16x8 ke_ = *(const LAS bf16x8*)(p_ + 4096 + kadr0), kf_ = *(const LAS bf16x8*)(p_ + 4096 + kadr1), kg_ = *(const LAS bf16x8*)(p_ + 6144 + kadr0), kh_ = *(const LAS bf16x8*)(p_ + 6144 + kadr1); \
              s_[0] = MFMA16(ka_, qf0, z_); s_[1] = MFMA16(kc_, qf0, z_); s_[2] = MFMA16(ke_, qf0, z_); s_[3] = MFMA16(kg_, qf0, z_); \
              s_[0] = MFMA16(kb_, qf1, s_[0]); s_[1] = MFMA16(kd_, qf1, s_[1]); s_[2] = MFMA16(kf_, qf1, s_[2]); s_[3] = MFMA16(kh_, qf1, s_[3]); } \
            const unsigned b_ = (unsigned)((slot) * 16384); const unsigned a0_ = vadr[0] + b_, a1_ = vadr[1] + b_, a2_ = vadr[2] + b_, a3_ = vadr[3] + b_; \
            u32x2 v0_, v1_, v2_, v3_, v4_, v5_, v6_, v7_, v8_, v9_, v10_, v11_, v12_, v13_, v14_, v15_; \
            asm volatile("ds_read_b64_tr_b16 %0, %16\n\tds_read_b64_tr_b16 %1, %16 offset:2048\n\tds_read_b64_tr_b16 %2, %17\n\tds_read_b64_tr_b16 %3, %17 offset:2048\n\t" \
                         "ds_read_b64_tr_b16 %4, %18\n\tds_read_b64_tr_b16 %5, %18 offset:2048\n\tds_read_b64_tr_b16 %6, %19\n\tds_read_b64_tr_b16 %7, %19 offset:2048\n\t" \
                         "ds_read_b64_tr_b16 %8, %16 offset:4096\n\tds_read_b64_tr_b16 %9, %16 offset:6144\n\tds_read_b64_tr_b16 %10, %17 offset:4096\n\tds_read_b64_tr_b16 %11, %17 offset:6144\n\t" \
                         "ds_read_b64_tr_b16 %12, %18 offset:4096\n\tds_read_b64_tr_b16 %13, %18 offset:6144\n\tds_read_b64_tr_b16 %14, %19 offset:4096\n\tds_read_b64_tr_b16 %15, %19 offset:6144\n\ts_waitcnt lgkmcnt(0)" \
                         : "=&v"(v0_), "=&v"(v1_), "=&v"(v2_), "=&v"(v3_), "=&v"(v4_), "=&v"(v5_), "=&v"(v6_), "=&v"(v7_), "=&v"(v8_), "=&v"(v9_), "=&v"(v10_), "=&v"(v11_), "=&v"(v12_), "=&v"(v13_), "=&v"(v14_), "=&v"(v15_) \
                         : "v"(a0_), "v"(a1_), "v"(a2_), "v"(a3_) : "memory"); \
            bf16x8 pb0_, pb1_; if (fast) osm_fast64(s_, mine, m, l, o, pb0_, pb1_); else osm_step64(s_, vm, m, l, o, pb0_, pb1_); \
            o[0] = MFMA16(MK8(v0_, v1_), pb0_, o[0]); o[1] = MFMA16(MK8(v2_, v3_), pb0_, o[1]); o[2] = MFMA16(MK8(v4_, v5_), pb0_, o[2]); o[3] = MFMA16(MK8(v6_, v7_), pb0_, o[3]); \
            o[0] = MFMA16(MK8(v8_, v9_), pb1_, o[0]); o[1] = MFMA16(MK8(v10_, v11_), pb1_, o[1]); o[2] = MFMA16(MK8(v12_, v13_), pb1_, o[2]); o[3] = MFMA16(MK8(v14_, v15_), pb1_, o[3]); } while (0)
        for (int uu = blockIdx.x; uu < 2048; uu += G) {
            const int bhu = uu >> 8; int tb = uu & 255; if (bhu & 1) tb = 255 - tb;
            const int b = bhu >> 2, kvh = bhu & 3, t0w = 32 * tb, t0 = t0w + 4 * wid, t = t0 + tk; const size_t tok = (size_t)b * S + t, bh = (size_t)bhu;
            const bf16_t* zr = Z + tok * ZC; const int head = kvh * 4 + hd;
            const bf16x8 qf0 = *(const bf16x8*)(zr + C_Q + head * 64 + 8 * q4), qf1 = *(const bf16x8*)(zr + C_Q + head * 64 + 32 + 8 * q4);
            for (int i = lane; i < 1040; i += 64) wl[i] = 0.f;
            if (tid < 8) wgum[tid] = 0u;
            const float gcm = sigm(bf1(zr[C_GN + head * 3 + 0])), gsl = sigm(bf1(zr[C_GN + head * 3 + 1])), gwn = sigm(bf1(zr[C_GN + head * 3 + 2]));
            f32x4 yb[4];
#pragma unroll
            for (int dt = 0; dt < 4; ++dt) yb[dt] = (f32x4){0.f, 0.f, 0.f, 0.f};
            __syncthreads();
            const int ncw = (t0w + 31 >= 31) ? (((t0w + 31 - 31) >> 4) + 1) : 0;
            const int ncmax = (t0 + 3 >= 31) ? (((t0 + 3 - 31) >> 4) + 1) : 0;
            const int nvalid = (t >= 31) ? (((t - 31) >> 4) + 1) : 0;
            const int nb_c = (ncw + 63) >> 6;
            {
                float m = -1e30f, l = 0.f;
                const bf16_t* kcb = KC + bh * 512 * 64; const bf16_t* vcb = VC + bh * 512 * 64;
                WAITV(0);
                for (int pre = 0; pre < 3 && pre < nb_c; ++pre) ISSUE(pre, kcb + (size_t)pre * 4096, vcb + (size_t)pre * 4096, 64);
                for (int n = 0; n < nb_c; ++n) { const int slot = n & 3; PIPE_WAIT(n, nb_c); if (n + 3 < nb_c) ISSUE(n + 3, kcb + (size_t)(n + 3) * 4096, vcb + (size_t)(n + 3) * 4096, 64);
#pragma unroll
                    for (int hf = 0; hf < 2; ++hf) { const int kb = 64 * n + 32 * hf; if (kb < ncmax) { f32x4 s0, s1; QK_LDS(slot, hf, s0, s1);
                        float mx = -1e30f;
#pragma unroll
                        for (int e = 0; e < 4; ++e) { if (kb + 4 * q4 + e < nvalid) mx = fmaxf(mx, s0[e]); if (kb + 16 + 4 * q4 + e < nvalid) mx = fmaxf(mx, s1[e]); }
                        mx = fmaxf(mx, __shfl_xor(mx, 16)); mx = fmaxf(mx, __shfl_xor(mx, 32));
                        const float mn = fmaxf(m, mx); float ps = 0.f;
#pragma unroll
                        for (int e = 0; e < 4; ++e) { if (kb + 4 * q4 + e < nvalid) ps += __builtin_amdgcn_exp2f(s0[e] - mn); if (kb + 16 + 4 * q4 + e < nvalid) ps += __builtin_amdgcn_exp2f(s1[e] - mn); }
                        l = l * __builtin_amdgcn_exp2f(m - mn) + ps; m = mn; } } }
                l += __shfl_xor(l, 16); l += __shfl_xor(l, 32);
                const float invl = l > 0.f ? 1.f / l : 0.f;
                f32x4 o[4];
#pragma unroll
                for (int dt = 0; dt < 4; ++dt) o[dt] = (f32x4){0.f, 0.f, 0.f, 0.f};
                WAITV(0); __builtin_amdgcn_s_barrier();
                for (int pre = 0; pre < 3 && pre < nb_c; ++pre) ISSUE(pre, kcb + (size_t)pre * 4096, vcb + (size_t)pre * 4096, 64);
                for (int n = 0; n < nb_c; ++n) { const int slot = n & 3; PIPE_WAIT(n, nb_c); if (n + 3 < nb_c) ISSUE(n + 3, kcb + (size_t)(n + 3) * 4096, vcb + (size_t)(n + 3) * 4096, 64);
#pragma unroll
                    for (int hf = 0; hf < 2; ++hf) { const int kb = 64 * n + 32 * hf; if (kb < ncmax) { f32x4 s0, s1; QK_LDS(slot, hf, s0, s1);
                        float p[8];
#pragma unroll
                        for (int e = 0; e < 4; ++e) { p[e] = (kb + 4 * q4 + e < nvalid) ? __builtin_amdgcn_exp2f(s0[e] - m) * invl : 0.f; p[4 + e] = (kb + 16 + 4 * q4 + e < nvalid) ? __builtin_amdgcn_exp2f(s1[e] - m) * invl : 0.f; }
                        float a0 = (p[0] + p[1]) + (p[2] + p[3]), a1 = (p[4] + p[5]) + (p[6] + p[7]), x0 = p[3], x1 = p[7];
                        a0 += dpp_xor1(a0); a0 += dpp_xor2(a0); a1 += dpp_xor1(a1); a1 += dpp_xor2(a1);
                        x0 += dpp_xor1(x0); x0 += dpp_xor2(x0); x1 += dpp_xor1(x1); x1 += dpp_xor2(x1);
                        if (hd == 0) { const int jj0 = (kb >> 2) + q4, jj1 = jj0 + 4; wl[tk * 128 + jj0] = a0; wl[tk * 128 + jj1] = a1; wl[512 + tk * 132 + jj0 + 1] = x0; wl[512 + tk * 132 + jj1 + 1] = x1; }
                        const bf16x8 pb = pack_p(p); PV_LDS(slot, hf, pb, o); } } }
#pragma unroll
                for (int dt = 0; dt < 4; ++dt) yb[dt] = yb[dt] + o[dt] * gcm;
            }
            LDS_WAIT();
            unsigned mysel[4], um[4];
            {
                const int tk2 = lane >> 4, r = lane & 15, cur = t0 >> 6;
                float val[8];
#pragma unroll
                for (int mm = 0; mm < 8; ++mm) { const int jj = r + 16 * mm; const float pvv = wl[tk2 * 128 + jj] + wl[512 + tk2 * 132 + jj];
                    const bool forced = (jj == 0) | (jj == cur) | (jj == cur - 1);
                    val[mm] = forced ? __builtin_inff() : (jj <= cur ? pvv : -__builtin_inff()); }
                LDS_WAIT();
#pragma unroll
                for (int mm = 0; mm < 8; ++mm) wl[tk2 * 128 + r + 16 * mm] = val[mm];
                LDS_WAIT();
                int rank[8];
#pragma unroll
                for (int mm = 0; mm < 8; ++mm) rank[mm] = 0;
                for (int jp = 0; jp <= cur; ++jp) { const float vp = wl[tk2 * 128 + jp];
#pragma unroll
                    for (int mm = 0; mm < 8; ++mm) rank[mm] += ((vp > val[mm]) || (vp == val[mm] && jp < r + 16 * mm)) ? 1 : 0; }
                unsigned long long bm[8];
#pragma unroll
                for (int mm = 0; mm < 8; ++mm) bm[mm] = __ballot((r + 16 * mm <= cur) && rank[mm] < 16);
#pragma unroll
                for (int w = 0; w < 4; ++w) { const unsigned long long b0 = bm[2 * w], b1 = bm[2 * w + 1];
                    mysel[w] = (unsigned)((b0 >> (16 * tk)) & 0xFFFFull) | ((unsigned)((b1 >> (16 * tk)) & 0xFFFFull) << 16);
                    const unsigned u0 = (unsigned)((b0 | (b0 >> 16) | (b0 >> 32) | (b0 >> 48)) & 0xFFFFull), u1 = (unsigned)((b1 | (b1 >> 16) | (b1 >> 32) | (b1 >> 48)) & 0xFFFFull);
                    um[w] = (unsigned)__builtin_amdgcn_readfirstlane((int)(u0 | (u1 << 16))); }
                if (lane < 4) { const unsigned v = lane == 0 ? um[0] : (lane == 1 ? um[1] : (lane == 2 ? um[2] : um[3])); atomicOr((unsigned*)(wgum + lane), v); }
            }
            __syncthreads();
            if (tid < 128) { const int w = tid >> 5, bi = tid & 31; const unsigned w0 = wgum[0], w1 = wgum[1], w2 = wgum[2], w3 = wgum[3]; const unsigned word = w == 0 ? w0 : (w == 1 ? w1 : (w == 2 ? w2 : w3));
                if ((word >> bi) & 1u) { const int pos = (w > 0 ? __builtin_popcount(w0) : 0) + (w > 1 ? __builtin_popcount(w1) : 0) + (w > 2 ? __builtin_popcount(w2) : 0) + __builtin_popcount(word & ((1u << bi) - 1u)); blist[pos] = (unsigned char)tid; }
                if (tid == 0) wgum[4] = (unsigned)(__builtin_popcount(w0) + __builtin_popcount(w1) + __builtin_popcount(w2) + __builtin_popcount(w3)); }
            __syncthreads();
            {
                float m = -1e30f, l = 0.f; f32x4 o[4];
#pragma unroll
                for (int dt = 0; dt < 4; ++dt) o[dt] = (f32x4){0.f, 0.f, 0.f, 0.f};
                const int nb_s = (int)wgum[4];
                const bf16_t* ksb = Z + (size_t)b * S * ZC + C_KSLC + kvh * 64; const bf16_t* vsb = Z + (size_t)b * S * ZC + C_VSLC + kvh * 64;
                WAITV(0);
                for (int pre = 0; pre < 3 && pre < nb_s; ++pre) { const size_t ro = (size_t)(64 * (int)blist[pre]) * ZC; ISSUE(pre, ksb + ro, vsb + ro, ZC); }
                for (int n = 0; n < nb_s; ++n) { const int slot = n & 3; const int jj = blist[n]; PIPE_WAIT(n, nb_s);
                    if (n + 3 < nb_s) { const size_t ro = (size_t)(64 * (int)blist[n + 3]) * ZC; ISSUE(n + 3, ksb + ro, vsb + ro, ZC); }
                    const unsigned uw = jj < 32 ? um[0] : (jj < 64 ? um[1] : (jj < 96 ? um[2] : um[3]));
                    if ((uw >> (jj & 31)) & 1u) { const unsigned mw = jj < 32 ? mysel[0] : (jj < 64 ? mysel[1] : (jj < 96 ? mysel[2] : mysel[3])); const bool mine = (mw >> (jj & 31)) & 1u;
                        unsigned vm = 0u; const bool fastp = jj < (t0 >> 6);
                        if (!fastp) {
#pragma unroll
                            for (int qd = 0; qd < 4; ++qd)
#pragma unroll
                                for (int e = 0; e < 4; ++e) vm |= (mine && (64 * jj + 16 * qd + 4 * q4 + e <= t)) ? (1u << (4 * qd + e)) : 0u; }
                        BLOCK64(slot, vm, fastp, mine, m, l, o); } }
                l += __shfl_xor(l, 16); l += __shfl_xor(l, 32); const float sc2 = (l > 0.f ? 1.f / l : 0.f) * gsl;
#pragma unroll
                for (int dt = 0; dt < 4; ++dt) yb[dt] = yb[dt] + o[dt] * sc2;
            }
            {
                float m = -1e30f, l = 0.f; f32x4 o[4];
#pragma unroll
                for (int dt = 0; dt < 4; ++dt) o[dt] = (f32x4){0.f, 0.f, 0.f, 0.f};
                const int kws = ((t0w - 511 > 0) ? (t0w - 511) : 0) & ~63; const int nb_w = ((t0w + 31 - kws) >> 6) + 1;
                const bf16_t* kwb = Z + ((size_t)b * S + kws) * ZC + C_KWIN + kvh * 64; const bf16_t* vwb = Z + ((size_t)b * S + kws) * ZC + C_VWIN + kvh * 64;
                WAITV(0); __builtin_amdgcn_s_barrier();
                for (int pre = 0; pre < 3 && pre < nb_w; ++pre) ISSUE(pre, kwb + (size_t)(64 * pre) * ZC, vwb + (size_t)(64 * pre) * ZC, ZC);
                for (int n = 0; n < nb_w; ++n) { const int slot = n & 3; PIPE_WAIT(n, nb_w);
                    if (n + 3 < nb_w) ISSUE(n + 3, kwb + (size_t)(64 * (n + 3)) * ZC, vwb + (size_t)(64 * (n + 3)) * ZC, ZC);
                    const int key0 = kws + 64 * n;
                    if (key0 + 63 >= t0 - 511 && key0 <= t0 + 3) {
                        unsigned vm = 0u; const bool fastp = (key0 + 63 <= t0 && key0 > t0 + 3 - 512);
                        if (!fastp) {
#pragma unroll
                            for (int qd = 0; qd < 4; ++qd)
#pragma unroll
                                for (int e = 0; e < 4; ++e) { const int kk = key0 + 16 * qd + 4 * q4 + e; vm |= (kk <= t && kk > t - 512) ? (1u << (4 * qd + e)) : 0u; } }
                        BLOCK64(slot, vm, fastp, true, m, l, o); } }
                l += __shfl_xor(l, 16); l += __shfl_xor(l, 32); const float sc2 = (l > 0.f ? 1.f / l : 0.f) * gwn;
#pragma unroll
                for (int dt = 0; dt < 4; ++dt) yb[dt] = yb[dt] + o[dt] * sc2;
            }
#pragma unroll
            for (int dt = 0; dt < 4; ++dt) { const int c = head * 64 + 16 * dt + 4 * q4; const u32x2 mw = *(const u32x2*)(zr + C_U + c), gw2 = *(const u32x2*)(zr + C_GB + c);
                u32x2 o2; o2.x = pk2(bflo(mw.x) + sigm(bflo(gw2.x)) * yb[dt][0], bfhi(mw.x) + sigm(bfhi(gw2.x)) * yb[dt][1]); o2.y = pk2(bflo(mw.y) + sigm(bflo(gw2.y)) * yb[dt][2], bfhi(mw.y) + sigm(bfhi(gw2.y)) * yb[dt][3]);
                *(u32x2*)(MIX + tok * 1024 + c) = o2; }
            __syncthreads();
        }
#undef DMA16
#undef ISSUE
#undef WAITV
#undef PIPE_WAIT
#undef QK_LDS
#undef PV_LDS
#undef BLOCK64
#undef MK8
    }
    SYNC(5);

    if (IN(6)) RPT(6) { pg8::Gemm g{(const bf16_t*)(dout + DO_MIX), (const bf16_t*)(ws + WS_WOUT_T), T, D, D, D}; pg8::StaticOrder So; So.init(T, D, G, (int)blockIdx.x);
        pg8::EpiF32 E{(float*)(ws + WS_ACCF), D}; pg8::gemm_phase<pg8::EpiF32, pg8::StaticOrder, true>(lds, g, So, E); }
    SYNC(6);

    if (IN(7)) RPT(7) {
        for (int m = gw; m < T; m += NGW) { f32x4 v[4], ac[4]; row_load(v, a.in[0] + (size_t)m * D, lane); row_load(ac, (const float*)(ws + WS_ACCF) + (size_t)m * D, lane); ln_apply(v, a.in[3], a.in[4], lane);
#pragma unroll
            for (int jx = 0; jx < 4; ++jx) v[jx] = v[jx] * ALPHA + ac[jx];
            ln_apply(v, a.in[21], a.in[22], lane); row_store_f32(v, (float*)(ws + WS_HF) + (size_t)m * D, lane); row_store_bf16(v, (bf16_t*)(ws + WS_HB) + (size_t)m * D, lane); }
        LAS float* scr = (LAS float*)(lds + wid * 8448);
        constexpr int I_SQ = 16 * 32, I_F1 = 16 * 128, I_F2 = 64 * 32;
        for (int it = gw; it < 2 * I_SQ + I_F1 + I_F2; it += NGW) { int r = it;
            if (r < I_SQ) { tr_item(a.in[23], 1024, 1024, 1024, (bf16_t*)(ws + WS_WXQ_T), scr, r, lane); continue; } r -= I_SQ;
            if (r < I_SQ) { tr_item(a.in[25], 1024, 1024, 1024, (bf16_t*)(ws + WS_WXO_T), scr, r, lane); continue; } r -= I_SQ;
            if (r < I_F1) { tr_item(a.in[28], 1024, 4096, 4096, (bf16_t*)(ws + WS_WFF1_T), scr, r, lane); continue; } r -= I_F1;
            tr_item(a.in[29], 4096, 1024, 1024, (bf16_t*)(ws + WS_WFF2_T), scr, r, lane); }
    }
    SYNC(7);

    if (IN(8)) RPT(8) { pg8::Gemm g{(const bf16_t*)(ws + WS_HB), (const bf16_t*)(ws + WS_WXQ_T), T, D, D, D}; pg8::StaticOrder So; So.init(T, D, G, (int)blockIdx.x);
        pg8::EpiBf16<0> E{(bf16_t*)(ws + WS_XQ), D, nullptr, XSCALE}; pg8::gemm_phase<pg8::EpiBf16<0>, pg8::StaticOrder, true>(lds, g, So, E); }
    SYNC(8);

    if (IN(9)) RPT(9) {
        const bf16_t* XQ = (const bf16_t*)(ws + WS_XQ); const bf16_t* XKV = (const bf16_t*)(dout + DO_XKV); bf16_t* XO = (bf16_t*)(ws + WS_XO);
        const int j = lane & 15, q4 = lane >> 4;
        const unsigned ldsb = (unsigned)(uintptr_t)lds;
        const unsigned kadr0 = (unsigned)(j * 128 + ((q4 ^ (j & 7)) << 4)), kadr1 = (unsigned)(j * 128 + (((4 + q4) ^ (j & 7)) << 4));
        const int vrow = 4 * q4 + (j >> 2);
        unsigned vadr4[4];
#pragma unroll
        for (int dtl = 0; dtl < 4; ++dtl) vadr4[dtl] = (unsigned)(vrow * 128 + (((2 * dtl + ((lane & 3) >> 1)) ^ (vrow & 7)) << 4) + 8 * (lane & 1));
#define WAITV(n) asm volatile("s_waitcnt vmcnt(" #n ")" ::: "memory")
#define X_ISSUE(st) do { const int st_ = (st); const int sl_ = st_ & 1; \
            if (st_ < 4) { const bf16_t* gb_ = kvb + (size_t)(64 * st_) * 2048; \
                _Pragma("unroll") for (int q_ = 0; q_ < 4; ++q_) { const int row_ = 8 * wid + (lane >> 3); const int ch_ = (lane & 7) ^ (lane >> 3); \
                    __builtin_amdgcn_global_load_lds((const unsigned*)(gb_ + (size_t)row_ * 2048 + 64 * q_ + ch_ * 8), (LAS unsigned*)(lds + sl_ * 32768 + q_ * 8192 + wid * 1024), 16, 0, 0); } } \
            else { const bf16_t* gb_ = kvb + (size_t)(64 * (st_ & 3)) * 2048 + 1024; \
                _Pragma("unroll") for (int q_ = 0; q_ < 4; ++q_) { const int row_ = 8 * wid + (lane >> 3); const int ch_ = (lane & 7) ^ (lane >> 3); \
                    __builtin_amdgcn_global_load_lds((const unsigned*)(gb_ + (size_t)row_ * 2048 + 64 * q_ + ch_ * 8), (LAS unsigned*)(lds + sl_ * 32768 + q_ * 8192 + wid * 1024), 16, 0, 0); } } } while (0)
#define X_WAIT(n) do { WAITV(0); __builtin_amdgcn_s_barrier(); asm volatile("" ::: "memory"); } while (0)
#define MK8(lo, hi) __builtin_bit_cast(bf16x8, (u32x4){(lo).x, (lo).y, (hi).x, (hi).y})
#define X_VGRP(slot, d0, pfa, pfb) do { const unsigned sb_ = (unsigned)((slot) * 32768 + ((d0) >> 2) * 8192) + ldsb; \
            const unsigned a0_ = vadr4[0] + sb_, a1_ = vadr4[1] + sb_, a2_ = vadr4[2] + sb_, a3_ = vadr4[3] + sb_; \
            u32x2 v0_, v1_, v2_, v3_, v4_, v5_, v6_, v7_, v8_, v9_, v10_, v11_, v12_, v13_, v14_, v15_; \
            asm volatile("ds_read_b64_tr_b16 %0, %16\n\tds_read_b64_tr_b16 %1, %16 offset:2048\n\tds_read_b64_tr_b16 %2, %16 offset:4096\n\tds_read_b64_tr_b16 %3, %16 offset:6144\n\t" \
                         "ds_read_b64_tr_b16 %4, %17\n\tds_read_b64_tr_b16 %5, %17 offset:2048\n\tds_read_b64_tr_b16 %6, %17 offset:4096\n\tds_read_b64_tr_b16 %7, %17 offset:6144\n\t" \
                         "ds_read_b64_tr_b16 %8, %18\n\tds_read_b64_tr_b16 %9, %18 offset:2048\n\tds_read_b64_tr_b16 %10, %18 offset:4096\n\tds_read_b64_tr_b16 %11, %18 offset:6144\n\t" \
                         "ds_read_b64_tr_b16 %12, %19\n\tds_read_b64_tr_b16 %13, %19 offset:2048\n\tds_read_b64_tr_b16 %14, %19 offset:4096\n\tds_read_b64_tr_b16 %15, %19 offset:6144\n\ts_waitcnt lgkmcnt(0)" \
                         : "=&v"(v0_), "=&v"(v1_), "=&v"(v2_), "=&v"(v3_), "=&v"(v4_), "=&v"(v5_), "=&v"(v6_), "=&v"(v7_), "=&v"(v8_), "=&v"(v9_), "=&v"(v10_), "=&v"(v11_), "=&v"(v12_), "=&v"(v13_), "=&v"(v14_), "=&v"(v15_) \
                         : "v"(a0_), "v"(a1_), "v"(a2_), "v"(a3_) : "memory"); \
            o[(d0)] = MFMA16(MK8(v0_, v1_), pfa, o[(d0)]); o[(d0)] = MFMA16(MK8(v2_, v3_), pfb, o[(d0)]); o[(d0) + 1] = MFMA16(MK8(v4_, v5_), pfa, o[(d0) + 1]); o[(d0) + 1] = MFMA16(MK8(v6_, v7_), pfb, o[(d0) + 1]); \
            o[(d0) + 2] = MFMA16(MK8(v8_, v9_), pfa, o[(d0) + 2]); o[(d0) + 2] = MFMA16(MK8(v10_, v11_), pfb, o[(d0) + 2]); o[(d0) + 3] = MFMA16(MK8(v12_, v13_), pfa, o[(d0) + 3]); o[(d0) + 3] = MFMA16(MK8(v14_, v15_), pfb, o[(d0) + 3]); } while (0)
        for (int u = blockIdx.x; u < 512; u += G) {
            const int hx = u & 3, tile = u >> 2, tok0 = 128 * tile + 16 * wid, b = tile >> 6;
            const bf16_t* kvb = XKV + (size_t)(b * 256) * 2048 + hx * 256;
            bf16x8 qf[8];
#pragma unroll
            for (int ks = 0; ks < 8; ++ks) qf[ks] = *(const bf16x8*)(XQ + (size_t)(tok0 + j) * 1024 + hx * 256 + 32 * ks + 8 * q4);
            WAITV(0); __builtin_amdgcn_s_barrier(); asm volatile("" ::: "memory");
            X_ISSUE(4); X_ISSUE(5);
            f32x4 s[16];
#pragma unroll
            for (int kt = 0; kt < 16; ++kt) { const bf16_t* kp = kvb + (size_t)(16 * kt + j) * 2048 + 8 * q4; f32x4 acc = {0.f, 0.f, 0.f, 0.f};
#pragma unroll
                for (int ks = 0; ks < 8; ++ks) acc = MFMA16(*(const bf16x8*)(kp + 32 * ks), qf[ks], acc);
                s[kt] = acc; }
            float mx = -1e30f;
#pragma unroll
            for (int kt = 0; kt < 16; ++kt) mx = fmaxf(fmaxf(mx, fmaxf(s[kt][0], s[kt][1])), fmaxf(s[kt][2], s[kt][3]));
            mx = fmaxf(mx, __shfl_xor(mx, 16)); mx = fmaxf(mx, __shfl_xor(mx, 32));
            float l = 0.f; bf16x8 pf[8];
#pragma unroll
            for (int kk = 0; kk < 8; ++kk) { float p[8];
#pragma unroll
                for (int e = 0; e < 4; ++e) { p[e] = __builtin_amdgcn_exp2f(s[2 * kk][e] - mx); p[4 + e] = __builtin_amdgcn_exp2f(s[2 * kk + 1][e] - mx); l += p[e] + p[4 + e]; }
                pf[kk] = pack_p(p); }
            l += __shfl_xor(l, 16); l += __shfl_xor(l, 32); const float invl = 1.f / l;
            f32x4 o[16];
#pragma unroll
            for (int dt = 0; dt < 16; ++dt) o[dt] = (f32x4){0.f, 0.f, 0.f, 0.f};
#pragma unroll
            for (int vb = 0; vb < 4; ++vb) {
                if (vb != 1) WAITV(0);
                __builtin_amdgcn_s_barrier(); asm volatile("" ::: "memory");
                if (vb == 1) X_ISSUE(6);
                if (vb == 2) X_ISSUE(7);
                X_VGRP(vb & 1, 0, pf[2 * vb], pf[2 * vb + 1]); X_VGRP(vb & 1, 4, pf[2 * vb], pf[2 * vb + 1]); X_VGRP(vb & 1, 8, pf[2 * vb], pf[2 * vb + 1]); X_VGRP(vb & 1, 12, pf[2 * vb], pf[2 * vb + 1]); }
#pragma unroll
            for (int dt = 0; dt < 16; ++dt) { u32x2 ow; ow.x = cvtpk(o[dt][0] * invl, o[dt][1] * invl); ow.y = cvtpk(o[dt][2] * invl, o[dt][3] * invl);
                *(u32x2*)(XO + (size_t)(tok0 + j) * 1024 + hx * 256 + 16 * dt + 4 * q4) = ow; }
        }
        WAITV(0); __syncthreads();
#undef WAITV
#undef X_ISSUE
#undef X_WAIT
#undef MK8
#undef X_VGRP
    }
    SYNC(9);

    if (IN(10)) RPT(10) { pg8::Gemm g{(const bf16_t*)(ws + WS_XO), (const bf16_t*)(ws + WS_WXO_T), T, D, D, D}; pg8::StaticOrder So; So.init(T, D, G, (int)blockIdx.x);
        pg8::EpiF32 E{(float*)(ws + WS_ACCF), D}; pg8::gemm_phase<pg8::EpiF32, pg8::StaticOrder, true>(lds, g, So, E); }
    SYNC(10);

    if (IN(11)) RPT(11) {
        for (int m = gw; m < T; m += NGW) { f32x4 v[4], ac[4]; row_load(v, (const float*)(ws + WS_HF) + (size_t)m * D, lane); row_load(ac, (const float*)(ws + WS_ACCF) + (size_t)m * D, lane);
#pragma unroll
            for (int jx = 0; jx < 4; ++jx) v[jx] = v[jx] * ALPHA + ac[jx];
            ln_apply(v, a.in[26], a.in[27], lane); row_store_f32(v, (float*)(ws + WS_HF) + (size_t)m * D, lane); row_store_bf16(v, (bf16_t*)(ws + WS_HB) + (size_t)m * D, lane); }
    }
    SYNC(11);

    if (IN(12)) RPT(12) { pg8::Gemm g{(const bf16_t*)(ws + WS_HB), (const bf16_t*)(ws + WS_WFF1_T), T, FF, D, D}; pg8::StaticOrder So; So.init(T, FF, G, (int)blockIdx.x);
        pg8::EpiBf16<3> E{(bf16_t*)(ws + WS_FFB), FF, nullptr, 1.f}; pg8::gemm_phase<pg8::EpiBf16<3>, pg8::StaticOrder, true>(lds, g, So, E); }
    SYNC(12);

    if (IN(13)) RPT(13) { pg8::Gemm g{(const bf16_t*)(ws + WS_FFB), (const bf16_t*)(ws + WS_WFF2_T), T, D, FF, FF}; pg8::StaticOrder So; So.init(T, D, G, (int)blockIdx.x);
        pg8::EpiF32 E{a.out, D}; pg8::gemm_phase<pg8::EpiF32, pg8::StaticOrder, true>(lds, g, So, E); }
    SYNC(13);

    if (IN(14)) RPT(14) {
        for (int m = gw; m < T; m += NGW) { f32x4 v[4], ac[4]; row_load(v, (const float*)(ws + WS_HF) + (size_t)m * D, lane); row_load(ac, a.out + (size_t)m * D, lane);
#pragma unroll
            for (int jx = 0; jx < 4; ++jx) v[jx] = v[jx] * ALPHA + ac[jx];
            ln_apply(v, a.in[30], a.in[31], lane); row_store_f32(v, a.out + (size_t)m * D, lane); }
    }
#undef IN
#undef SYNC
}

constexpr int NPHASE = 15;
extern "C" void kernel_launch(void* const* d_in, const int* in_sizes, int n_in, void* d_out, int out_size, void* d_ws, size_t ws_size, hipStream_t stream) {
    static int grid = 0;
    if (grid == 0) {
        if (n_in != 32 || out_size != T * D || ws_size < 256 * MiB) { fprintf(stderr, "kernel_launch: unexpected shapes (n_in %d out %d ws %zu)\n", n_in, out_size, ws_size); grid = -1; return; }
        int dev = 0, cus = 0, per_cu = 0;
        hipGetDevice(&dev); hipDeviceGetAttribute(&cus, hipDeviceAttributeMultiprocessorCount, dev);
        hipFuncSetAttribute((const void*)mk_fwd, hipFuncAttributeMaxDynamicSharedMemorySize, LDS_BYTES);
        hipOccupancyMaxActiveBlocksPerMultiprocessor(&per_cu, (const void*)mk_fwd, 512, LDS_BYTES);
        (void)hipGetLastError();
        if (per_cu < 1) fprintf(stderr, "kernel_launch: occupancy query says %d blocks per CU\n", per_cu);
        grid = cus > 0 ? cus : 256;
    }
    if (grid < 0) return;
    Args a{};
    for (int i = 0; i < 32; ++i) a.in[i] = (const float*)d_in[i];
    a.out = (float*)d_out; a.ws = (unsigned char*)d_ws; a.ph_lo = 0; a.ph_hi = NPHASE;
    (void)hipMemsetAsync((char*)d_ws + WS_BAR, 0, 16384, stream);
    void* args[] = {&a};
    hipError_t e = hipLaunchCooperativeKernel((const void*)mk_fwd, dim3(grid), dim3(512), args, LDS_BYTES, stream);
    if (e != hipSuccess) fprintf(stderr, "cooperative launch failed: %s (grid %d)\n", hipGetErrorString(e), grid);
}
```
